# Optimizing an MI355X kernel written in HIP

```python
import jax, jax.numpy as jnp
from jax import lax
import numpy as np

D_MODEL = 2048
BATCH = 4
SEQ = 4096
DEPTH = 2

GRID_W = 64
CTX_LEN = 256
CHUNK = 64
EPS = 1e-5
ROPE_BASE = 10000.0

D_MIX = D_MODEL
N_GROUPS = 4
GROUP_W = D_MIX // N_GROUPS

M_HEADS = 4
M_DH = GROUP_W // M_HEADS
S_HEADS = 8
S_P = GROUP_W // S_HEADS
S_G = 2
S_N = 128
CONV_W = 3
S_CONV_CH = GROUP_W + 2 * S_G * S_N
R_HEADS = 4
R_DH = GROUP_W // R_HEADS
G_HEADS = 4
G_DV = GROUP_W // G_HEADS
G_DK = G_DV // 2
G_RANK = 16
G_TAU = 16.0
D_FF = -(-(8 * D_MODEL) // (3 * 256)) * 256

IN_COLS = (
    ('m_q', M_HEADS * M_DH), ('m_k', M_HEADS * M_DH), ('m_v', M_HEADS * M_DH), ('m_o', GROUP_W),
    ('m_i', 2 * M_HEADS), ('m_f', 2 * M_HEADS),
    ('s_z', GROUP_W), ('s_xbc', S_CONV_CH), ('s_dt', 2 * S_HEADS),
    ('r_q', GROUP_W), ('r_k', GROUP_W), ('r_v', GROUP_W), ('r_g', GROUP_W),
    ('g_q', G_HEADS * G_DK), ('g_k', G_HEADS * G_DK), ('g_v', G_HEADS * G_DV), ('g_g', GROUP_W),
    ('g_a', 2 * G_RANK),
)
N_IN = sum(n for _, n in IN_COLS)

kernel_name = 'hybrid_parallel_heads_dit_block'


def layer_norm(x, gain=None, bias=None):
    x32 = x.astype(jnp.float32)
    mu = jnp.mean(x32, axis=-1, keepdims=True)
    var = jnp.mean(jnp.square(x32 - mu), axis=-1, keepdims=True)
    y = (x32 - mu) * lax.rsqrt(var + EPS)
    if gain is not None:
        y = y * gain + bias
    return y.astype(x.dtype)


def rms_norm(x, gain):
    x32 = x.astype(jnp.float32)
    y = x32 * lax.rsqrt(jnp.mean(jnp.square(x32), axis=-1, keepdims=True) + EPS)
    return (y * gain).astype(x.dtype)


def head_norm(y, gain, center):
    y32 = y.astype(jnp.float32)
    if center:
        y32 = y32 - jnp.mean(y32, axis=-1, keepdims=True)
    y32 = y32 * lax.rsqrt(jnp.mean(jnp.square(y32), axis=-1, keepdims=True) + EPS)
    return (y32.reshape(*y.shape[:2], -1) * gain).astype(y.dtype)


def modulate(x, shift, scale):
    return layer_norm(x) * (1.0 + scale) + shift


def _heads(a, h):
    return a.reshape(*a.shape[:-1], h, -1)


def split_cols(u):
    sizes = [n for _, n in IN_COLS]
    parts = jnp.split(u, np.cumsum(sizes)[:-1].tolist(), axis=-1)
    return {name: p for (name, _), p in zip(IN_COLS, parts)}


def dwconv_centred(x, w, b):
    k = w.shape[0]
    pad = k // 2
    length = x.shape[1]
    xp = jnp.pad(x, ((0, 0), (pad, pad), (0, 0)))
    out = b
    for i in range(k):
        out = out + xp[:, i:i + length] * w[i]
    return out


def rotary_2d(x, rows, cols):
    half = x.shape[-1] // 2
    quarter = half // 2
    freqs = 1.0 / (ROPE_BASE ** (jnp.arange(quarter, dtype=jnp.float32) / quarter))

    def rot(xh, pos):
        ang = pos[:, None] * freqs[None, :]
        cos = jnp.cos(ang)[None, :, None, :].astype(x.dtype)
        sin = jnp.sin(ang)[None, :, None, :].astype(x.dtype)
        x1, x2 = xh[..., :quarter], xh[..., quarter:]
        return jnp.concatenate([x1 * cos - x2 * sin, x1 * sin + x2 * cos], axis=-1)

    return jnp.concatenate([rot(x[..., :half], rows), rot(x[..., half:], cols)], axis=-1)


def _chunks(a):
    b, t = a.shape[:2]
    return jnp.moveaxis(a.reshape(b, t // CHUNK, CHUNK, *a.shape[2:]), 1, 0)


def _unchunk(a):
    n, b = a.shape[:2]
    return jnp.moveaxis(a, 0, 1).reshape(b, n * CHUNK, *a.shape[3:])


def _causal_mask():
    return jnp.tril(jnp.ones((CHUNK, CHUNK), dtype=bool))[None, :, :, None]


def mlstm_scan(q, k, v, ig, lf):
    dtype = v.dtype
    q, k, v, ig, lf = (a.astype(jnp.float32) for a in (q, k, v, ig, lf))
    b_sz, _, h_sz, dk = q.shape
    dv = v.shape[-1]
    causal = _causal_mask()

    def step(carry, inp):
        c_st, n_st, m_st = carry
        qb, kb, vb, igb, lfb = inp
        b = jnp.cumsum(lfb, axis=1)
        log_intra = jnp.where(causal, b[:, :, None] - b[:, None] + igb[:, None], -jnp.inf)
        log_inter = b + m_st[:, None]
        m_i = jnp.maximum(log_inter, jnp.max(log_intra, axis=2))
        w = jnp.exp(log_intra - m_i[:, :, None])
        w_inter = jnp.exp(log_inter - m_i)
        s = jnp.einsum('bihd,bjhd->bijh', qb, kb) * w
        num = jnp.einsum('bijh,bjhe->bihe', s, vb) + w_inter[..., None] * jnp.einsum('bihd,bhde->bihe', qb, c_st)
        den = jnp.sum(s, axis=2) + w_inter * jnp.einsum('bihd,bhd->bih', qb, n_st)
        h = num / jnp.maximum(jnp.abs(den), jnp.exp(-m_i))[..., None]
        b_end = b[:, -1]
        log_state = b_end[:, None] - b + igb
        m_new = jnp.maximum(b_end + m_st, jnp.max(log_state, axis=1))
        ws = jnp.exp(log_state - m_new[:, None])
        decay = jnp.exp(b_end + m_st - m_new)
        c_st = decay[..., None, None] * c_st + jnp.einsum('bjhd,bjhe->bhde', kb * ws[..., None], vb)
        n_st = decay[..., None] * n_st + jnp.einsum('bjhd,bjh->bhd', kb, ws)
        return (c_st, n_st, m_new), h

    init = (jnp.zeros((b_sz, h_sz, dk, dv), jnp.float32), jnp.zeros((b_sz, h_sz, dk), jnp.float32),
            jnp.zeros((b_sz, h_sz), jnp.float32))
    _, hs = lax.scan(step, init, tuple(_chunks(a) for a in (q, k, v, ig, lf)))
    return _unchunk(hs).astype(dtype)


def decay_scan(q, k, v, log_a):
    dtype = v.dtype
    q, k, v, log_a = (a.astype(jnp.float32) for a in (q, k, v, log_a))
    b_sz, _, h_sz, dk = q.shape
    dv = v.shape[-1]
    causal = _causal_mask()

    def step(s_st, inp):
        qb, kb, vb, la = inp
        b = jnp.cumsum(la, axis=1)
        w = jnp.exp(jnp.where(causal, b[:, :, None] - b[:, None], -jnp.inf))
        s = jnp.einsum('bihd,bjhd->bijh', qb, kb) * w
        y = jnp.einsum('bijh,bjhe->bihe', s, vb) + jnp.exp(b)[..., None] * jnp.einsum('bihd,bhde->bihe', qb, s_st)
        b_end = b[:, -1]
        s_st = jnp.exp(b_end)[..., None, None] * s_st + jnp.einsum(
            'bjhd,bjhe->bhde', kb * jnp.exp(b_end[:, None] - b)[..., None], vb)
        return s_st, y

    init = jnp.zeros((b_sz, h_sz, dk, dv), jnp.float32)
    _, ys = lax.scan(step, init, tuple(_chunks(a) for a in (q, k, v, log_a)))
    return _unchunk(ys).astype(dtype)


def gla_scan(q, k, v, log_a):
    dtype = v.dtype
    q, k, v, log_a = (a.astype(jnp.float32) for a in (q, k, v, log_a))
    b_sz, _, h_sz, dk = q.shape
    dv = v.shape[-1]
    causal = _causal_mask()

    def step(s_st, inp):
        qb, kb, vb, la = inp
        b = jnp.cumsum(la, axis=1)
        qg = qb * jnp.exp(b)
        kg = kb * jnp.exp(-b)
        s = jnp.where(causal, jnp.einsum('bihd,bjhd->bijh', qg, kg), 0.0)
        y = jnp.einsum('bijh,bjhe->bihe', s, vb) + jnp.einsum('bihd,bhde->bihe', qg, s_st)
        b_end = b[:, -1]
        s_st = jnp.exp(b_end)[..., None] * s_st + jnp.einsum(
            'bjhd,bjhe->bhde', kb * jnp.exp(b_end[:, None] - b), vb)
        return s_st, y

    init = jnp.zeros((b_sz, h_sz, dk, dv), jnp.float32)
    _, ys = lax.scan(step, init, tuple(_chunks(a) for a in (q, k, v, log_a)))
    return _unchunk(ys).astype(dtype)


def _orient(a, backward):
    return jnp.flip(a, axis=1) if backward else a


def two_way(scan_fn, ctx_args, lat_args):
    lc = ctx_args[0][0].shape[1]
    outs = []
    for d in range(2):
        bwd = d == 1
        seq = tuple(jnp.concatenate([_orient(a, bwd), _orient(b, bwd)], axis=1)
                    for a, b in zip(ctx_args[d], lat_args[d]))
        y = scan_fn(*seq)
        outs.append((_orient(y[:, :lc], bwd), _orient(y[:, lc:], bwd)))
    return outs[0][0] + outs[1][0], outs[0][1] + outs[1][1]


def mlstm_group(pc, pl, ig_b, fg_b, norm_g):
    def prep(p):
        b_sz, length, _ = p['m_q'].shape
        q = _heads(p['m_q'], M_HEADS) * M_DH ** -0.5
        k = _heads(p['m_k'], M_HEADS)
        v = _heads(p['m_v'], M_HEADS)
        ig = p['m_i'].reshape(b_sz, length, 2, M_HEADS) + ig_b
        lf = jax.nn.log_sigmoid(p['m_f'].reshape(b_sz, length, 2, M_HEADS) + fg_b)
        return [(q, k, v, ig[:, :, d], lf[:, :, d]) for d in range(2)]

    h_c, h_l = two_way(mlstm_scan, prep(pc), prep(pl))
    return (jax.nn.sigmoid(pc['m_o']) * head_norm(h_c, norm_g, True),
            jax.nn.sigmoid(pl['m_o']) * head_norm(h_l, norm_g, True))


def ssd_group(pc, pl, conv_w, conv_b, dt_bias, a_log, d_skip, norm_g):
    a_neg = -jnp.exp(a_log)

    def prep(p):
        b_sz, length, _ = p['s_z'].shape
        xbc = jax.nn.silu(dwconv_centred(p['s_xbc'], conv_w, conv_b))
        xs, bm, cm = jnp.split(xbc, [GROUP_W, GROUP_W + S_G * S_N], axis=-1)
        xs = _heads(xs, S_HEADS)
        bm = jnp.repeat(_heads(bm, S_G), S_HEADS // S_G, axis=2)
        cm = jnp.repeat(_heads(cm, S_G), S_HEADS // S_G, axis=2)
        dt = jax.nn.softplus(p['s_dt'].reshape(b_sz, length, 2, S_HEADS) + dt_bias)
        return xs, [(cm, bm * dt[:, :, d, :, None], xs, dt[:, :, d] * a_neg[d]) for d in range(2)]

    xs_c, args_c = prep(pc)
    xs_l, args_l = prep(pl)
    y_c, y_l = two_way(decay_scan, args_c, args_l)

    def out(y, xs, p):
        y = (y + d_skip[:, None] * xs).reshape(*xs.shape[:2], GROUP_W) * jax.nn.silu(p['s_z'])
        return rms_norm(y, norm_g)

    return out(y_c, xs_c, pc), out(y_l, xs_l, pl)


def retention_group(pc, pl, rows, cols, r_decay, norm_g):
    log_gamma = -jnp.exp(r_decay)

    def prep(p, pos):
        q = _heads(p['r_q'], R_HEADS)
        k = _heads(p['r_k'], R_HEADS) * R_DH ** -0.5
        if pos is not None:
            q = rotary_2d(q, *pos)
            k = rotary_2d(k, *pos)
        v = _heads(p['r_v'], R_HEADS)
        return [(q, k, v, jnp.broadcast_to(log_gamma[d], q.shape[:3])) for d in range(2)]

    y_c, y_l = two_way(decay_scan, prep(pc, None), prep(pl, (rows, cols)))
    return (head_norm(y_c, norm_g, True) * jax.nn.silu(pc['r_g']),
            head_norm(y_l, norm_g, True) * jax.nn.silu(pl['r_g']))


def gla_group(pc, pl, gate_w, gate_b, norm_g):
    def prep(p):
        b_sz, length, _ = p['g_q'].shape
        q = _heads(p['g_q'], G_HEADS) * G_DK ** -0.5
        k = _heads(p['g_k'], G_HEADS)
        v = _heads(p['g_v'], G_HEADS)
        a = p['g_a'].reshape(b_sz, length, 2, G_RANK)
        la = jax.nn.log_sigmoid(jnp.einsum('blnr,nrk->blnk', a, gate_w) + gate_b) / G_TAU
        return [(q, k, v, _heads(la[:, :, d], G_HEADS)) for d in range(2)]

    y_c, y_l = two_way(gla_scan, prep(pc), prep(pl))
    return (head_norm(y_c, norm_g, False) * jax.nn.silu(pc['g_g']),
            head_norm(y_l, norm_g, False) * jax.nn.silu(pl['g_g']))


def token_mixers(h, hc, rows, cols, w_in, w_out, m_ig_b, m_fg_b, m_norm, s_conv_w, s_conv_b,
                 s_dt_bias, s_a_log, s_d, s_norm, r_decay, r_norm, g_gate_w, g_gate_b, g_norm):
    pl = split_cols(h @ w_in)
    pc = split_cols(hc @ w_in)
    m_c, m_l = mlstm_group(pc, pl, m_ig_b, m_fg_b, m_norm)
    s_c, s_l = ssd_group(pc, pl, s_conv_w, s_conv_b, s_dt_bias, s_a_log, s_d, s_norm)
    r_c, r_l = retention_group(pc, pl, rows, cols, r_decay, r_norm)
    g_c, g_l = gla_group(pc, pl, g_gate_w, g_gate_b, g_norm)
    y_l = jnp.concatenate([m_l, s_l, r_l, g_l], axis=-1) @ w_out
    y_c = jnp.concatenate([m_c, s_c, r_c, g_c], axis=-1) @ w_out
    return y_l, y_c


def swiglu(h, w_up, w_down):
    a, g = jnp.split(h @ w_up, 2, axis=-1)
    return (jax.nn.silu(a) * g) @ w_down


def setup_inputs(seed: int = 0) -> dict:
    key = jax.random.key(seed)
    ks = iter(jax.random.split(key, 40))

    def nrm(shape, scale):
        return scale * jax.random.normal(next(ks), shape, jnp.float32)

    def uni(shape, lo, hi):
        return jax.random.uniform(next(ks), shape, jnp.float32, lo, hi)

    beta = (8.0 * DEPTH) ** -0.25
    dt0 = jnp.exp(uni((DEPTH, 2, S_HEADS), float(np.log(1e-3)), float(np.log(1e-1))))
    gamma = 1.0 - 2.0 ** (-5.0 - np.arange(R_HEADS, dtype=np.float32))
    r_decay0 = jnp.asarray(np.log(-np.log(gamma)), jnp.float32)
    return {
        'x': nrm((BATCH, SEQ, D_MODEL), 1.0),
        'c': nrm((BATCH, D_MODEL), 1.0),
        'ctx': nrm((BATCH, CTX_LEN, D_MODEL), 1.0),
        'c_ctx': nrm((D_MODEL,), 1.0),
        'ada_w': nrm((DEPTH, D_MODEL, 6 * D_MODEL), 0.5 * D_MODEL ** -0.5),
        'ada_b': nrm((DEPTH, 6 * D_MODEL), 0.02),
        'w_in': nrm((DEPTH, D_MODEL, N_IN), D_MODEL ** -0.5),
        'm_ig_b': -2.0 + nrm((DEPTH, 2, M_HEADS), 0.1),
        'm_fg_b': jnp.linspace(3.0, 6.0, M_HEADS, dtype=jnp.float32) + nrm((DEPTH, 2, M_HEADS), 0.1),
        'm_norm': 1.0 + nrm((DEPTH, GROUP_W), 0.02),
        's_conv_w': nrm((DEPTH, CONV_W, S_CONV_CH), CONV_W ** -0.5),
        's_conv_b': nrm((DEPTH, S_CONV_CH), 0.02),
        's_dt_bias': dt0 + jnp.log(-jnp.expm1(-dt0)),
        's_a_log': jnp.log(uni((DEPTH, 2, S_HEADS), 1.0, 16.0)),
        's_d': 1.0 + nrm((DEPTH, S_HEADS), 0.02),
        's_norm': 1.0 + nrm((DEPTH, GROUP_W), 0.02),
        'r_decay': r_decay0 + nrm((DEPTH, 2, R_HEADS), 0.05),
        'r_norm': 1.0 + nrm((DEPTH, GROUP_W), 0.02),
        'g_gate_w': nrm((DEPTH, 2, G_RANK, G_HEADS * G_DK), G_RANK ** -0.5),
        'g_gate_b': nrm((DEPTH, 2, G_HEADS * G_DK), 0.1),
        'g_norm': 1.0 + nrm((DEPTH, GROUP_W), 0.02),
        'w_out': nrm((DEPTH, D_MIX, D_MODEL), beta * D_MIX ** -0.5),
        'post_g': 1.0 + nrm((DEPTH, 2, D_MODEL), 0.02),
        'post_b': nrm((DEPTH, 2, D_MODEL), 0.02),
        'ffn_w_up': nrm((DEPTH, D_MODEL, 2 * D_FF), D_MODEL ** -0.5),
        'ffn_w_down': nrm((DEPTH, D_FF, D_MODEL), beta * D_FF ** -0.5),
    }


def reference(x, c, ctx, c_ctx, ada_w, ada_b, w_in, m_ig_b, m_fg_b, m_norm, s_conv_w, s_conv_b,
              s_dt_bias, s_a_log, s_d, s_norm, r_decay, r_norm, g_gate_w, g_gate_b, g_norm, w_out,
              post_g, post_b, ffn_w_up, ffn_w_down):
    alpha = (2.0 * DEPTH) ** 0.25
    n_lat = x.shape[1]
    ROWS = n_lat // GRID_W
    rows = jnp.repeat(jnp.arange(ROWS, dtype=jnp.float32), GRID_W)
    cols = jnp.tile(jnp.arange(GRID_W, dtype=jnp.float32), ROWS)
    xc = ctx
    for l in range(DEPTH):
        last = l == DEPTH - 1
        mod = jax.nn.silu(c) @ ada_w[l] + ada_b[l]
        mod_c = jax.nn.silu(c_ctx) @ ada_w[l] + ada_b[l]
        sh1, sc1, g1, sh2, sc2, g2 = jnp.split(mod[:, None, :], 6, axis=-1)
        sh1c, sc1c, g1c, sh2c, sc2c, g2c = jnp.split(mod_c, 6, axis=-1)

        h = modulate(x, sh1, sc1)
        hc = modulate(xc, sh1c, sc1c)
        y, yc = token_mixers(h, hc, rows, cols, w_in[l], w_out[l], m_ig_b[l], m_fg_b[l], m_norm[l],
                             s_conv_w[l], s_conv_b[l], s_dt_bias[l], s_a_log[l], s_d[l], s_norm[l],
                             r_decay[l], r_norm[l], g_gate_w[l], g_gate_b[l], g_norm[l])
        x = layer_norm(alpha * x + g1 * y, post_g[l, 0], post_b[l, 0])
        x = layer_norm(alpha * x + g2 * swiglu(modulate(x, sh2, sc2), ffn_w_up[l], ffn_w_down[l]),
                       post_g[l, 1], post_b[l, 1])
        if not last:
            xc = layer_norm(alpha * xc + g1c * yc, post_g[l, 0], post_b[l, 0])
            xc = layer_norm(alpha * xc + g2c * swiglu(modulate(xc, sh2c, sc2c), ffn_w_up[l], ffn_w_down[l]),
                            post_g[l, 1], post_b[l, 1])
    return x
```

```cpp
#include <hip/hip_runtime.h>
#include <hip/hip_cooperative_groups.h>
#include <cstdio>
namespace cg = cooperative_groups;
namespace pg8 {
#define PG8_LAS __attribute__((address_space(3)))
typedef unsigned short bf16_t;
typedef short bf16x8 __attribute__((ext_vector_type(8)));
typedef float f32x4 __attribute__((ext_vector_type(4)));
typedef unsigned u32x4 __attribute__((ext_vector_type(4)));
constexpr int BM = 256, BK = 64, HALF = 128, HTB = HALF * BK * 2  , STAGE_BYTES = 8 * HTB, NXCD = 8, WGM = 8;

__host__ __device__ __forceinline__ int lds_byte(int r, int c) { const int st = (r >> 4) * 2 + (c >> 5), rr = r & 15, cc = c & 31, ob = rr * 64 + cc * 2; return st * 1024 + (ob ^ (((ob >> 9) & 1) << 5)); }
__host__ __device__ __forceinline__ void stage_rc(int b, int& R, int& C) { const int st = b / 1024, sb = b % 1024, swz = sb ^ (((sb >> 9) & 1) << 5); R = (st >> 1) * 16 + swz / 64; C = (st & 1) * 32 + (swz % 64) / 2; }
__host__ __device__ __forceinline__ int perm32(int rho) { const int n = rho >> 4, i = rho & 15; return 8 * (i >> 2) + 4 * n + (i & 3); }

struct Unit { int pm, pn; };
struct Gemm { const bf16_t* A; const bf16_t* Bt; int M, N, K; };

struct StaticOrder {
    int nM, nN, nwg, G, c;
    __host__ __device__ void init(int M, int N, int G_, int c_) { nM = M / BM; nN = N / BM; nwg = nM * nN; G = G_; c = c_; }
    __host__ __device__ bool next(int i, Unit& u) const {
        const long L = (long)i * G + c; if (L >= nwg) return false;
        int wgid = (int)L; { const int q = nwg / NXCD, r = nwg % NXCD, xcd = wgid % NXCD, off = wgid / NXCD; wgid = (xcd < r ? xcd * (q + 1) : r * (q + 1) + (xcd - r) * q) + off; }
        const int nig = WGM * nN, gid = wgid / nig, fm = gid * WGM, gsz = (nM - fm) < WGM ? (nM - fm) : WGM;
        u.pm = fm + ((wgid % nig) % gsz); u.pn = (wgid % nig) / gsz; return true;
    }
    __device__ __forceinline__ void a_ready(const Unit&) const {}
    __device__ __forceinline__ void done(const Unit&) const {}
};
__device__ __forceinline__ unsigned cvt_pk_bf16(float lo, float hi) { unsigned r; asm volatile("v_cvt_pk_bf16_f32 %0, %1, %2" : "=v"(r) : "v"(lo), "v"(hi)); return r; }
template <class Epi, class Sched, bool STAMP = false>
__device__ __forceinline__ void gemm_phase(PG8_LAS unsigned char* lds, const Gemm g, const Sched& S, const Epi& E, unsigned long long* stamps) {
    int tid_ = threadIdx.x; asm volatile("" : "+v"(tid_)); const int tid = tid_, wid = __builtin_amdgcn_readfirstlane(tid >> 6), lane = tid & 63, wr = wid >> 2, wc = wid & 3, fr = lane & 15, fq = lane >> 4;
    const int K = g.K, nt = K / BK;
    int ts_lo = 0, ts_hi = 0, nts = 0; const unsigned long long rt_entry = STAMP ? (unsigned long long)wall_clock64() : 0ull;
#define PG8_STAMP() do { if (STAMP && wid == 0 && nts < 64) { const unsigned long long _c = (unsigned long long)clock64(); \
        ts_lo = (lane == nts) ? (int)(unsigned)_c : ts_lo; ts_hi = (lane == nts) ? (int)(unsigned)(_c >> 32) : ts_hi; ++nts; } } while (0)
    PG8_STAMP();
    unsigned voffA[2], voffB[2];
#pragma unroll
    for (int i = 0; i < 2; ++i) { int R, C; stage_rc(tid * 16 + i * 8192, R, C); const int Rb = Epi::PERM ? ((R & ~31) + perm32(R & 31)) : R;
        voffA[i] = (unsigned)(R * K + C) * 2u; voffB[i] = (unsigned)(Rb * K + C) * 2u; }
    const size_t kstep = (size_t)(BK * 2);
    const size_t hstep = (size_t)HALF * K * 2;
    const size_t tstep = 2 * hstep;
    const unsigned ldsw = (unsigned)wid * 1024u;
    const int aoff = lds_byte(wr * 64 + fr, fq * 8), boff = lds_byte(wc * 32 + fr, fq * 8);
#define PG8_SA(b, h) (((b) * 2 + (h)) * HTB)
#define PG8_SB(b, h) ((4 + (b) * 2 + (h)) * HTB)
#define PG8_STAGE(bufoff, gbase, voff) do { _Pragma("unroll") for (int _i = 0; _i < 2; ++_i) \
        __builtin_amdgcn_global_load_lds((const unsigned*)((const char*)(gbase) + (voff)[_i]), (PG8_LAS unsigned*)(lds + (bufoff) + ldsw + _i * 8192), 16, 0, 0); } while (0)
#define PG8_LDA(dst, b, h) do { _Pragma("unroll") for (int m = 0; m < 4; ++m) _Pragma("unroll") for (int k = 0; k < 2; ++k) dst[m][k] = *(const PG8_LAS bf16x8*)(lds + PG8_SA(b, h) + aoff + m * 2048 + k * 1024); } while (0)
#define PG8_LDB(dst, b, h) do { _Pragma("unroll") for (int n = 0; n < 2; ++n) _Pragma("unroll") for (int k = 0; k < 2; ++k) dst[n][k] = *(const PG8_LAS bf16x8*)(lds + PG8_SB(b, h) + boff + n * 2048 + k * 1024); } while (0)
#define PG8_MMA(ai, bj, At, Bt) do { __builtin_amdgcn_s_setprio(1); _Pragma("unroll") for (int m = 0; m < 4; ++m) _Pragma("unroll") for (int n = 0; n < 2; ++n) _Pragma("unroll") for (int k = 0; k < 2; ++k) \
        acc[ai][bj][m][n] = __builtin_amdgcn_mfma_f32_16x16x32_bf16(Bt[n][k], At[m][k], acc[ai][bj][m][n], 0, 0, 0); __builtin_amdgcn_s_setprio(0); } while (0)
#define PG8_WAIT_V(n) asm volatile("s_waitcnt vmcnt(" #n ")" ::: "memory")
#define PG8_WAIT_L(n) asm volatile("s_waitcnt lgkmcnt(" #n ")" ::: "memory")
#define PG8_BAR __builtin_amdgcn_s_barrier()
#define PG8_SCHED __builtin_amdgcn_sched_barrier(0)
    Unit cur, nxt; int ui = 0;
    if (!S.next(0, cur)) return;
    f32x4 acc[2][2][4][2];
#pragma unroll
    for (int a = 0; a < 2; ++a)
#pragma unroll
        for (int b = 0; b < 2; ++b)
#pragma unroll
            for (int m = 0; m < 4; ++m)
#pragma unroll
                for (int n = 0; n < 2; ++n) acc[a][b][m][n] = (f32x4){0.f, 0.f, 0.f, 0.f};
    bf16x8 At[4][2], B0[2][2], B1[2][2];
    const char* cA = (const char*)g.A + (size_t)cur.pm * tstep; const char* cB = (const char*)g.Bt + (size_t)cur.pn * tstep;
    S.a_ready(cur);
    PG8_STAGE(PG8_SB(0, 0), cB, voffB); PG8_STAGE(PG8_SA(0, 0), cA, voffA); PG8_STAGE(PG8_SB(0, 1), cB + hstep, voffB); PG8_STAGE(PG8_SA(0, 1), cA + hstep, voffA);
    if (wr == 1) PG8_BAR;
    PG8_WAIT_V(4); PG8_BAR;
    PG8_STAGE(PG8_SB(1, 0), cB + kstep, voffB); PG8_STAGE(PG8_SA(1, 0), cA + kstep, voffA); PG8_STAGE(PG8_SB(1, 1), cB + hstep + kstep, voffB);
    PG8_WAIT_V(6); PG8_BAR;
    PG8_STAMP();
    for (;;) {
        const bool has_next = S.next(ui + 1, nxt);
        const char* nA = has_next ? (const char*)g.A + (size_t)nxt.pm * tstep : cA; const char* nB = has_next ? (const char*)g.Bt + (size_t)nxt.pn * tstep : cB;
        for (int t = 0; t < nt; t += 2) {
            const bool last = (t == nt - 2);
            const char* a1 = cA + (size_t)(t + 1) * kstep;
            const char* a2 = last ? nA : cA + (size_t)(t + 2) * kstep; const char* b2 = last ? nB : cB + (size_t)(t + 2) * kstep;
            const char* a3 = a2 + kstep; const char* b3 = b2 + kstep;
            if (last && has_next) S.a_ready(nxt);
            PG8_LDB(B0, 0, 0); PG8_SCHED; PG8_LDA(At, 0, 0); PG8_STAGE(PG8_SA(1, 1), a1 + hstep, voffA);
            PG8_WAIT_L(8); PG8_BAR; PG8_WAIT_L(0); PG8_MMA(0, 0, At, B0); PG8_BAR; PG8_SCHED;
            PG8_LDB(B1, 0, 1); PG8_STAGE(PG8_SB(0, 0), b2, voffB);
            PG8_BAR; PG8_WAIT_L(0); PG8_MMA(0, 1, At, B1); PG8_BAR;
            PG8_LDA(At, 0, 1); PG8_STAGE(PG8_SA(0, 0), a2, voffA);
            PG8_BAR; PG8_WAIT_L(0); PG8_MMA(1, 0, At, B0); PG8_BAR; PG8_SCHED;
            PG8_STAGE(PG8_SB(0, 1), b2 + hstep, voffB);
            PG8_WAIT_V(6); PG8_BAR; PG8_MMA(1, 1, At, B1); PG8_BAR;
            PG8_LDB(B0, 1, 0); PG8_SCHED; PG8_LDA(At, 1, 0); PG8_STAGE(PG8_SA(0, 1), a2 + hstep, voffA);
            PG8_WAIT_L(8); PG8_BAR; PG8_WAIT_L(0); PG8_MMA(0, 0, At, B0); PG8_BAR; PG8_SCHED;
            PG8_LDB(B1, 1, 1); PG8_STAGE(PG8_SB(1, 0), b3, voffB);
            PG8_BAR; PG8_WAIT_L(0); PG8_MMA(0, 1, At, B1); PG8_BAR;
            PG8_LDA(At, 1, 1); PG8_STAGE(PG8_SA(1, 0), a3, voffA);
            PG8_BAR; PG8_WAIT_L(0); PG8_MMA(1, 0, At, B0); PG8_BAR; PG8_SCHED;
            PG8_STAGE(PG8_SB(1, 1), b3 + hstep, voffB);
            PG8_WAIT_V(6); PG8_BAR; PG8_MMA(1, 1, At, B1); PG8_BAR;
        }
        PG8_STAMP();
        if constexpr (!Epi::AFTER_DRAIN) { E(acc, cur, wr, wc, fr, fq); S.done(cur); }
        PG8_STAMP();
        if (!has_next) break;
#pragma unroll
        for (int a = 0; a < 2; ++a)
#pragma unroll
            for (int b = 0; b < 2; ++b)
#pragma unroll
                for (int m = 0; m < 4; ++m)
#pragma unroll
                    for (int n = 0; n < 2; ++n) acc[a][b][m][n] = (f32x4){0.f, 0.f, 0.f, 0.f};
        cur = nxt; cA = nA; cB = nB; ++ui;
    }
    PG8_WAIT_V(0);
    if (wr == 0) PG8_BAR;
    PG8_BAR;
    if constexpr (Epi::AFTER_DRAIN) { E.fused(acc, cur, wr, wc, fr, fq, lds, wid, lane); S.done(cur); }
    PG8_STAMP();
    if (STAMP && wid == 0) { stamps[lane] = lane < nts ? (((unsigned long long)(unsigned)ts_hi << 32) | (unsigned)ts_lo) : 0ull;
        if (lane == 62) stamps[62] = rt_entry; if (lane == 63) stamps[63] = (unsigned long long)wall_clock64(); }
#undef PG8_STAMP
#undef PG8_SA
#undef PG8_SB
#undef PG8_STAGE
#undef PG8_LDA
#undef PG8_LDB
#undef PG8_MMA
#undef PG8_WAIT_V
#undef PG8_WAIT_L
#undef PG8_BAR
#undef PG8_SCHED
}
}

using pg8::bf16_t; using pg8::bf16x8; using pg8::f32x4; using pg8::u32x4;
#define DI __device__ __forceinline__
constexpr int D = 2048, NBATCH = 4, SEQ = 4096, CTXL = 256;
constexpr int TL = NBATCH * SEQ, TC = NBATCH * CTXL, T = TL + TC;
constexpr int NIN = 7232, NINP = 7424, NU = 7168, DFF = 5632, NUP = 2 * DFF, NMOD = 12288;
constexpr float EPS = 1e-5f, ALPHA = 1.41421356237309515f;
constexpr int U_MQ = 0, U_MK = 512, U_MV = 1024, U_MO = 1536, U_SZ = 2048, U_XBC = 2560, U_RQ = 3584, U_RK = 4096, U_RV = 4608, U_RG = 5120,
              U_GQ = 5632, U_GK = 5888, U_GV = 6144, U_GG = 6656;
constexpr size_t al256(size_t x) { return (x + 255) & ~(size_t)255; }
constexpr size_t WS_WIN = 0;
constexpr size_t WS_WOUT = WS_WIN + al256((size_t)NINP * D * 2);
constexpr size_t WS_WUP = WS_WOUT + al256((size_t)D * D * 2);
constexpr size_t WS_WDN = WS_WUP + al256((size_t)NUP * D * 2);
constexpr size_t WS_MOD = WS_WDN + al256((size_t)D * DFF * 2);
constexpr size_t WS_XC = WS_MOD + al256((size_t)2 * 5 * NMOD * 4);
constexpr size_t WS_H = WS_XC + al256((size_t)TC * D * 4);
constexpr size_t WS_U = WS_H + al256((size_t)T * D * 2);
constexpr size_t WS_GATES = WS_U + al256((size_t)T * NU * 2);
constexpr size_t WS_XBC = WS_GATES + al256((size_t)T * 64 * 4);
constexpr size_t WS_GL = WS_XBC + al256((size_t)T * 1024 * 2);
constexpr size_t WS_LA = WS_GL + al256((size_t)2 * 16 * T * 8);
constexpr size_t WS_YS = WS_LA + al256((size_t)2 * T * 256 * 4);
constexpr size_t WS_DEN = WS_YS + al256((size_t)2 * T * D * 2);
constexpr size_t WS_END = WS_DEN + al256((size_t)2 * T * 4 * 4);
constexpr int LDS_BYTES = 131072;
constexpr int NPHASE = 20;

struct KP { const float* in[26]; float* out; unsigned char* ws; int ph_lo, ph_hi; };
enum { I_X = 0, I_C, I_CTX, I_CCTX, I_ADAW, I_ADAB, I_WIN, I_MIGB, I_MFGB, I_MNORM, I_SCONVW, I_SCONVB, I_SDTB, I_SALOG, I_SD, I_SNORM, I_RDECAY, I_RNORM,
       I_GGW, I_GGB, I_GNORM, I_WOUT, I_POSTG, I_POSTB, I_WUP, I_WDN };

DI int otid() { int t = threadIdx.x; asm volatile("" : "+v"(t)); return t; }
DI float bf2f(unsigned short h) { return __uint_as_float(((unsigned)h) << 16); }
DI unsigned short f2bf(float f) { unsigned u = __float_as_uint(f); u += 0x7fffu + ((u >> 16) & 1u); return (unsigned short)(u >> 16); }
DI unsigned pk2(float lo, float hi) { return (unsigned)f2bf(lo) | ((unsigned)f2bf(hi) << 16); }
DI float silu_f(float x) { return x / (1.f + __expf(-x)); }
DI float sigmoid_f(float x) { return 1.f / (1.f + __expf(-x)); }
DI float softplus_f(float x) { return fmaxf(x, 0.f) + log1pf(__expf(-fabsf(x))); }
DI float logsigmoid_f(float x) { return fminf(x, 0.f) - log1pf(__expf(-fabsf(x))); }
DI float wave_sum(float v) {
#pragma unroll
    for (int m = 32; m >= 1; m >>= 1) v += __shfl_xor(v, m);
    return v;
}
DI float* xrow_ptr(const KP& p, int row) { return row < TL ? p.out + (size_t)row * D : (float*)(p.ws + WS_XC) + (size_t)(row - TL) * D; }
DI int modidx(int row) { return row < TL ? (row >> 12) : 4; }
DI int scan_row(int b, int d, int s) { if (s < CTXL) { const int t = d ? CTXL - 1 - s : s; return TL + b * CTXL + t; } int t = s - CTXL; t = d ? SEQ - 1 - t : t; return b * SEQ + t; }

template <int KIND> DI int srccol(int n) {
    if (KIND == 0) {
        if (n < 2048) return n;
        if (n < 3584) return n + 16;
        if (n < 7168) return n + 32;
        if (n < 7184) return 2048 + (n - 7168);
        if (n < 7200) return 3600 + (n - 7184);
        if (n < 7232) return n;
        return -1;
    }
    if (KIND == 2) { const int pn = n >> 8, bj = (n >> 7) & 1, cl = n & 127; return bj * DFF + pn * 128 + cl; }
    return n;
}
template <int KIND> DI void conv_tile(const float* __restrict__ W, int Nsrc, bf16_t* __restrict__ dst, int Kd, int n0, int k0, float* tile) {
    const int tid = otid();
    {
        const int r = tid >> 4, c4 = (tid & 15) * 4;
        const int sc = srccol<KIND>(n0 + c4);
#pragma unroll
        for (int i = 0; i < 2; ++i) {
            const int k = r + 32 * i;
            float4 v = make_float4(0.f, 0.f, 0.f, 0.f);
            if (sc >= 0) v = *(const float4*)(W + (size_t)(k0 + k) * Nsrc + sc);
            float* t = tile + k * 65 + c4; t[0] = v.x; t[1] = v.y; t[2] = v.z; t[3] = v.w;
        }
    }
    __syncthreads();
    {
        const int n = tid >> 3, ks = (tid & 7) * 8;
        float f[8];
#pragma unroll
        for (int j = 0; j < 8; ++j) f[j] = tile[(ks + j) * 65 + n];
        uint4 w; w.x = pk2(f[0], f[1]); w.y = pk2(f[2], f[3]); w.z = pk2(f[4], f[5]); w.w = pk2(f[6], f[7]);
        *(uint4*)(dst + (size_t)(n0 + n) * Kd + k0 + ks) = w;
    }
    __syncthreads();
}
__device__ void convert_weights(const KP& p, int l, unsigned char* smem) {
    float* tile = (float*)smem;
    constexpr int T0 = (NINP / 64) * (D / 64), T1 = (D / 64) * (D / 64), T2 = (NUP / 64) * (D / 64), T3 = (D / 64) * (DFF / 64);
    for (int t = blockIdx.x; t < T0 + T1 + T2 + T3; t += gridDim.x) {
        if (t < T0) { const int tn = t / (D / 64), tk = t % (D / 64); conv_tile<0>(p.in[I_WIN] + (size_t)l * D * NIN, NIN, (bf16_t*)(p.ws + WS_WIN), D, tn * 64, tk * 64, tile); }
        else if (t < T0 + T1) { const int u = t - T0, tn = u / (D / 64), tk = u % (D / 64); conv_tile<1>(p.in[I_WOUT] + (size_t)l * D * D, D, (bf16_t*)(p.ws + WS_WOUT), D, tn * 64, tk * 64, tile); }
        else if (t < T0 + T1 + T2) { const int u = t - T0 - T1, tn = u / (D / 64), tk = u % (D / 64); conv_tile<2>(p.in[I_WUP] + (size_t)l * D * NUP, NUP, (bf16_t*)(p.ws + WS_WUP), D, tn * 64, tk * 64, tile); }
        else { const int u = t - T0 - T1 - T2, tn = u / (DFF / 64), tk = u % (DFF / 64); conv_tile<3>(p.in[I_WDN] + (size_t)l * DFF * D, D, (bf16_t*)(p.ws + WS_WDN), DFF, tn * 64, tk * 64, tile); }
    }
}

__device__ void phase_init(const KP& p, unsigned char* smem) {
    const int tid = otid(), bid = blockIdx.x, nb = gridDim.x;
    float* sil = (float*)smem;
    float* red = sil + 5 * 2048;
    for (int i = tid; i < 5 * 2048; i += 512) { const int r = i >> 11, k = i & 2047; const float v = r < 4 ? p.in[I_C][r * 2048 + k] : p.in[I_CCTX][k]; sil[i] = silu_f(v); }
    __syncthreads();
    float* mod = (float*)(p.ws + WS_MOD);
    for (int chunk = bid; chunk < 256; chunk += nb) {
        const int l = chunk >> 7, n0 = (chunk & 127) * 96;
        const float* W = p.in[I_ADAW] + (size_t)l * D * NMOD;
        const int kp = tid >> 5, cc = tid & 31;
        float acc[3][5];
#pragma unroll
        for (int j = 0; j < 3; ++j)
#pragma unroll
            for (int r = 0; r < 5; ++r) acc[j][r] = 0.f;
        for (int k = kp; k < D; k += 16) {
            const float* wr = W + (size_t)k * NMOD + n0 + cc;
            const float w0 = wr[0], w1 = wr[32], w2 = wr[64];
#pragma unroll
            for (int r = 0; r < 5; ++r) { const float s = sil[r * 2048 + k]; acc[0][r] += s * w0; acc[1][r] += s * w1; acc[2][r] += s * w2; }
        }
#pragma unroll
        for (int j = 0; j < 3; ++j)
#pragma unroll
            for (int r = 0; r < 5; ++r) red[(kp * 96 + j * 32 + cc) * 5 + r] = acc[j][r];
        __syncthreads();
        if (tid < 480) {
            const int col = tid / 5, r = tid % 5; float s = 0.f;
#pragma unroll
            for (int k2 = 0; k2 < 16; ++k2) s += red[(k2 * 96 + col) * 5 + r];
            mod[(size_t)(l * 5 + r) * NMOD + n0 + col] = s + p.in[I_ADAB][l * NMOD + n0 + col];
        }
        __syncthreads();
    }
    convert_weights(p, 0, smem);
    {
        const float4* xs = (const float4*)p.in[I_X]; float4* xd = (float4*)p.out;
        const size_t n4 = (size_t)TL * D / 4;
        for (size_t i = (size_t)bid * 512 + tid; i < n4; i += (size_t)nb * 512) xd[i] = xs[i];
        const float4* cs = (const float4*)p.in[I_CTX]; float4* cd = (float4*)(p.ws + WS_XC);
        const size_t c4 = (size_t)TC * D / 4;
        for (size_t i = (size_t)bid * 512 + tid; i < c4; i += (size_t)nb * 512) cd[i] = cs[i];
    }
}

DI void ln_stats(const float4 (&v)[8], float& mean, float& rstd) {
    float s = 0.f;
#pragma unroll
    for (int i = 0; i < 8; ++i) s += (v[i].x + v[i].y) + (v[i].z + v[i].w);
    s = wave_sum(s); mean = s * (1.f / D);
    float q = 0.f;
#pragma unroll
    for (int i = 0; i < 8; ++i) { const float a = v[i].x - mean, b = v[i].y - mean, c = v[i].z - mean, d = v[i].w - mean; q += (a * a + b * b) + (c * c + d * d); }
    q = wave_sum(q); rstd = rsqrtf(q * (1.f / D) + EPS);
}
template <bool FIRST, bool MOD>
__device__ void phase_row(const KP& p, int Mrows, const float* pg, const float* pb, const float* modl  , int shoff, int scoff) {
    const int tid = otid(); const int lane = tid & 63, wid = tid >> 6;
    bf16_t* H = (bf16_t*)(p.ws + WS_H);
    for (int row = blockIdx.x * 8 + wid; row < Mrows; row += gridDim.x * 8) {
        float* xr = xrow_ptr(p, row);
        float4 v[8];
#pragma unroll
        for (int i = 0; i < 8; ++i) v[i] = ((const float4*)xr)[i * 64 + lane];
        float mean, rstd;
        if (FIRST) {
            ln_stats(v, mean, rstd);
#pragma unroll
            for (int i = 0; i < 8; ++i) {
                const float4 g = ((const float4*)pg)[i * 64 + lane], b = ((const float4*)pb)[i * 64 + lane];
                v[i].x = (v[i].x - mean) * rstd * g.x + b.x; v[i].y = (v[i].y - mean) * rstd * g.y + b.y;
                v[i].z = (v[i].z - mean) * rstd * g.z + b.z; v[i].w = (v[i].w - mean) * rstd * g.w + b.w;
                ((float4*)xr)[i * 64 + lane] = v[i];
            }
        }
        if (MOD) {
            ln_stats(v, mean, rstd);
            const float* mb = modl + (size_t)modidx(row) * NMOD;
#pragma unroll
            for (int i = 0; i < 8; ++i) {
                const float4 sh = ((const float4*)(mb + shoff))[i * 64 + lane], sc = ((const float4*)(mb + scoff))[i * 64 + lane];
                uint2 w;
                w.x = pk2((v[i].x - mean) * rstd * (1.f + sc.x) + sh.x, (v[i].y - mean) * rstd * (1.f + sc.y) + sh.y);
                w.y = pk2((v[i].z - mean) * rstd * (1.f + sc.z) + sh.z, (v[i].w - mean) * rstd * (1.f + sc.w) + sh.w);
                ((uint2*)(H + (size_t)row * D))[i * 64 + lane] = w;
            }
        }
    }
}

struct EpiAll {
    static constexpr bool PERM = true, AFTER_DRAIN = false;
    int kind; bf16_t* O; float* G; float* xl; float* xc; const float* gmod;
    DI void operator()(const f32x4 (&acc)[2][2][4][2], const pg8::Unit& u, int wr, int wc, int fr, int fq) const {
        const int row0 = u.pm * 256 + wr * 64 + fr;
        if (kind == 0) {
            if (u.pn < 28) {
                const int col0 = u.pn * 256 + wc * 32 + 8 * fq;
#pragma unroll
                for (int ai = 0; ai < 2; ++ai)
#pragma unroll
                    for (int m = 0; m < 4; ++m) {
                        bf16_t* rowp = O + (size_t)(row0 + ai * 128 + m * 16) * NU + col0;
#pragma unroll
                        for (int bj = 0; bj < 2; ++bj) {
                            const f32x4 v0 = acc[ai][bj][m][0], v1 = acc[ai][bj][m][1];
                            u32x4 w; w.x = pg8::cvt_pk_bf16(v0[0], v0[1]); w.y = pg8::cvt_pk_bf16(v0[2], v0[3]); w.z = pg8::cvt_pk_bf16(v1[0], v1[1]); w.w = pg8::cvt_pk_bf16(v1[2], v1[3]);
                            *(u32x4*)(rowp + bj * 128) = w;
                        }
                    }
            } else if (wc < 2) {
                const int col0 = wc * 32 + 8 * fq;
#pragma unroll
                for (int ai = 0; ai < 2; ++ai)
#pragma unroll
                    for (int m = 0; m < 4; ++m) {
                        float* rowp = G + (size_t)(row0 + ai * 128 + m * 16) * 64 + col0;
                        *(f32x4*)rowp = acc[ai][0][m][0]; *(f32x4*)(rowp + 4) = acc[ai][0][m][1];
                    }
            }
        } else if (kind == 1) {
            const int col0 = u.pn * 256 + wc * 32 + 8 * fq;
            const int mi = u.pm < 64 ? (u.pm >> 4) : 4;
            const float* gp = gmod + (size_t)mi * NMOD + col0;
            f32x4 gv[2][2];
#pragma unroll
            for (int bj = 0; bj < 2; ++bj)
#pragma unroll
                for (int n = 0; n < 2; ++n) gv[bj][n] = *(const f32x4*)(gp + bj * 128 + n * 4);
#pragma unroll
            for (int ai = 0; ai < 2; ++ai)
#pragma unroll
                for (int m = 0; m < 4; ++m) {
                    const int r = row0 + ai * 128 + m * 16;
                    float* rowp = (r < TL ? xl + (size_t)r * D : xc + (size_t)(r - TL) * D) + col0;
#pragma unroll
                    for (int bj = 0; bj < 2; ++bj)
#pragma unroll
                        for (int n = 0; n < 2; ++n) { f32x4* q = (f32x4*)(rowp + bj * 128 + n * 4); const f32x4 x = *q; *q = ALPHA * x + gv[bj][n] * acc[ai][bj][m][n]; }
                }
        } else {
            const int col0 = u.pn * 128 + wc * 32 + 8 * fq;
#pragma unroll
            for (int ai = 0; ai < 2; ++ai)
#pragma unroll
                for (int m = 0; m < 4; ++m) {
                    bf16_t* rowp = O + (size_t)(row0 + ai * 128 + m * 16) * DFF + col0;
                    f32x4 v0, v1;
#pragma unroll
                    for (int j = 0; j < 4; ++j) { v0[j] = silu_f(acc[ai][0][m][0][j]) * acc[ai][1][m][0][j]; v1[j] = silu_f(acc[ai][0][m][1][j]) * acc[ai][1][m][1][j]; }
                    u32x4 w; w.x = pg8::cvt_pk_bf16(v0[0], v0[1]); w.y = pg8::cvt_pk_bf16(v0[2], v0[3]); w.z = pg8::cvt_pk_bf16(v1[0], v1[1]); w.w = pg8::cvt_pk_bf16(v1[2], v1[3]);
                    *(u32x4*)rowp = w;
                }
        }
    }
};
template <class Epi> DI void run_gemm(unsigned char* smem, const bf16_t* A, const bf16_t* Bt, int M, int N, int K, const Epi& E) {
    pg8::Gemm g; g.A = A; g.Bt = Bt; g.M = M; g.N = N; g.K = K;
    pg8::StaticOrder S; S.init(M, N, gridDim.x, blockIdx.x);
    pg8::gemm_phase<Epi, pg8::StaticOrder, false>((PG8_LAS unsigned char*)smem, g, S, E, nullptr);
}

__device__ void phase_pre(const KP& p, int l) {
    const int tid = otid();
    bf16_t* U = (bf16_t*)(p.ws + WS_U);
    const float* G = (const float*)(p.ws + WS_GATES);
    bf16_t* X = (bf16_t*)(p.ws + WS_XBC);
    float2* GL = (float2*)(p.ws + WS_GL);
    float* LA = (float*)(p.ws + WS_LA);
    const int c0 = 2 * tid;
    const float* cw = p.in[I_SCONVW] + (size_t)l * 3 * 1024; const float* cb = p.in[I_SCONVB] + (size_t)l * 1024;
    const float w00 = cw[c0], w01 = cw[c0 + 1], w10 = cw[1024 + c0], w11 = cw[1024 + c0 + 1], w20 = cw[2048 + c0], w21 = cw[2048 + c0 + 1], b0 = cb[c0], b1 = cb[c0 + 1];
    const int pidx = tid & 255, rh = pidx >> 6, rhalf = (pidx >> 5) & 1, ri = pidx & 31;
    const int rcol = (tid < 256 ? U_RQ : U_RK) + rh * 128 + rhalf * 64 + ri;
    const float rscale = tid < 256 ? 1.f : 0.08838834764831845f;
    const float freq = exp2f(-(float)ri * (13.287712379549449f / 32.f));
    const int gd = tid >> 8, gch = tid & 255;
    float gw[16];
#pragma unroll
    for (int r = 0; r < 16; ++r) gw[r] = p.in[I_GGW][((size_t)(l * 2 + gd) * 16 + r) * 256 + gch];
    const float gb = p.in[I_GGB][(l * 2 + gd) * 256 + gch];
    for (int row = blockIdx.x; row < T; row += gridDim.x) {
        int t, L; if (row < TL) { t = row & (SEQ - 1); L = SEQ; } else { t = (row - TL) & (CTXL - 1); L = CTXL; }
        {
            const bf16_t* up = U + (size_t)row * NU + U_XBC + c0;
            const unsigned x0 = *(const unsigned*)up;
            const unsigned xm = t > 0 ? *(const unsigned*)(up - NU) : 0u;
            const unsigned xp = t < L - 1 ? *(const unsigned*)(up + NU) : 0u;
            const float o0 = b0 + w00 * bf2f(xm & 0xffff) + w10 * bf2f(x0 & 0xffff) + w20 * bf2f(xp & 0xffff);
            const float o1 = b1 + w01 * bf2f(xm >> 16) + w11 * bf2f(x0 >> 16) + w21 * bf2f(xp >> 16);
            *(unsigned*)(X + (size_t)row * 1024 + c0) = pk2(silu_f(o0), silu_f(o1));
        }
        {
            bf16_t* q = U + (size_t)row * NU + rcol;
            float x1 = bf2f(q[0]), x2 = bf2f(q[32]);
            if (row < TL) {
                const float pos = (float)(rhalf ? (t & 63) : (t >> 6));
                float rev = pos * freq * 0.15915494309189535f; rev -= floorf(rev);
                const float sn = __builtin_amdgcn_sinf(rev), cs = __builtin_amdgcn_cosf(rev);
                const float y1 = x1 * cs - x2 * sn, y2 = x1 * sn + x2 * cs; x1 = y1; x2 = y2;
            }
            q[0] = f2bf(x1 * rscale); q[32] = f2bf(x2 * rscale);
        }
        const float* gr = G + (size_t)row * 64;
        if (tid < 32) {
            const int d = tid >> 4, slot = tid & 15; float loga, logw;
            if (slot < 4) {
                const int h = slot;
                logw = gr[d * 4 + h] + p.in[I_MIGB][(l * 2 + d) * 4 + h];
                loga = logsigmoid_f(gr[8 + d * 4 + h] + p.in[I_MFGB][(l * 2 + d) * 4 + h]);
            } else if (slot < 12) {
                const int h = slot - 4;
                const float dt = softplus_f(gr[16 + d * 8 + h] + p.in[I_SDTB][(l * 2 + d) * 8 + h]);
                loga = -dt * __expf(p.in[I_SALOG][(l * 2 + d) * 8 + h]); logw = __logf(dt);
            } else {
                const int h = slot - 12;
                loga = -__expf(p.in[I_RDECAY][(l * 2 + d) * 4 + h]); logw = 0.f;
            }
            GL[(size_t)(d * 16 + slot) * T + row] = make_float2(loga, logw);
        }
        {
            float x = gb;
#pragma unroll
            for (int r = 0; r < 16; ++r) x += gr[32 + gd * 16 + r] * gw[r];
            LA[((size_t)gd * T + row) * 256 + gch] = logsigmoid_f(x) * (1.f / 16.f);
        }
    }
}

template <int MIX>
__device__ void naive_scan(const KP& p, int b, int d, int blk) {
    constexpr int DK = MIX == 3 ? 64 : 128, KQ = DK / 4;
    const int tid = otid(), el = tid >> 2, kq = tid & 3, ec = blk * 128 + el;
    const bf16_t* U = (const bf16_t*)(p.ws + WS_U); const bf16_t* X = (const bf16_t*)(p.ws + WS_XBC);
    const bf16_t* src = U; int ld = NU, qoff = 0, koff = 0, voff = 0, slot = 0; float qs = 1.f;
    if (MIX == 0) { qoff = U_MQ + blk * 128; koff = U_MK + blk * 128; voff = U_MV + ec; slot = blk; qs = 0.08838834764831845f; }
    if (MIX == 1) { const int head = ec >> 6, grp = head >> 2; src = X; ld = 1024; qoff = 768 + grp * 128; koff = 512 + grp * 128; voff = ec; slot = 4 + head; }
    if (MIX == 2) { qoff = U_RQ + blk * 128; koff = U_RK + blk * 128; voff = U_RV + ec; slot = 12 + blk; }
    if (MIX == 3) { qoff = U_GQ + blk * 64; koff = U_GK + blk * 64; voff = U_GV + ec; qs = 0.125f; }
    qoff += kq * KQ; koff += kq * KQ;
    const float2* GL = (const float2*)(p.ws + WS_GL) + (size_t)(d * 16 + slot) * T;
    const float* LA = (const float*)(p.ws + WS_LA) + (size_t)d * T * 256 + blk * 64 + kq * 16;
    bf16_t* YS = (bf16_t*)(p.ws + WS_YS) + (size_t)d * T * D + MIX * 512 + ec;
    float* DEN = (float*)(p.ws + WS_DEN) + (size_t)d * T * 4 + blk;
    float S[KQ], nn[KQ];
#pragma unroll
    for (int i = 0; i < KQ; ++i) { S[i] = 0.f; nn[i] = 0.f; }
    for (int s = 0; s < CTXL + SEQ; ++s) {
        const int row = scan_row(b, d, s);
        const bf16_t* rp = src + (size_t)row * ld;
        bf16x8 qv[KQ / 8], kv[KQ / 8];
#pragma unroll
        for (int i = 0; i < KQ / 8; ++i) { qv[i] = *(const bf16x8*)(rp + qoff + i * 8); kv[i] = *(const bf16x8*)(rp + koff + i * 8); }
        const float v = bf2f(rp[voff]);
        float a = 1.f, wn = 1.f;
        if (MIX < 3) { const float2 g = GL[row]; a = __expf(g.x); wn = __expf(g.y); }
        const float w = wn * v;
        float la[16];
        if (MIX == 3) {
#pragma unroll
            for (int i = 0; i < 4; ++i) { const float4 t4 = *(const float4*)(LA + (size_t)row * 256 + i * 4); la[i * 4] = t4.x; la[i * 4 + 1] = t4.y; la[i * 4 + 2] = t4.z; la[i * 4 + 3] = t4.w; }
        }
        float dot = 0.f, dn = 0.f;
#pragma unroll
        for (int i = 0; i < KQ; ++i) {
            const float kf = bf2f((unsigned short)kv[i >> 3][i & 7]), qf = bf2f((unsigned short)qv[i >> 3][i & 7]);
            const float ai = MIX == 3 ? __expf(la[i & 15]) : a;
            S[i] = ai * S[i] + w * kf; dot += qf * S[i];
            if (MIX == 0) { nn[i] = a * nn[i] + wn * kf; dn += qf * nn[i]; }
        }
        dot += __shfl_xor(dot, 1); dot += __shfl_xor(dot, 2);
        if (MIX == 0) { dn += __shfl_xor(dn, 1); dn += __shfl_xor(dn, 2); }
        if (kq == 0) YS[(size_t)row * D] = f2bf(qs * dot);
        if (MIX == 0 && tid == 0) DEN[(size_t)row * 4] = qs * dn;
    }
}
__device__ void phase_scan_naive(const KP& p) {
    for (int item = blockIdx.x; item < 128; item += gridDim.x) {
        const int blk = item & 3, mix = (item >> 2) & 3, d = (item >> 4) & 1, b = item >> 5;
        if (mix == 0) naive_scan<0>(p, b, d, blk);
        else if (mix == 1) naive_scan<1>(p, b, d, blk);
        else if (mix == 2) naive_scan<2>(p, b, d, blk);
        else naive_scan<3>(p, b, d, blk);
    }
}

__device__ void phase_comb(const KP& p, int l, int Mrows) {
    const int tid = otid(); const int lane = tid & 63, wid = tid >> 6;
    const int mixer = lane >> 4, ec0 = (lane & 15) * 32;
    const bf16_t* U = (const bf16_t*)(p.ws + WS_U); const bf16_t* X = (const bf16_t*)(p.ws + WS_XBC);
    const bf16_t* YS = (const bf16_t*)(p.ws + WS_YS); const float* DEN = (const float*)(p.ws + WS_DEN);
    bf16_t* H = (bf16_t*)(p.ws + WS_H);
    const int gcol = (mixer == 0 ? U_MO : mixer == 1 ? U_SZ : mixer == 2 ? U_RG : U_GG) + ec0;
    const float* gain = (mixer == 0 ? p.in[I_MNORM] : mixer == 1 ? p.in[I_SNORM] : mixer == 2 ? p.in[I_RNORM] : p.in[I_GNORM]) + l * 512 + ec0;
    const float sd = p.in[I_SD][l * 8 + (ec0 >> 6)];
    for (int row = blockIdx.x * 8 + wid; row < Mrows; row += gridDim.x * 8) {
        float y[32], gt[32];
        const bf16_t* y0p = YS + (size_t)row * D + mixer * 512 + ec0; const bf16_t* y1p = y0p + (size_t)T * D;
        float s0 = 1.f, s1 = 1.f;
        if (mixer == 0) { const int h = (lane & 15) >> 2; s0 = 1.f / fmaxf(fabsf(DEN[(size_t)row * 4 + h]), 1.f); s1 = 1.f / fmaxf(fabsf(DEN[((size_t)T + row) * 4 + h]), 1.f); }
#pragma unroll
        for (int i = 0; i < 4; ++i) {
            const bf16x8 a = *(const bf16x8*)(y0p + i * 8), b = *(const bf16x8*)(y1p + i * 8), g = *(const bf16x8*)(U + (size_t)row * NU + gcol + i * 8);
#pragma unroll
            for (int j = 0; j < 8; ++j) {
                y[i * 8 + j] = bf2f((unsigned short)a[j]) * s0 + bf2f((unsigned short)b[j]) * s1;
                const float gv = bf2f((unsigned short)g[j]);
                gt[i * 8 + j] = mixer == 0 ? sigmoid_f(gv) : silu_f(gv);
            }
        }
        if (mixer == 1) {
#pragma unroll
            for (int i = 0; i < 4; ++i) {
                const bf16x8 xs = *(const bf16x8*)(X + (size_t)row * 1024 + ec0 + i * 8);
#pragma unroll
                for (int j = 0; j < 8; ++j) { y[i * 8 + j] = (y[i * 8 + j] + sd * bf2f((unsigned short)xs[j])) * gt[i * 8 + j]; gt[i * 8 + j] = 1.f; }
            }
        }
        float s = 0.f;
#pragma unroll
        for (int j = 0; j < 32; ++j) s += y[j];
        s += __shfl_xor(s, 1); s += __shfl_xor(s, 2);
        const float mean = (mixer == 0 || mixer == 2) ? s * (1.f / 128.f) : 0.f;
        float q = 0.f;
#pragma unroll
        for (int j = 0; j < 32; ++j) { y[j] -= mean; q += y[j] * y[j]; }
        q += __shfl_xor(q, 1); q += __shfl_xor(q, 2);
        float q16 = q; q16 += __shfl_xor(q16, 4); q16 += __shfl_xor(q16, 8);
        const float rstd = rsqrtf((mixer == 1 ? q16 * (1.f / 512.f) : q * (1.f / 128.f)) + EPS);
        bf16_t* op = H + (size_t)row * D + mixer * 512 + ec0;
#pragma unroll
        for (int i = 0; i < 4; ++i) {
            const float4 g0 = *(const float4*)(gain + i * 8), g1 = *(const float4*)(gain + i * 8 + 4);
            uint4 w;
            w.x = pk2(y[i * 8 + 0] * rstd * g0.x * gt[i * 8 + 0], y[i * 8 + 1] * rstd * g0.y * gt[i * 8 + 1]);
            w.y = pk2(y[i * 8 + 2] * rstd * g0.z * gt[i * 8 + 2], y[i * 8 + 3] * rstd * g0.w * gt[i * 8 + 3]);
            w.z = pk2(y[i * 8 + 4] * rstd * g1.x * gt[i * 8 + 4], y[i * 8 + 5] * rstd * g1.y * gt[i * 8 + 5]);
            w.w = pk2(y[i * 8 + 6] * rstd * g1.z * gt[i * 8 + 6], y[i * 8 + 7] * rstd * g1.w * gt[i * 8 + 7]);
            *(uint4*)(op + i * 8) = w;
        }
    }
}

__device__ void run_phase(const KP& p, int ph, unsigned char* smem) {
    const float* mod = (const float*)(p.ws + WS_MOD);
    if (ph == 0) { phase_init(p, smem); return; }
    if (ph == 1) { phase_row<false, true>(p, T, nullptr, nullptr, mod, 0, 2048); return; }
    const int l = (ph - 2) / 9, k = (ph - 2) % 9;
    const bool last = l == 1;
    const int Mrows = last ? TL : T;
    const float* modl = mod + (size_t)l * 5 * NMOD;
    bf16_t* H = (bf16_t*)(p.ws + WS_H); bf16_t* U = (bf16_t*)(p.ws + WS_U);
    if (k == 0 || k == 4 || k == 6 || k == 7) {
        EpiAll E; E.kind = k == 0 ? 0 : (k == 6 ? 2 : 1); E.O = U; E.G = (float*)(p.ws + WS_GATES); E.xl = p.out; E.xc = (float*)(p.ws + WS_XC); E.gmod = modl + (k == 4 ? 4096 : 10240);
        const bf16_t* A = k == 7 ? U : H;
        const bf16_t* Bt = (const bf16_t*)(p.ws + (k == 0 ? WS_WIN : k == 4 ? WS_WOUT : k == 6 ? WS_WUP : WS_WDN));
        const int M = k == 0 ? T : Mrows, N = k == 0 ? NINP : (k == 6 ? NUP : D), K = k == 7 ? DFF : D;
        run_gemm(smem, A, Bt, M, N, K, E);
        return;
    }
    switch (k) {
    case 1: phase_pre(p, l); break;
    case 2: phase_scan_naive(p); break;
    case 3: phase_comb(p, l, Mrows); break;
    case 5: phase_row<true, true>(p, Mrows, p.in[I_POSTG] + (size_t)(l * 2 + 0) * D, p.in[I_POSTB] + (size_t)(l * 2 + 0) * D, modl, 6144, 8192); break;
    case 8:
        if (!last) { phase_row<true, true>(p, T, p.in[I_POSTG] + (size_t)(l * 2 + 1) * D, p.in[I_POSTB] + (size_t)(l * 2 + 1) * D, modl + 5 * NMOD, 0, 2048); convert_weights(p, l + 1, smem); }
        else phase_row<true, false>(p, TL, p.in[I_POSTG] + (size_t)(l * 2 + 1) * D, p.in[I_POSTB] + (size_t)(l * 2 + 1) * D, modl, 0, 0);
        break;
    }
}

__global__ void __launch_bounds__(512, 2) mega(KP p) {
    extern __shared__ __attribute__((aligned(16))) unsigned char smem[];
    cg::grid_group grid = cg::this_grid();
    for (int ph = p.ph_lo; ph < p.ph_hi; ++ph) {
        run_phase(p, ph, smem);
        if (ph + 1 < p.ph_hi) grid.sync();
    }
}

#ifndef ONE_LAUNCH
#define ONE_LAUNCH 1
#endif
extern "C" void kernel_launch(void* const* d_in, const int* in_sizes, int n_in, void* d_out, int out_size, void* d_ws, size_t ws_size, hipStream_t stream) {
    static int grid = 0;
    if (grid == 0) {
        if (n_in != 26 || out_size != TL * D || ws_size < WS_END) { fprintf(stderr, "kernel_launch: unexpected shapes (n_in %d out %d ws %zu need %zu)\n", n_in, out_size, ws_size, (size_t)WS_END); grid = -1; return; }
        int dev = 0, cus = 0, per_cu = 0;
        hipGetDevice(&dev); hipDeviceGetAttribute(&cus, hipDeviceAttributeMultiprocessorCount, dev);
        if (hipFuncSetAttribute((const void*)mega, hipFuncAttributeMaxDynamicSharedMemorySize, LDS_BYTES) != hipSuccess) { fprintf(stderr, "kernel_launch: hipFuncSetAttribute failed\n"); grid = -1; return; }
        if (hipOccupancyMaxActiveBlocksPerMultiprocessor(&per_cu, (const void*)mega, 512, LDS_BYTES) != hipSuccess || per_cu < 1) { fprintf(stderr, "kernel_launch: occupancy query gives %d\n", per_cu); per_cu = 1; }
        (void)hipGetLastError();
        grid = cus;
    }
    if (grid < 0) return;
    KP p{};
    for (int i = 0; i < 26; ++i) p.in[i] = (const float*)d_in[i];
    p.out = (float*)d_out; p.ws = (unsigned char*)d_ws;
#if ONE_LAUNCH
    p.ph_lo = 0; p.ph_hi = NPHASE;
    void* args[] = {&p};
    hipError_t e = hipLaunchCooperativeKernel((const void*)mega, dim3(grid), dim3(512), args, LDS_BYTES, stream);
    if (e != hipSuccess) fprintf(stderr, "cooperative launch failed: %s (grid %d)\n", hipGetErrorString(e), grid);
#else
    for (int ph = 0; ph < NPHASE; ++ph) {
        p.ph_lo = ph; p.ph_hi = ph + 1;
        hipLaunchKernelGGL(mega, dim3(grid), dim3(512), LDS_BYTES, stream, p);
    }
#endif
}
```

```cpp
#include <hip/hip_runtime.h>
#include <hip/hip_cooperative_groups.h>
#include <cstdio>
namespace cg = cooperative_groups;
namespace pg8 {
#define PG8_LAS __attribute__((address_space(3)))
typedef unsigned short bf16_t;
typedef short bf16x8 __attribute__((ext_vector_type(8)));
typedef float f32x4 __attribute__((ext_vector_type(4)));
typedef unsigned u32x4 __attribute__((ext_vector_type(4)));
constexpr int BM = 256, BK = 64, HALF = 128, HTB = HALF * BK * 2  , STAGE_BYTES = 8 * HTB, NXCD = 8, WGM = 8;

__host__ __device__ __forceinline__ int lds_byte(int r, int c) { const int st = (r >> 4) * 2 + (c >> 5), rr = r & 15, cc = c & 31, ob = rr * 64 + cc * 2; return st * 1024 + (ob ^ (((ob >> 9) & 1) << 5)); }
__host__ __device__ __forceinline__ void stage_rc(int b, int& R, int& C) { const int st = b / 1024, sb = b % 1024, swz = sb ^ (((sb >> 9) & 1) << 5); R = (st >> 1) * 16 + swz / 64; C = (st & 1) * 32 + (swz % 64) / 2; }
__host__ __device__ __forceinline__ int perm32(int rho) { const int n = rho >> 4, i = rho & 15; return 8 * (i >> 2) + 4 * n + (i & 3); }

struct Unit { int pm, pn, ks; };
struct Gemm { const bf16_t* A; const bf16_t* Bt; int M, N, K, ld; };

struct StaticOrder {
    int nM, nN, nwg, G, c;
    __host__ __device__ void init(int M, int N, int G_, int c_) { nM = M / BM; nN = N / BM; nwg = nM * nN; G = G_; c = c_; }
    __host__ __device__ bool next(int i, Unit& u) const {
        const long L = (long)i * G + c; if (L >= nwg) return false;
        int wgid = (int)L; { const int q = nwg / NXCD, r = nwg % NXCD, xcd = wgid % NXCD, off = wgid / NXCD; wgid = (xcd < r ? xcd * (q + 1) : r * (q + 1) + (xcd - r) * q) + off; }
        const int nig = WGM * nN, gid = wgid / nig, fm = gid * WGM, gsz = (nM - fm) < WGM ? (nM - fm) : WGM;
        u.pm = fm + ((wgid % nig) % gsz); u.pn = (wgid % nig) / gsz; u.ks = 0; return true;
    }
    __device__ __forceinline__ void a_ready(const Unit&) const {}
    __device__ __forceinline__ void done(const Unit&) const {}
};
__device__ __forceinline__ unsigned cvt_pk_bf16(float lo, float hi) { unsigned r; asm volatile("v_cvt_pk_bf16_f32 %0, %1, %2" : "=v"(r) : "v"(lo), "v"(hi)); return r; }
template <class Epi, class Sched, bool STAMP = false>
__device__ __forceinline__ void gemm_phase(PG8_LAS unsigned char* lds, const Gemm g, const Sched& S, const Epi& E, unsigned long long* stamps) {
    int tid_ = threadIdx.x; asm volatile("" : "+v"(tid_)); const int tid = tid_, wid = __builtin_amdgcn_readfirstlane(tid >> 6), lane = tid & 63, wr = wid >> 2, wc = wid & 3, fr = lane & 15, fq = lane >> 4;
    const int K = g.ld, nt = g.K / BK; const size_t sstep = (size_t)g.K * 2;
    int ts_lo = 0, ts_hi = 0, nts = 0; const unsigned long long rt_entry = STAMP ? (unsigned long long)wall_clock64() : 0ull;
#define PG8_STAMP() do { if (STAMP && wid == 0 && nts < 64) { const unsigned long long _c = (unsigned long long)clock64(); \
        ts_lo = (lane == nts) ? (int)(unsigned)_c : ts_lo; ts_hi = (lane == nts) ? (int)(unsigned)(_c >> 32) : ts_hi; ++nts; } } while (0)
    PG8_STAMP();
    unsigned voffA[2], voffB[2];
#pragma unroll
    for (int i = 0; i < 2; ++i) { int R, C; stage_rc(tid * 16 + i * 8192, R, C); const int Rb = Epi::PERM ? ((R & ~31) + perm32(R & 31)) : R;
        voffA[i] = (unsigned)(R * K + C) * 2u; voffB[i] = (unsigned)(Rb * K + C) * 2u; }
    const size_t kstep = (size_t)(BK * 2);
    const size_t hstep = (size_t)HALF * K * 2;
    const size_t tstep = 2 * hstep;
    const unsigned ldsw = (unsigned)wid * 1024u;
    const int aoff = lds_byte(wr * 64 + fr, fq * 8), boff = lds_byte(wc * 32 + fr, fq * 8);
#define PG8_SA(b, h) (((b) * 2 + (h)) * HTB)
#define PG8_SB(b, h) ((4 + (b) * 2 + (h)) * HTB)
#define PG8_STAGE(bufoff, gbase, voff) do { _Pragma("unroll") for (int _i = 0; _i < 2; ++_i) \
        __builtin_amdgcn_global_load_lds((const unsigned*)((const char*)(gbase) + (voff)[_i]), (PG8_LAS unsigned*)(lds + (bufoff) + ldsw + _i * 8192), 16, 0, 0); } while (0)
#define PG8_LDA(dst, b, h) do { _Pragma("unroll") for (int m = 0; m < 4; ++m) _Pragma("unroll") for (int k = 0; k < 2; ++k) dst[m][k] = *(const PG8_LAS bf16x8*)(lds + PG8_SA(b, h) + aoff + m * 2048 + k * 1024); } while (0)
#define PG8_LDB(dst, b, h) do { _Pragma("unroll") for (int n = 0; n < 2; ++n) _Pragma("unroll") for (int k = 0; k < 2; ++k) dst[n][k] = *(const PG8_LAS bf16x8*)(lds + PG8_SB(b, h) + boff + n * 2048 + k * 1024); } while (0)
#define PG8_MMA(ai, bj, At, Bt) do { __builtin_amdgcn_s_setprio(1); _Pragma("unroll") for (int m = 0; m < 4; ++m) _Pragma("unroll") for (int n = 0; n < 2; ++n) _Pragma("unroll") for (int k = 0; k < 2; ++k) \
        acc[ai][bj][m][n] = __builtin_amdgcn_mfma_f32_16x16x32_bf16(Bt[n][k], At[m][k], acc[ai][bj][m][n], 0, 0, 0); __builtin_amdgcn_s_setprio(0); } while (0)
#define PG8_WAIT_V(n) asm volatile("s_waitcnt vmcnt(" #n ")" ::: "memory")
#define PG8_WAIT_L(n) asm volatile("s_waitcnt lgkmcnt(" #n ")" ::: "memory")
#define PG8_BAR __builtin_amdgcn_s_barrier()
#define PG8_SCHED __builtin_amdgcn_sched_barrier(0)
    Unit cur, nxt; int ui = 0;
    if (!S.next(0, cur)) return;
    f32x4 acc[2][2][4][2];
#pragma unroll
    for (int a = 0; a < 2; ++a)
#pragma unroll
        for (int b = 0; b < 2; ++b)
#pragma unroll
            for (int m = 0; m < 4; ++m)
#pragma unroll
                for (int n = 0; n < 2; ++n) acc[a][b][m][n] = (f32x4){0.f, 0.f, 0.f, 0.f};
    bf16x8 At[4][2], B0[2][2], B1[2][2];
    const char* cA = (const char*)g.A + (size_t)cur.pm * tstep + (size_t)cur.ks * sstep; const char* cB = (const char*)g.Bt + (size_t)cur.pn * tstep + (size_t)cur.ks * sstep;
    S.a_ready(cur);
    PG8_STAGE(PG8_SB(0, 0), cB, voffB); PG8_STAGE(PG8_SA(0, 0), cA, voffA); PG8_STAGE(PG8_SB(0, 1), cB + hstep, voffB); PG8_STAGE(PG8_SA(0, 1), cA + hstep, voffA);
    if (wr == 1) PG8_BAR;
    PG8_WAIT_V(4); PG8_BAR;
    PG8_STAGE(PG8_SB(1, 0), cB + kstep, voffB); PG8_STAGE(PG8_SA(1, 0), cA + kstep, voffA); PG8_STAGE(PG8_SB(1, 1), cB + hstep + kstep, voffB);
    PG8_WAIT_V(6); PG8_BAR;
    PG8_STAMP();
    for (;;) {
        const bool has_next = S.next(ui + 1, nxt);
        const char* nA = has_next ? (const char*)g.A + (size_t)nxt.pm * tstep + (size_t)nxt.ks * sstep : cA; const char* nB = has_next ? (const char*)g.Bt + (size_t)nxt.pn * tstep + (size_t)nxt.ks * sstep : cB;
        for (int t = 0; t < nt; t += 2) {
            const bool last = (t == nt - 2);
            const char* a1 = cA + (size_t)(t + 1) * kstep;
            const char* a2 = last ? nA : cA + (size_t)(t + 2) * kstep; const char* b2 = last ? nB : cB + (size_t)(t + 2) * kstep;
            const char* a3 = a2 + kstep; const char* b3 = b2 + kstep;
            if (last && has_next) S.a_ready(nxt);
            PG8_LDB(B0, 0, 0); PG8_SCHED; PG8_LDA(At, 0, 0); PG8_STAGE(PG8_SA(1, 1), a1 + hstep, voffA);
            PG8_WAIT_L(8); PG8_BAR; PG8_WAIT_L(0); PG8_MMA(0, 0, At, B0); PG8_BAR; PG8_SCHED;
            PG8_LDB(B1, 0, 1); PG8_STAGE(PG8_SB(0, 0), b2, voffB);
            PG8_BAR; PG8_WAIT_L(0); PG8_MMA(0, 1, At, B1); PG8_BAR;
            PG8_LDA(At, 0, 1); PG8_STAGE(PG8_SA(0, 0), a2, voffA);
            PG8_BAR; PG8_WAIT_L(0); PG8_MMA(1, 0, At, B0); PG8_BAR; PG8_SCHED;
            PG8_STAGE(PG8_SB(0, 1), b2 + hstep, voffB);
            PG8_WAIT_V(6); PG8_BAR; PG8_MMA(1, 1, At, B1); PG8_BAR;
            PG8_LDB(B0, 1, 0); PG8_SCHED; PG8_LDA(At, 1, 0); PG8_STAGE(PG8_SA(0, 1), a2 + hstep, voffA);
            PG8_WAIT_L(8); PG8_BAR; PG8_WAIT_L(0); PG8_MMA(0, 0, At, B0); PG8_BAR; PG8_SCHED;
            PG8_LDB(B1, 1, 1); PG8_STAGE(PG8_SB(1, 0), b3, voffB);
            PG8_BAR; PG8_WAIT_L(0); PG8_MMA(0, 1, At, B1); PG8_BAR;
            PG8_LDA(At, 1, 1); PG8_STAGE(PG8_SA(1, 0), a3, voffA);
            PG8_BAR; PG8_WAIT_L(0); PG8_MMA(1, 0, At, B0); PG8_BAR; PG8_SCHED;
            PG8_STAGE(PG8_SB(1, 1), b3 + hstep, voffB);
            PG8_WAIT_V(6); PG8_BAR; PG8_MMA(1, 1, At, B1); PG8_BAR;
        }
        PG8_STAMP();
        if constexpr (!Epi::AFTER_DRAIN) { E(acc, cur, wr, wc, fr, fq); S.done(cur); }
        PG8_STAMP();
        if (!has_next) break;
#pragma unroll
        for (int a = 0; a < 2; ++a)
#pragma unroll
            for (int b = 0; b < 2; ++b)
#pragma unroll
                for (int m = 0; m < 4; ++m)
#pragma unroll
                    for (int n = 0; n < 2; ++n) acc[a][b][m][n] = (f32x4){0.f, 0.f, 0.f, 0.f};
        cur = nxt; cA = nA; cB = nB; ++ui;
    }
    PG8_WAIT_V(0);
    if (wr == 0) PG8_BAR;
    PG8_BAR;
    if constexpr (Epi::AFTER_DRAIN) { E.fused(acc, cur, wr, wc, fr, fq, lds, wid, lane); S.done(cur); }
    PG8_STAMP();
    if (STAMP && wid == 0) { stamps[lane] = lane < nts ? (((unsigned long long)(unsigned)ts_hi << 32) | (unsigned)ts_lo) : 0ull;
        if (lane == 62) stamps[62] = rt_entry; if (lane == 63) stamps[63] = (unsigned long long)wall_clock64(); }
#undef PG8_STAMP
#undef PG8_SA
#undef PG8_SB
#undef PG8_STAGE
#undef PG8_LDA
#undef PG8_LDB
#undef PG8_MMA
#undef PG8_WAIT_V
#undef PG8_WAIT_L
#undef PG8_BAR
#undef PG8_SCHED
}
}

using pg8::bf16_t; using pg8::bf16x8; using pg8::f32x4; using pg8::u32x4;
#define DI __device__ __forceinline__
typedef unsigned u32x2 __attribute__((ext_vector_type(2)));
constexpr int D = 2048, NBATCH = 4, SEQ = 4096, CTXL = 256;
constexpr int TL = NBATCH * SEQ, TC = NBATCH * CTXL, T = TL + TC;
constexpr int NIN = 7232, NINP = 7424, NU = 7168, DFF = 5632, NUP = 2 * DFF, NMOD = 12288;
constexpr float EPS = 1e-5f, ALPHA = 1.41421356237309515f;
constexpr int U_MQ = 0, U_MK = 512, U_MV = 1024, U_MO = 1536, U_SZ = 2048, U_XBC = 2560, U_RQ = 3584, U_RK = 4096, U_RV = 4608, U_RG = 5120,
              U_GQ = 5632, U_GK = 5888, U_GV = 6144, U_GG = 6656;
constexpr size_t al256(size_t x) { return (x + 255) & ~(size_t)255; }
constexpr size_t WS_WIN = 0;
constexpr size_t WS_WOUT = WS_WIN + al256((size_t)NINP * D * 2);
constexpr size_t WS_WUP = WS_WOUT + al256((size_t)D * D * 2);
constexpr size_t WS_WDN = WS_WUP + al256((size_t)NUP * D * 2);
constexpr size_t WS_MOD = WS_WDN + al256((size_t)D * DFF * 2);
constexpr size_t WS_XC = WS_MOD + al256((size_t)2 * 5 * NMOD * 4);
constexpr size_t WS_H = WS_XC + al256((size_t)TC * D * 4);
constexpr size_t WS_U = WS_H + al256((size_t)T * D * 2);
constexpr size_t WS_GATES = WS_U + al256((size_t)T * NU * 2);
constexpr size_t WS_XBC = WS_GATES + al256((size_t)T * 64 * 4);
constexpr size_t WS_GL = WS_XBC + al256((size_t)T * 1024 * 2);
constexpr size_t WS_LA = WS_GL + al256((size_t)2 * 16 * T * 8);
constexpr size_t WS_YS = WS_LA + al256((size_t)2 * T * 256 * 4);
constexpr size_t WS_DEN = WS_YS + al256((size_t)2 * T * D * 2);
constexpr size_t WS_QG = WS_DEN + al256((size_t)2 * T * 4 * 4);
constexpr size_t WS_KG = WS_QG + al256((size_t)2 * T * 256 * 2);
constexpr size_t WS_EE = WS_KG + al256((size_t)2 * T * 256 * 2);
constexpr size_t WS_BAR = WS_EE + al256((size_t)2 * (T / 64) * 256 * 4);
constexpr size_t WS_YC = WS_BAR + 256;
constexpr size_t WS_END = WS_YC;
constexpr int LDS_BYTES = 131072;
constexpr int NPHASE = 20;
#ifndef SCAN_MFMA
#define SCAN_MFMA 15
#endif

struct KP { const float* in[26]; float* out; unsigned char* ws; int ph_lo, ph_hi; };
enum { I_X = 0, I_C, I_CTX, I_CCTX, I_ADAW, I_ADAB, I_WIN, I_MIGB, I_MFGB, I_MNORM, I_SCONVW, I_SCONVB, I_SDTB, I_SALOG, I_SD, I_SNORM, I_RDECAY, I_RNORM,
       I_GGW, I_GGB, I_GNORM, I_WOUT, I_POSTG, I_POSTB, I_WUP, I_WDN };

DI int obid() { int b = blockIdx.x; asm volatile("" : "+s"(b)); return b; }
DI int ogdim() { int g = gridDim.x; asm volatile("" : "+s"(g)); return g; }
DI int otid() { int t = threadIdx.x; asm volatile("" : "+v"(t)); return t; }
DI float bf2f(unsigned short h) { return __uint_as_float(((unsigned)h) << 16); }
DI unsigned short f2bf(float f) { unsigned u = __float_as_uint(f); u += 0x7fffu + ((u >> 16) & 1u); return (unsigned short)(u >> 16); }
DI unsigned pk2(float lo, float hi) { return (unsigned)f2bf(lo) | ((unsigned)f2bf(hi) << 16); }
DI float silu_f(float x) { return x / (1.f + __expf(-x)); }
DI float sigmoid_f(float x) { return 1.f / (1.f + __expf(-x)); }
DI float softplus_f(float x) { return fmaxf(x, 0.f) + log1pf(__expf(-fabsf(x))); }
DI float logsigmoid_f(float x) { return fminf(x, 0.f) - log1pf(__expf(-fabsf(x))); }
DI float shx(float v, int m, int lane) { return __uint_as_float(__builtin_amdgcn_ds_bpermute((lane ^ m) << 2, __float_as_uint(v))); }
DI float wave_sum(float v, int lane) {
#pragma unroll
    for (int m = 32; m >= 1; m >>= 1) v += shx(v, m, lane);
    return v;
}
DI float* xrow_ptr(const KP& p, int row) { return row < TL ? p.out + (size_t)row * D : (float*)(p.ws + WS_XC) + (size_t)(row - TL) * D; }
DI const float* xin_ptr(const KP& p, int row) { return row < TL ? p.in[I_X] + (size_t)row * D : p.in[I_CTX] + (size_t)(row - TL) * D; }
DI int modidx(int row) { return row < TL ? (row >> 12) : 4; }
DI int scan_row(int b, int d, int s) { if (s < CTXL) { const int t = d ? CTXL - 1 - s : s; return TL + b * CTXL + t; } int t = s - CTXL; t = d ? SEQ - 1 - t : t; return b * SEQ + t; }

template <int KIND> DI int srccol(int n) {
    if (KIND == 0) {
        if (n < 2048) return n;
        if (n < 3584) return n + 16;
        if (n < 7168) return n + 32;
        if (n < 7184) return 2048 + (n - 7168);
        if (n < 7200) return 3600 + (n - 7184);
        if (n < 7232) return n;
        return -1;
    }
    if (KIND == 2) { const int pn = n >> 8, bj = (n >> 7) & 1, cl = n & 127; return bj * DFF + pn * 128 + cl; }
    return n;
}
constexpr int CT_IN = (NINP / 128) * (D / 64), CT_OUT = (D / 128) * (D / 64), CT_UP = (NUP / 128) * (D / 64), CT_DN = (D / 128) * (DFF / 64);
struct ConvTile { const float* W; bf16_t* dst; int Nsrc, Kd, n0, k0, kind; };
DI ConvTile conv_decode(const KP& p, int l, int t  ) {
    ConvTile c;
    if (t < CT_IN) { c.kind = 0; c.W = p.in[I_WIN] + (size_t)l * D * NIN; c.Nsrc = NIN; c.dst = (bf16_t*)(p.ws + WS_WIN); c.Kd = D; c.n0 = (t / (D / 64)) * 128; c.k0 = (t % (D / 64)) * 64; return c; }
    t -= CT_IN;
    if (t < CT_OUT) { c.kind = 1; c.W = p.in[I_WOUT] + (size_t)l * D * D; c.Nsrc = D; c.dst = (bf16_t*)(p.ws + WS_WOUT); c.Kd = D; c.n0 = (t / (D / 64)) * 128; c.k0 = (t % (D / 64)) * 64; return c; }
    t -= CT_OUT;
    if (t < CT_UP) { c.kind = 2; c.W = p.in[I_WUP] + (size_t)l * D * NUP; c.Nsrc = NUP; c.dst = (bf16_t*)(p.ws + WS_WUP); c.Kd = D; c.n0 = (t / (D / 64)) * 128; c.k0 = (t % (D / 64)) * 64; return c; }
    t -= CT_UP;
    c.kind = 3; c.W = p.in[I_WDN] + (size_t)l * DFF * D; c.Nsrc = D; c.dst = (bf16_t*)(p.ws + WS_WDN); c.Kd = DFF; c.n0 = (t / (DFF / 64)) * 128; c.k0 = (t % (DFF / 64)) * 64; return c;
}
DI int conv_srccol(int kind, int n) { return kind == 0 ? srccol<0>(n) : kind == 2 ? srccol<2>(n) : n; }
DI void conv_load(const ConvTile& c, int tid, f32x4 (&v)[4]) {
    const int r = tid >> 5, c4 = (tid & 31) * 4;
    const int sc = conv_srccol(c.kind, c.n0 + c4);
#pragma unroll
    for (int i = 0; i < 4; ++i) { v[i] = (f32x4){0.f, 0.f, 0.f, 0.f}; if (sc >= 0) v[i] = *(const f32x4*)(c.W + (size_t)(c.k0 + r + 16 * i) * c.Nsrc + sc); }
}
__device__ void convert_weights(const KP& p, int l, int t_lo, int t_hi, int w, int nw, unsigned char* smem) {
    float* tile = (float*)smem;
    const int tid = otid();
    int t = t_lo + w;
    if (t >= t_hi) return;
    ConvTile c = conv_decode(p, l, t);
    f32x4 v[4]; conv_load(c, tid, v);
    for (;;) {
        const int tn = t + nw; const bool more = tn < t_hi;
        ConvTile cn = c; f32x4 vn[4];
        if (more) { cn = conv_decode(p, l, tn); conv_load(cn, tid, vn); }
        {
            const int r = tid >> 5, c4 = (tid & 31) * 4;
#pragma unroll
            for (int i = 0; i < 4; ++i) { float* q = tile + (r + 16 * i) * 129 + c4; q[0] = v[i][0]; q[1] = v[i][1]; q[2] = v[i][2]; q[3] = v[i][3]; }
        }
        __syncthreads();
        {
            const int n = tid >> 2, ks = (tid & 3) * 16;
            float f[16];
#pragma unroll
            for (int j = 0; j < 16; ++j) f[j] = tile[(ks + j) * 129 + n];
            u32x4 w0, w1;
            w0.x = pk2(f[0], f[1]); w0.y = pk2(f[2], f[3]); w0.z = pk2(f[4], f[5]); w0.w = pk2(f[6], f[7]);
            w1.x = pk2(f[8], f[9]); w1.y = pk2(f[10], f[11]); w1.z = pk2(f[12], f[13]); w1.w = pk2(f[14], f[15]);
            bf16_t* q = c.dst + (size_t)(c.n0 + n) * c.Kd + c.k0 + ks;
            *(u32x4*)q = w0; *(u32x4*)(q + 8) = w1;
        }
        __syncthreads();
        if (!more) break;
        t = tn; c = cn;
#pragma unroll
        for (int i = 0; i < 4; ++i) v[i] = vn[i];
    }
}

__device__ void phase_init(const KP& p, unsigned char* smem) {
    const int tid = otid(), bid = obid(), nb = ogdim();
    float* sil = (float*)smem;
    float* red = sil + 5 * 2048;
    for (int i = tid; i < 5 * 2048; i += 512) { const int r = i >> 11, k = i & 2047; const float v = r < 4 ? p.in[I_C][r * 2048 + k] : p.in[I_CCTX][k]; sil[i] = silu_f(v); }
    __syncthreads();
    float* mod = (float*)(p.ws + WS_MOD);
    for (int chunk = bid; chunk < 256; chunk += nb) {
        const int l = chunk >> 7, n0 = (chunk & 127) * 96;
        const float* W = p.in[I_ADAW] + (size_t)l * D * NMOD;
        const int kp = tid >> 5, cc = tid & 31;
        float acc[3][5];
#pragma unroll
        for (int j = 0; j < 3; ++j)
#pragma unroll
            for (int r = 0; r < 5; ++r) acc[j][r] = 0.f;
#pragma unroll 8
        for (int k = kp; k < D; k += 16) {
            const float* wr = W + (size_t)k * NMOD + n0 + cc;
            const float w0 = wr[0], w1 = wr[32], w2 = wr[64];
#pragma unroll
            for (int r = 0; r < 5; ++r) { const float s = sil[r * 2048 + k]; acc[0][r] += s * w0; acc[1][r] += s * w1; acc[2][r] += s * w2; }
        }
#pragma unroll
        for (int j = 0; j < 3; ++j)
#pragma unroll
            for (int r = 0; r < 5; ++r) red[(kp * 96 + j * 32 + cc) * 5 + r] = acc[j][r];
        __syncthreads();
        if (tid < 480) {
            const int col = tid / 5, r = tid % 5; float s = 0.f;
#pragma unroll
            for (int k2 = 0; k2 < 16; ++k2) s += red[(k2 * 96 + col) * 5 + r];
            mod[(size_t)(l * 5 + r) * NMOD + n0 + col] = s + p.in[I_ADAB][l * NMOD + n0 + col];
        }
        __syncthreads();
    }
    convert_weights(p, 0, 0, CT_IN, bid, nb, smem);
}

DI void ln_stats(const f32x4 (&v)[8], int lane, float& mean, float& rstd) {
    float s = 0.f;
#pragma unroll
    for (int i = 0; i < 8; ++i) s += (v[i][0] + v[i][1]) + (v[i][2] + v[i][3]);
    s = wave_sum(s, lane); mean = s * (1.f / D);
    float q = 0.f;
#pragma unroll
    for (int i = 0; i < 8; ++i) { const f32x4 dd = v[i] - mean; q += (dd[0] * dd[0] + dd[1] * dd[1]) + (dd[2] * dd[2] + dd[3] * dd[3]); }
    q = wave_sum(q, lane); rstd = rsqrtf(q * (1.f / D) + EPS);
}
template <bool FIRST, bool MOD, bool FROM_INPUT>
DI void row_load(const KP& p, int row, int lane, const float* ycf, int nsplit, f32x4 (&v)[8], f32x4 (&y)[8]) {
    const float* xi = FROM_INPUT ? xin_ptr(p, row) : xrow_ptr(p, row);
#pragma unroll
    for (int i = 0; i < 8; ++i) v[i] = ((const f32x4*)xi)[i * 64 + lane];
    if (FIRST) {
        if (ycf != nullptr && row >= TL) {
            const float* yr = ycf + (size_t)(row - TL) * D;
#pragma unroll
            for (int i = 0; i < 8; ++i) y[i] = ((const f32x4*)yr)[i * 64 + lane];
            for (int sp = 1; sp < nsplit; ++sp) {
                yr += (size_t)TC * D;
#pragma unroll
                for (int i = 0; i < 8; ++i) y[i] += ((const f32x4*)yr)[i * 64 + lane];
            }
        } else {
            const bf16_t* yr = (const bf16_t*)(p.ws + WS_YS) + (size_t)row * D;
#pragma unroll
            for (int i = 0; i < 8; ++i) { const u32x2 t = ((const u32x2*)yr)[i * 64 + lane];
                y[i][0] = __uint_as_float(t[0] << 16); y[i][1] = __uint_as_float(t[0] & 0xffff0000u); y[i][2] = __uint_as_float(t[1] << 16); y[i][3] = __uint_as_float(t[1] & 0xffff0000u); }
        }
    }
}
template <bool FIRST, bool MOD>
DI void row_compute(const KP& p, int row, int lane, f32x4 (&v)[8], const f32x4 (&y)[8], const float* pg, const float* pb, const float* modl, int shoff, int scoff) {
    float mean, rstd;
    if (FIRST) {
        float* xr = xrow_ptr(p, row);
#pragma unroll
        for (int i = 0; i < 8; ++i) v[i] = ALPHA * v[i] + y[i];
        ln_stats(v, lane, mean, rstd);
#pragma unroll
        for (int i = 0; i < 8; ++i) {
            const f32x4 g = ((const f32x4*)pg)[i * 64 + lane], b = ((const f32x4*)pb)[i * 64 + lane];
            v[i] = (v[i] - mean) * rstd * g + b;
            ((f32x4*)xr)[i * 64 + lane] = v[i];
        }
    }
    if (MOD) {
        ln_stats(v, lane, mean, rstd);
        const float* mb = modl + (size_t)modidx(row) * NMOD;
        bf16_t* H = (bf16_t*)(p.ws + WS_H);
#pragma unroll
        for (int i = 0; i < 8; ++i) {
            const f32x4 sh = ((const f32x4*)(mb + shoff))[i * 64 + lane], sc = ((const f32x4*)(mb + scoff))[i * 64 + lane];
            const f32x4 o = (v[i] - mean) * rstd * (1.f + sc) + sh;
            u32x2 w; w[0] = pg8::cvt_pk_bf16(o[0], o[1]); w[1] = pg8::cvt_pk_bf16(o[2], o[3]);
            ((u32x2*)(H + (size_t)row * D))[i * 64 + lane] = w;
        }
    }
}
template <bool FIRST, bool MOD, bool FROM_INPUT = false>
__device__ void phase_row(const KP& p, int Mrows, const float* pg, const float* pb, const float* modl  , int shoff, int scoff, const float* ycf = nullptr, int nsplit = 0) {
    const int tid = otid(); const int lane = tid & 63, wid = tid >> 6;
    const int stride = ogdim() * 8;
    for (int row = obid() * 8 + wid; row < Mrows; row += 2 * stride) {
        const int row1 = row + stride; const bool has1 = row1 < Mrows;
        f32x4 v0[8], v1[8], y0[8], y1[8];
        row_load<FIRST, MOD, FROM_INPUT>(p, row, lane, ycf, nsplit, v0, y0);
        if (has1) row_load<FIRST, MOD, FROM_INPUT>(p, row1, lane, ycf, nsplit, v1, y1);
        row_compute<FIRST, MOD>(p, row, lane, v0, y0, pg, pb, modl, shoff, scoff);
        if (has1) row_compute<FIRST, MOD>(p, row1, lane, v1, y1, pg, pb, modl, shoff, scoff);
    }
}

struct EpiAll {
    static constexpr bool PERM = true, AFTER_DRAIN = false;
    int kind; bf16_t* O; float* G; const float* gmod;
    DI void operator()(const f32x4 (&acc)[2][2][4][2], const pg8::Unit& u, int wr, int wc, int fr, int fq) const {
        const int row0 = u.pm * 256 + wr * 64 + fr;
        if (kind == 0) {
            if (u.pn < 28) {
                const int col0 = u.pn * 256 + wc * 32 + 8 * fq;
#pragma unroll
                for (int ai = 0; ai < 2; ++ai)
#pragma unroll
                    for (int m = 0; m < 4; ++m) {
                        bf16_t* rowp = O + (size_t)(row0 + ai * 128 + m * 16) * NU + col0;
#pragma unroll
                        for (int bj = 0; bj < 2; ++bj) {
                            const f32x4 v0 = acc[ai][bj][m][0], v1 = acc[ai][bj][m][1];
                            u32x4 w; w.x = pg8::cvt_pk_bf16(v0[0], v0[1]); w.y = pg8::cvt_pk_bf16(v0[2], v0[3]); w.z = pg8::cvt_pk_bf16(v1[0], v1[1]); w.w = pg8::cvt_pk_bf16(v1[2], v1[3]);
                            *(u32x4*)(rowp + bj * 128) = w;
                        }
                    }
            } else if (wc < 2) {
                const int col0 = wc * 32 + 8 * fq;
#pragma unroll
                for (int ai = 0; ai < 2; ++ai)
#pragma unroll
                    for (int m = 0; m < 4; ++m) {
                        float* rowp = G + (size_t)(row0 + ai * 128 + m * 16) * 64 + col0;
                        *(f32x4*)rowp = acc[ai][0][m][0]; *(f32x4*)(rowp + 4) = acc[ai][0][m][1];
                    }
            }
        } else if (kind == 1) {
            const int col0 = u.pn * 256 + wc * 32 + 8 * fq;
            const int mi = u.pm < 64 ? (u.pm >> 4) : 4;
            const float* gp = gmod + (size_t)mi * NMOD + col0;
            f32x4 gv[2][2];
#pragma unroll
            for (int bj = 0; bj < 2; ++bj)
#pragma unroll
                for (int n = 0; n < 2; ++n) gv[bj][n] = *(const f32x4*)(gp + bj * 128 + n * 4);
#pragma unroll
            for (int ai = 0; ai < 2; ++ai)
#pragma unroll
                for (int m = 0; m < 4; ++m) {
                    bf16_t* rowp = O + (size_t)(row0 + ai * 128 + m * 16) * D + col0;
#pragma unroll
                    for (int bj = 0; bj < 2; ++bj) {
                        const f32x4 v0 = gv[bj][0] * acc[ai][bj][m][0], v1 = gv[bj][1] * acc[ai][bj][m][1];
                        u32x4 w; w.x = pg8::cvt_pk_bf16(v0[0], v0[1]); w.y = pg8::cvt_pk_bf16(v0[2], v0[3]); w.z = pg8::cvt_pk_bf16(v1[0], v1[1]); w.w = pg8::cvt_pk_bf16(v1[2], v1[3]);
                        *(u32x4*)(rowp + bj * 128) = w;
                    }
                }
        } else if (kind == 3) {
            const int col0 = u.pn * 256 + wc * 32 + 8 * fq;
            const float* gp = gmod + (size_t)4 * NMOD + col0;
            f32x4 gv[2][2];
#pragma unroll
            for (int bj = 0; bj < 2; ++bj)
#pragma unroll
                for (int n = 0; n < 2; ++n) gv[bj][n] = *(const f32x4*)(gp + bj * 128 + n * 4);
            float* Pk = G + (size_t)u.ks * TC * D;
#pragma unroll
            for (int ai = 0; ai < 2; ++ai)
#pragma unroll
                for (int m = 0; m < 4; ++m) {
                    float* rowp = Pk + (size_t)(row0 + ai * 128 + m * 16) * D + col0;
#pragma unroll
                    for (int bj = 0; bj < 2; ++bj)
#pragma unroll
                        for (int n = 0; n < 2; ++n) *(f32x4*)(rowp + bj * 128 + n * 4) = gv[bj][n] * acc[ai][bj][m][n];
                }
        } else {
            const int col0 = u.pn * 128 + wc * 32 + 8 * fq;
#pragma unroll
            for (int ai = 0; ai < 2; ++ai)
#pragma unroll
                for (int m = 0; m < 4; ++m) {
                    bf16_t* rowp = O + (size_t)(row0 + ai * 128 + m * 16) * DFF + col0;
                    f32x4 v0, v1;
#pragma unroll
                    for (int j = 0; j < 4; ++j) { v0[j] = silu_f(acc[ai][0][m][0][j]) * acc[ai][1][m][0][j]; v1[j] = silu_f(acc[ai][0][m][1][j]) * acc[ai][1][m][1][j]; }
                    u32x4 w; w.x = pg8::cvt_pk_bf16(v0[0], v0[1]); w.y = pg8::cvt_pk_bf16(v0[2], v0[3]); w.z = pg8::cvt_pk_bf16(v1[0], v1[1]); w.w = pg8::cvt_pk_bf16(v1[2], v1[3]);
                    *(u32x4*)rowp = w;
                }
        }
    }
};
struct SplitOrder {
    int nsplit, G, c;
    __device__ bool next(int i, pg8::Unit& u) const {
        const int L = i * G + c; if (L >= 32 * nsplit) return false;
        const int tile = L / nsplit; u.ks = L % nsplit; u.pm = tile >> 3; u.pn = tile & 7; return true;
    }
    DI void a_ready(const pg8::Unit&) const {}
    DI void done(const pg8::Unit&) const {}
};
template <class Epi> DI void run_gemm(unsigned char* smem, const bf16_t* A, const bf16_t* Bt, int M, int N, int K, const Epi& E) {
    pg8::Gemm g; g.A = A; g.Bt = Bt; g.M = M; g.N = N; g.K = K; g.ld = K;
    pg8::StaticOrder S; S.init(M, N, ogdim(), obid());
    pg8::gemm_phase<Epi, pg8::StaticOrder, false>((PG8_LAS unsigned char*)smem, g, S, E, nullptr);
}

__device__ void phase_pre(const KP& p, int l, unsigned char* smem) {
    const int tid = otid();
    bf16_t* U = (bf16_t*)(p.ws + WS_U);
    const float* G = (const float*)(p.ws + WS_GATES);
    bf16_t* X = (bf16_t*)(p.ws + WS_XBC);
    float2* GL = (float2*)(p.ws + WS_GL);
    constexpr int NGLA = 2 * (T / 64), NR16 = T / 16;
    for (int it = obid(); it < NGLA + 2 * NR16; it += ogdim()) {
        if (it < NGLA) {
            const int blk = it >> 1, gd = it & 1, r0 = blk * 64;
            const int half = tid >> 8, gch = tid & 255;
            float* as = (float*)smem;
            float* tot = as + 64 * 16;
            __syncthreads();
            if (tid < 256) { const int t = tid >> 2, c4 = (tid & 3) * 4; *(f32x4*)(as + t * 16 + c4) = *(const f32x4*)(G + (size_t)(r0 + t) * 64 + 32 + gd * 16 + c4); }
            float gw[16];
#pragma unroll
            for (int r = 0; r < 16; ++r) gw[r] = p.in[I_GGW][((size_t)(l * 2 + gd) * 16 + r) * 256 + gch];
            const float gb = p.in[I_GGB][(l * 2 + gd) * 256 + gch];
            bf16_t* QG = (bf16_t*)(p.ws + WS_QG) + (size_t)gd * T * 256 + gch;
            bf16_t* KG = (bf16_t*)(p.ws + WS_KG) + (size_t)gd * T * 256 + gch;
            __syncthreads();
            float* las = tot + 256;
            float lsum = 0.f;
#pragma unroll 2
            for (int j = 0; j < 32; ++j) {
                const int sp = half * 32 + j, t = gd ? 63 - sp : sp;
                const float* ar = as + t * 16;
                float x = gb;
#pragma unroll
                for (int r4 = 0; r4 < 4; ++r4) { const f32x4 a4 = *(const f32x4*)(ar + r4 * 4); x += a4[0] * gw[r4 * 4] + a4[1] * gw[r4 * 4 + 1] + a4[2] * gw[r4 * 4 + 2] + a4[3] * gw[r4 * 4 + 3]; }
                const float lv = logsigmoid_f(x) * (1.f / 16.f); las[j * 512 + tid] = lv; lsum += lv;
            }
            if (half == 0) tot[gch] = lsum;
            __syncthreads();
            float bsum = half ? tot[gch] : 0.f;
            if (half) ((float*)(p.ws + WS_EE))[((size_t)gd * (T / 64) + blk) * 256 + gch] = __expf(bsum + lsum);
            for (int tb = 0; tb < 32; tb += 8) {
                unsigned short qv[8], kv[8];
#pragma unroll
                for (int j = 0; j < 8; ++j) { const int sp = half * 32 + tb + j, t = gd ? 63 - sp : sp; qv[j] = U[(size_t)(r0 + t) * NU + U_GQ + gch]; kv[j] = U[(size_t)(r0 + t) * NU + U_GK + gch]; }
#pragma unroll
                for (int j = 0; j < 8; ++j) {
                    const int sp = half * 32 + tb + j, t = gd ? 63 - sp : sp;
                    bsum += las[(tb + j) * 512 + tid];
                    QG[(size_t)(r0 + t) * 256] = f2bf(bf2f(qv[j]) * __expf(bsum) * 0.125f);
                    KG[(size_t)(r0 + t) * 256] = f2bf(bf2f(kv[j]) * __expf(-bsum));
                }
            }
        } else if (it < NGLA + NR16) {
            const int r0 = (it - NGLA) * 16, c0 = 2 * tid;
            int t0, L; if (r0 < TL) { t0 = r0 & (SEQ - 1); L = SEQ; } else { t0 = (r0 - TL) & (CTXL - 1); L = CTXL; }
            const float* cw = p.in[I_SCONVW] + (size_t)l * 3 * 1024; const float* cb = p.in[I_SCONVB] + (size_t)l * 1024;
            const float2 w0 = *(const float2*)(cw + c0), w1 = *(const float2*)(cw + 1024 + c0), w2 = *(const float2*)(cw + 2048 + c0), bb = *(const float2*)(cb + c0);
            const bf16_t* up = U + (size_t)r0 * NU + U_XBC + c0;
            unsigned x[18];
            x[0] = t0 > 0 ? *(const unsigned*)(up - NU) : 0u;
#pragma unroll
            for (int j = 0; j < 16; ++j) x[j + 1] = *(const unsigned*)(up + (size_t)j * NU);
            x[17] = (t0 + 16 < L) ? *(const unsigned*)(up + (size_t)16 * NU) : 0u;
#pragma unroll
            for (int j = 0; j < 16; ++j) {
                const float o0 = bb.x + w0.x * bf2f(x[j] & 0xffff) + w1.x * bf2f(x[j + 1] & 0xffff) + w2.x * bf2f(x[j + 2] & 0xffff);
                const float o1 = bb.y + w0.y * bf2f(x[j] >> 16) + w1.y * bf2f(x[j + 1] >> 16) + w2.y * bf2f(x[j + 2] >> 16);
                *(unsigned*)(X + (size_t)(r0 + j) * 1024 + c0) = pk2(silu_f(o0), silu_f(o1));
            }
        } else {
            const int r0 = (it - NGLA - NR16) * 16;
            {
                const int rsel = tid >> 8, pp = tid & 255, isk = pp >> 7, idx = (2 * pp) & 255, rh = idx >> 6, rhalf = (idx >> 5) & 1, ri = idx & 31;
                const int rcol = (isk ? U_RK : U_RQ) + rh * 128 + rhalf * 64 + ri;
                const float rscale = isk ? 0.08838834764831845f : 1.f;
                const float f0 = exp2f(-(float)ri * (13.287712379549449f / 32.f)), f1 = exp2f(-(float)(ri + 1) * (13.287712379549449f / 32.f));
                unsigned a[8], b[8];
#pragma unroll
                for (int j = 0; j < 8; ++j) { const bf16_t* q = U + (size_t)(r0 + rsel * 8 + j) * NU + rcol; a[j] = *(const unsigned*)q; b[j] = *(const unsigned*)(q + 32); }
#pragma unroll
                for (int j = 0; j < 8; ++j) {
                    const int row = r0 + rsel * 8 + j;
                    float x1a = bf2f(a[j] & 0xffff), x1b = bf2f(a[j] >> 16), x2a = bf2f(b[j] & 0xffff), x2b = bf2f(b[j] >> 16);
                    if (row < TL) {
                        const int t = row & (SEQ - 1);
                        const float pos = (float)(rhalf ? (t & 63) : (t >> 6));
                        float ra = pos * f0 * 0.15915494309189535f, rb = pos * f1 * 0.15915494309189535f; ra -= floorf(ra); rb -= floorf(rb);
                        const float sa = __builtin_amdgcn_sinf(ra), ca = __builtin_amdgcn_cosf(ra), sb = __builtin_amdgcn_sinf(rb), cbv = __builtin_amdgcn_cosf(rb);
                        const float y1a = x1a * ca - x2a * sa, y2a = x1a * sa + x2a * ca, y1b = x1b * cbv - x2b * sb, y2b = x1b * sb + x2b * cbv;
                        x1a = y1a; x2a = y2a; x1b = y1b; x2b = y2b;
                    }
                    bf16_t* q = U + (size_t)row * NU + rcol;
                    *(unsigned*)q = pk2(x1a * rscale, x1b * rscale); *(unsigned*)(q + 32) = pk2(x2a * rscale, x2b * rscale);
                }
            }
            {
                const int row = r0 + (tid >> 5), ds = tid & 31, d = ds >> 4, slot = ds & 15;
                const float* gr = G + (size_t)row * 64;
                float loga, logw;
                if (slot < 4) {
                    const int h = slot;
                    logw = gr[d * 4 + h] + p.in[I_MIGB][(l * 2 + d) * 4 + h];
                    loga = logsigmoid_f(gr[8 + d * 4 + h] + p.in[I_MFGB][(l * 2 + d) * 4 + h]);
                } else if (slot < 12) {
                    const int h = slot - 4;
                    const float dt = softplus_f(gr[16 + d * 8 + h] + p.in[I_SDTB][(l * 2 + d) * 8 + h]);
                    loga = -dt * __expf(p.in[I_SALOG][(l * 2 + d) * 8 + h]); logw = __logf(dt);
                } else {
                    const int h = slot - 12;
                    loga = -__expf(p.in[I_RDECAY][(l * 2 + d) * 4 + h]); logw = 0.f;
                }
                GL[(size_t)(d * 16 + slot) * T + row] = make_float2(loga, logw);
            }
        }
    }
}

typedef short s16x4 __attribute__((ext_vector_type(4)));
#define LDSP(T_, ptr) ((__attribute__((address_space(3))) T_*)(ptr))
DI bf16x8 tr_frag(const bf16_t* lo_addr, int row_stride  ) {
    const s16x4 lo = __builtin_amdgcn_ds_read_tr16_b64_v4i16(LDSP(s16x4, lo_addr));
    const s16x4 hi = __builtin_amdgcn_ds_read_tr16_b64_v4i16(LDSP(s16x4, lo_addr + 4 * row_stride));
    return __builtin_shufflevector(lo, hi, 0, 1, 2, 3, 4, 5, 6, 7);
}
#define MFMA16(a, b, c) __builtin_amdgcn_mfma_f32_16x16x32_bf16((a), (b), (c), 0, 0, 0)
template <int MIX, bool DEN> struct ScanCfg {
    static constexpr int DK = MIX == 3 ? 64 : 128, NH = MIX == 1 ? 2 : 1, NT = DK / 16, KS2 = DK / 32;
    static constexpr int NVC = DEN ? 144 : 128;
    static constexpr int QST = DK + 8, VST = NVC + 8, PST = 72;
    static constexpr int SZQ = 64 * QST * 2, SZV = 64 * VST * 2, SZVEC = NH * 320 * 4;
    static constexpr int OFF_K = SZQ, OFF_V = 2 * SZQ, OFF_VEC = 2 * SZQ + SZV, BUF = 2 * SZQ + SZV + SZVEC;
    static constexpr int OFF_PW = 2 * BUF, SZP = NH * 64 * PST * 2;
    static_assert(OFF_PW + SZP <= LDS_BYTES, "scan LDS layout");
};
DI int chunk_base(int b, int d, int c) { if (c < 4) return TL + b * CTXL + (d ? 3 - c : c) * 64; const int cc = c - 4; return b * SEQ + (d ? 63 - cc : cc) * 64; }

template <int MIX, bool DEN>
__device__ void scan_item(const KP& p, int b, int d, int grp, unsigned char* smem) {
    using C = ScanCfg<MIX, DEN>;
    constexpr int DK = C::DK, NH = C::NH, NT = C::NT, KS2 = C::KS2, QST = C::QST, VST = C::VST, PST = C::PST;
    constexpr int QPR = DK / 8;
    constexpr int NQP = (64 * QPR) / 512;
    const int tid = otid(), lane = tid & 63, wid = __builtin_amdgcn_readfirstlane(tid >> 6);
    const int l15 = lane & 15, g4 = lane >> 4, tq = l15 >> 2, tp = l15 & 3;
    const bf16_t* U = (const bf16_t*)(p.ws + WS_U); const bf16_t* X = (const bf16_t*)(p.ws + WS_XBC);
    const bf16_t *qsrc, *ksrc, *vsrc; int qld, vld;
    if (MIX == 0) { qsrc = U + U_MQ + grp * 128; ksrc = U + U_MK + grp * 128; vsrc = U + U_MV + grp * 128; qld = NU; vld = NU; }
    if (MIX == 1) { qsrc = X + 768 + (grp >> 1) * 128; ksrc = X + 512 + (grp >> 1) * 128; vsrc = X + grp * 128; qld = 1024; vld = 1024; }
    if (MIX == 2) { qsrc = U + U_RQ + grp * 128; ksrc = U + U_RK + grp * 128; vsrc = U + U_RV + grp * 128; qld = NU; vld = NU; }
    if (MIX == 3) { qsrc = (const bf16_t*)(p.ws + WS_QG) + (size_t)d * T * 256 + grp * 64; ksrc = (const bf16_t*)(p.ws + WS_KG) + (size_t)d * T * 256 + grp * 64; vsrc = U + U_GV + grp * 128; qld = 256; vld = NU; }
    const int slot0 = MIX == 0 ? grp : MIX == 1 ? 4 + 2 * grp : 12 + grp;
    const float2* GL = (const float2*)(p.ws + WS_GL) + (size_t)(d * 16 + slot0 + (wid < NH ? wid : 0)) * T;
    const float* EE = (const float*)(p.ws + WS_EE) + (size_t)d * (T / 64) * 256 + grp * 64;
    bf16_t* YS = (bf16_t*)(p.ws + WS_YS) + (size_t)d * T * D + MIX * 512 + grp * 128;
    float* DENP = (float*)(p.ws + WS_DEN) + (size_t)d * T * 4 + grp;
    constexpr float LOGQS = MIX == 0 ? -2.4260151319598084f : 0.f;

    __syncthreads();
    for (int i = tid; i < C::SZP / 4; i += 512) ((unsigned*)(smem + C::OFF_PW))[i] = 0u;
    if (DEN) {
        for (int i = tid; i < 2 * 64 * 16; i += 512) { const int bf = i >> 10, r = (i >> 4) & 63, cc = i & 15; ((bf16_t*)(smem + bf * C::BUF + C::OFF_V))[r * VST + 128 + cc] = cc == 0 ? (bf16_t)0x3F80 : (bf16_t)0; }
    }
    f32x4 S0[NT];
#pragma unroll
    for (int t = 0; t < NT; ++t) S0[t] = (f32x4){0.f, 0.f, 0.f, 0.f};

    u32x4 rqA[NQP], rkA[NQP], rvA[2], rqB[NQP], rkB[NQP], rvB[2]; float gxA = 0.f, gyA = 0.f, eeA = 0.f, gxB = 0.f, gyB = 0.f, eeB = 0.f;
#define ISSUE_ALL(c_, S_) do { \
        const int base_ = chunk_base(b, d, (c_)); \
_Pragma("unroll") \
        for (int i = 0; i < NQP; ++i) { const int pc = tid + 512 * i, r = pc / QPR, c8 = pc % QPR; const size_t row = (size_t)(base_ + (d ? 63 - r : r)); \
            rq##S_[i] = *(const u32x4*)(qsrc + row * qld + c8 * 8); rk##S_[i] = *(const u32x4*)(ksrc + row * qld + c8 * 8); } \
_Pragma("unroll") \
        for (int i = 0; i < 2; ++i) { const int pc = tid + 512 * i, r = pc >> 4, c8 = pc & 15; const size_t row = (size_t)(base_ + (d ? 63 - r : r)); \
            rv##S_[i] = *(const u32x4*)(vsrc + row * vld + c8 * 8); } \
        if (MIX != 3) { if (wid < NH) { const float2 g_ = GL[base_ + (d ? 63 - lane : lane)]; gx##S_ = g_.x; gy##S_ = g_.y; } } \
        else if (wid == 0) ee##S_ = EE[(size_t)(base_ >> 6) * 256 + lane]; \
    } while (0)
#define STAGE_ALL(bufi, S_) do { \
        unsigned char* B_ = smem + (bufi) * C::BUF; \
_Pragma("unroll") \
        for (int i = 0; i < NQP; ++i) { const int pc = tid + 512 * i, r = pc / QPR, c8 = pc % QPR; \
            *(u32x4*)((bf16_t*)B_ + r * QST + c8 * 8) = rq##S_[i]; *(u32x4*)((bf16_t*)(B_ + C::OFF_K) + r * QST + c8 * 8) = rk##S_[i]; } \
_Pragma("unroll") \
        for (int i = 0; i < 2; ++i) { const int pc = tid + 512 * i, r = pc >> 4, c8 = pc & 15; *(u32x4*)((bf16_t*)(B_ + C::OFF_V) + r * VST + c8 * 8) = rv##S_[i]; } \
        float* vec_ = (float*)(B_ + C::OFF_VEC); \
        if (MIX != 3) { \
            if (wid < NH) { \
                float bc = gx##S_; \
                bc += __uint_as_float(__builtin_amdgcn_update_dpp(0, __float_as_uint(bc), 0x111, 0xf, 0xf, false)); \
                bc += __uint_as_float(__builtin_amdgcn_update_dpp(0, __float_as_uint(bc), 0x112, 0xf, 0xf, false)); \
                bc += __uint_as_float(__builtin_amdgcn_update_dpp(0, __float_as_uint(bc), 0x114, 0xf, 0xf, false)); \
                bc += __uint_as_float(__builtin_amdgcn_update_dpp(0, __float_as_uint(bc), 0x118, 0xf, 0xf, false)); \
                bc += __uint_as_float(__builtin_amdgcn_update_dpp(0, __float_as_uint(bc), 0x142, 0xa, 0xf, false)); \
                bc += __uint_as_float(__builtin_amdgcn_update_dpp(0, __float_as_uint(bc), 0x143, 0xc, 0xf, false)); \
                const float bend = __uint_as_float(__builtin_amdgcn_readlane(__float_as_uint(bc), 63)); \
                const float rt = bc + LOGQS, ct = gy##S_ - bc; \
                float* v = vec_ + wid * 320; \
                v[lane] = rt; v[64 + lane] = ct; v[128 + lane] = __expf(rt); v[192 + lane] = __expf(bend + ct); v[256 + lane] = __expf(bend); \
            } \
        } else if (wid == 0) vec_[256 + lane] = ee##S_; \
    } while (0)

    ISSUE_ALL(0, A);
    STAGE_ALL(0, A);
    ISSUE_ALL(1, B);
    __syncthreads();

    for (int c2 = 0; c2 < (CTXL + SEQ) / 64; c2 += 2) {
#pragma unroll
    for (int par = 0; par < 2; ++par) {
        const int c = c2 + par;
        const int cur = par;
        const int base = chunk_base(b, d, c);
        unsigned char* B = smem + cur * C::BUF;
        const bf16_t* Qs = (const bf16_t*)B; const bf16_t* Ks = (const bf16_t*)(B + C::OFF_K); const bf16_t* Vs = (const bf16_t*)(B + C::OFF_V);
        const float* vec = (const float*)(B + C::OFF_VEC);
        bf16_t* Pw = (bf16_t*)(smem + C::OFF_PW);
        bf16_t* ysb = YS + (size_t)base * D;
        if (c + 2 < (CTXL + SEQ) / 64) { if (par == 0) ISSUE_ALL(c + 2, A); else ISSUE_ALL(c + 2, B); }
#pragma unroll
        for (int rep = 0; rep < 2; ++rep) {
            const int tl = rep == 0 ? wid : wid + 2;
            if (rep == 1 && wid < 6) break;
            const int it = tl >= 6 ? 3 : tl >= 3 ? 2 : tl >= 1 ? 1 : 0, jt = tl - ((it * (it + 1)) >> 1);
            f32x4 acc = (f32x4){0.f, 0.f, 0.f, 0.f};
            bf16x8 pa[KS2], pb[KS2];
#pragma unroll
            for (int ks = 0; ks < KS2; ++ks) {
                pa[ks] = *LDSP(const bf16x8, Ks + (jt * 16 + l15) * QST + ks * 32 + g4 * 8);
                pb[ks] = *LDSP(const bf16x8, Qs + (it * 16 + l15) * QST + ks * 32 + g4 * 8);
            }
            __builtin_amdgcn_sched_barrier(0);
#pragma unroll
            for (int ks = 0; ks < KS2; ++ks) acc = MFMA16(pa[ks], pb[ks], acc);
            const int i = it * 16 + l15, j0 = jt * 16 + g4 * 4;
#pragma unroll
            for (int h = 0; h < NH; ++h) {
                float w[4];
                if (MIX != 3) {
                    const float rt = vec[h * 320 + i]; const f32x4 ct = *LDSP(const f32x4, vec + h * 320 + 64 + j0);
#pragma unroll
                    for (int r = 0; r < 4; ++r) w[r] = (j0 + r <= i) ? __expf(rt + ct[r]) : 0.f;
                } else {
#pragma unroll
                    for (int r = 0; r < 4; ++r) w[r] = (j0 + r <= i) ? 1.f : 0.f;
                }
                u32x2 o; o.x = pg8::cvt_pk_bf16(acc[0] * w[0], acc[1] * w[1]); o.y = pg8::cvt_pk_bf16(acc[2] * w[2], acc[3] * w[3]);
                *LDSP(u32x2, Pw + (h * 64 + i) * PST + j0) = o;
            }
        }
        __syncthreads();
#define SB_() __builtin_amdgcn_sched_barrier(0)
#define QFRAG(dst, it_, ks_) do { \
            const s16x4 a0_ = *LDSP(const s16x4, Qs + ((it_) * 16 + l15) * QST + (ks_) * 32 + g4 * 4); \
            const s16x4 a1_ = *LDSP(const s16x4, Qs + ((it_) * 16 + l15) * QST + (ks_) * 32 + 16 + g4 * 4); \
            dst = __builtin_shufflevector(a0_, a1_, 0, 1, 2, 3, 4, 5, 6, 7); } while (0)
#define SPACK(dst, S, ks_) do { u32x4 sb_; sb_.x = pg8::cvt_pk_bf16(S[2 * (ks_)][0], S[2 * (ks_)][1]); sb_.y = pg8::cvt_pk_bf16(S[2 * (ks_)][2], S[2 * (ks_)][3]); \
            sb_.z = pg8::cvt_pk_bf16(S[2 * (ks_) + 1][0], S[2 * (ks_) + 1][1]); sb_.w = pg8::cvt_pk_bf16(S[2 * (ks_) + 1][2], S[2 * (ks_) + 1][3]); dst = __builtin_bit_cast(bf16x8, sb_); } while (0)
#define SLICE(S, sl) do { \
            const int hh = MIX == 1 ? (sl) >> 2 : 0, vc0 = (sl) * 16; \
            const float* vh = vec + hh * 320; \
            f32x4 Y[4]; \
_Pragma("unroll") \
            for (int it = 0; it < 4; ++it) Y[it] = (f32x4){0.f, 0.f, 0.f, 0.f}; \
              \
            { bf16x8 QA[2][4]; \
_Pragma("unroll") \
              for (int ks = 0; ks < 2; ++ks) \
_Pragma("unroll") \
                for (int it = 0; it < 4; ++it) QFRAG(QA[ks][it], it, ks); \
              SB_(); \
_Pragma("unroll") \
              for (int ks = 0; ks < 2; ++ks) { bf16x8 sbf; SPACK(sbf, S, ks); \
_Pragma("unroll") \
                for (int it = 0; it < 4; ++it) Y[it] = MFMA16(sbf, QA[ks][it], Y[it]); } } \
            SB_(); \
            bf16x8 Vf[2], PA[6]; \
            { bf16x8 QB[2][4]; \
              if (KS2 == 4) { \
_Pragma("unroll") \
              for (int ks = 0; ks < 2; ++ks) \
_Pragma("unroll") \
                for (int it = 0; it < 4; ++it) QFRAG(QB[ks][it], it, ks + 2); } \
_Pragma("unroll") \
              for (int ks = 0; ks < 2; ++ks) Vf[ks] = tr_frag(Vs + (ks * 32 + g4 * 8 + tq) * VST + vc0 + 4 * tp, VST); \
              PA[0] = *LDSP(const bf16x8, Pw + (hh * 64 + 0 * 16 + l15) * PST + 0 * 32 + g4 * 8); \
              PA[1] = *LDSP(const bf16x8, Pw + (hh * 64 + 1 * 16 + l15) * PST + 0 * 32 + g4 * 8); \
              PA[2] = *LDSP(const bf16x8, Pw + (hh * 64 + 2 * 16 + l15) * PST + 0 * 32 + g4 * 8); \
              PA[3] = *LDSP(const bf16x8, Pw + (hh * 64 + 2 * 16 + l15) * PST + 1 * 32 + g4 * 8); \
              PA[4] = *LDSP(const bf16x8, Pw + (hh * 64 + 3 * 16 + l15) * PST + 0 * 32 + g4 * 8); \
              PA[5] = *LDSP(const bf16x8, Pw + (hh * 64 + 3 * 16 + l15) * PST + 1 * 32 + g4 * 8); \
              SB_(); \
              if (KS2 == 4) { \
_Pragma("unroll") \
              for (int ks = 0; ks < 2; ++ks) { bf16x8 sbf; SPACK(sbf, S, ks + 2); \
_Pragma("unroll") \
                for (int it = 0; it < 4; ++it) Y[it] = MFMA16(sbf, QB[ks][it], Y[it]); } } } \
            SB_(); \
            if (MIX != 3) { \
_Pragma("unroll") \
                for (int it = 0; it < 4; ++it) Y[it] = Y[it] * vh[128 + it * 16 + l15]; \
            } \
            Y[0] = MFMA16(Vf[0], PA[0], Y[0]); Y[1] = MFMA16(Vf[0], PA[1], Y[1]); Y[2] = MFMA16(Vf[0], PA[2], Y[2]); Y[3] = MFMA16(Vf[0], PA[4], Y[3]); \
            Y[2] = MFMA16(Vf[1], PA[3], Y[2]); Y[3] = MFMA16(Vf[1], PA[5], Y[3]); \
            SB_(); \
              \
_Pragma("unroll") \
            for (int it = 0; it < 4; ++it) { \
                const int i = it * 16 + l15; const int ro = (d ? 63 - i : i); \
                const f32x4 y = Y[it]; \
                if (DEN) { if (g4 == 0) DENP[((size_t)base + ro) * 4] = y[0]; } \
                else { u32x2 o; o.x = pg8::cvt_pk_bf16(y[0], y[1]); o.y = pg8::cvt_pk_bf16(y[2], y[3]); *(u32x2*)(ysb + ro * D + vc0 + g4 * 4) = o; } \
            } \
            SB_(); \
            bf16x8 Vw[2]; float dec = 1.f; \
            if (MIX != 3) { \
                dec = vh[256]; \
_Pragma("unroll") \
                for (int ks = 0; ks < 2; ++ks) { \
                    const f32x4 w0 = *LDSP(const f32x4, vh + 192 + ks * 32 + g4 * 8), w1 = *LDSP(const f32x4, vh + 192 + ks * 32 + g4 * 8 + 4); \
                    u32x4 o; \
                    o.x = pg8::cvt_pk_bf16(bf2f((unsigned short)Vf[ks][0]) * w0[0], bf2f((unsigned short)Vf[ks][1]) * w0[1]); \
                    o.y = pg8::cvt_pk_bf16(bf2f((unsigned short)Vf[ks][2]) * w0[2], bf2f((unsigned short)Vf[ks][3]) * w0[3]); \
                    o.z = pg8::cvt_pk_bf16(bf2f((unsigned short)Vf[ks][4]) * w1[0], bf2f((unsigned short)Vf[ks][5]) * w1[1]); \
                    o.w = pg8::cvt_pk_bf16(bf2f((unsigned short)Vf[ks][6]) * w1[2], bf2f((unsigned short)Vf[ks][7]) * w1[3]); \
                    Vw[ks] = __builtin_bit_cast(bf16x8, o); \
                } \
            } else { Vw[0] = Vf[0]; Vw[1] = Vf[1]; } \
              \
_Pragma("unroll") \
            for (int th = 0; th < NT / 4; ++th) { \
                bf16x8 KA[4][2]; \
_Pragma("unroll") \
                for (int t = 0; t < 4; ++t) \
_Pragma("unroll") \
                    for (int ks = 0; ks < 2; ++ks) KA[t][ks] = tr_frag(Ks + (ks * 32 + g4 * 8 + tq) * QST + (th * 4 + t) * 16 + 4 * tp, QST); \
                SB_(); \
_Pragma("unroll") \
                for (int t = 0; t < 4; ++t) { \
                    f32x4 acc = S[th * 4 + t] * dec; \
                    acc = MFMA16(KA[t][0], Vw[0], acc); acc = MFMA16(KA[t][1], Vw[1], acc); \
                    if (MIX == 3) { const f32x4 e4 = *LDSP(const f32x4, vec + 256 + (th * 4 + t) * 16 + g4 * 4); acc = acc * e4; } \
                    S[th * 4 + t] = acc; \
                } \
                SB_(); \
            } \
    } while (0)
        if (!DEN) SLICE(S0, wid);
        else if (wid == 0) SLICE(S0, 8);
        if (c + 1 < (CTXL + SEQ) / 64) { if (par == 0) STAGE_ALL(1, B); else STAGE_ALL(0, A); }
        __syncthreads();
    }
    }
}
__device__ void phase_scan(const KP& p, int l, unsigned char* smem) {
    if (ogdim() > 160 && obid() >= 160) {
        const int w = obid() - 160, nw = ogdim() - 160;
        convert_weights(p, l, CT_IN, CT_IN + CT_OUT + CT_UP + CT_DN, w, nw, smem);
        if (l == 0) convert_weights(p, 1, 0, CT_IN, w, nw, smem);
        return;
    }
    for (int item = obid(); item < 160; item += ogdim()) {
        if (item >= 128) { const int idx = item - 128; scan_item<0, true>(p, idx >> 3, (idx >> 2) & 1, idx & 3, smem); continue; }
        const int grp = item & 3, mix = (item >> 2) & 3, d = (item >> 4) & 1, b = item >> 5;
        if (mix == 0) scan_item<0, false>(p, b, d, grp, smem);
        else if (mix == 1) scan_item<1, false>(p, b, d, grp, smem);
        else if (mix == 2) scan_item<2, false>(p, b, d, grp, smem);
        else scan_item<3, false>(p, b, d, grp, smem);
    }
    if (ogdim() <= 160) {
        convert_weights(p, l, CT_IN, CT_IN + CT_OUT + CT_UP + CT_DN, obid(), ogdim(), smem);
        if (l == 0) convert_weights(p, 1, 0, CT_IN, obid(), ogdim(), smem);
    }
}

struct CombRaw { bf16x8 a[4], b[4], g[4], xs[4]; float s0, s1; };
DI void comb_load(const KP& p, int row, int lane, int mixer, int ec0, int gcol, CombRaw& r) {
    const bf16_t* U = (const bf16_t*)(p.ws + WS_U); const bf16_t* X = (const bf16_t*)(p.ws + WS_XBC);
    const bf16_t* YS = (const bf16_t*)(p.ws + WS_YS); const float* DEN = (const float*)(p.ws + WS_DEN);
    const bf16_t* y0p = YS + (size_t)row * D + mixer * 512 + ec0; const bf16_t* y1p = y0p + (size_t)T * D;
    r.s0 = 1.f; r.s1 = 1.f;
    if (mixer == 0) { const int h = (lane & 15) >> 2; r.s0 = DEN[(size_t)row * 4 + h]; r.s1 = DEN[((size_t)T + row) * 4 + h]; }
#pragma unroll
    for (int i = 0; i < 4; ++i) { r.a[i] = *(const bf16x8*)(y0p + i * 8); r.b[i] = *(const bf16x8*)(y1p + i * 8); r.g[i] = *(const bf16x8*)(U + (size_t)row * NU + gcol + i * 8); }
    if (mixer == 1) {
#pragma unroll
        for (int i = 0; i < 4; ++i) r.xs[i] = *(const bf16x8*)(X + (size_t)row * 1024 + ec0 + i * 8);
    }
}
DI void comb_compute(const KP& p, int row, int lane, int mixer, int ec0, const float* gain, float sd, const CombRaw& r) {
    bf16_t* H = (bf16_t*)(p.ws + WS_H);
    float y[32], gt[32];
    float s0 = 1.f, s1 = 1.f;
    if (mixer == 0) { s0 = 1.f / fmaxf(fabsf(r.s0), 1.f); s1 = 1.f / fmaxf(fabsf(r.s1), 1.f); }
#pragma unroll
    for (int i = 0; i < 4; ++i) {
#pragma unroll
        for (int j = 0; j < 8; ++j) {
            y[i * 8 + j] = bf2f((unsigned short)r.a[i][j]) * s0 + bf2f((unsigned short)r.b[i][j]) * s1;
            const float gv = bf2f((unsigned short)r.g[i][j]);
            gt[i * 8 + j] = mixer == 0 ? sigmoid_f(gv) : silu_f(gv);
        }
    }
    if (mixer == 1) {
#pragma unroll
        for (int i = 0; i < 4; ++i) {
#pragma unroll
            for (int j = 0; j < 8; ++j) { y[i * 8 + j] = (y[i * 8 + j] + sd * bf2f((unsigned short)r.xs[i][j])) * gt[i * 8 + j]; gt[i * 8 + j] = 1.f; }
        }
    }
    float s = 0.f;
#pragma unroll
    for (int j = 0; j < 32; ++j) s += y[j];
    s += shx(s, 1, lane); s += shx(s, 2, lane);
    const float mean = (mixer == 0 || mixer == 2) ? s * (1.f / 128.f) : 0.f;
    float q = 0.f;
#pragma unroll
    for (int j = 0; j < 32; ++j) { y[j] -= mean; q += y[j] * y[j]; }
    q += shx(q, 1, lane); q += shx(q, 2, lane);
    float q16 = q; q16 += shx(q16, 4, lane); q16 += shx(q16, 8, lane);
    const float rstd = rsqrtf((mixer == 1 ? q16 * (1.f / 512.f) : q * (1.f / 128.f)) + EPS);
    bf16_t* op = H + (size_t)row * D + mixer * 512 + ec0;
#pragma unroll
    for (int i = 0; i < 4; ++i) {
        const f32x4 g0 = *(const f32x4*)(gain + i * 8), g1 = *(const f32x4*)(gain + i * 8 + 4);
        u32x4 w;
        w.x = pg8::cvt_pk_bf16(y[i * 8 + 0] * rstd * g0[0] * gt[i * 8 + 0], y[i * 8 + 1] * rstd * g0[1] * gt[i * 8 + 1]);
        w.y = pg8::cvt_pk_bf16(y[i * 8 + 2] * rstd * g0[2] * gt[i * 8 + 2], y[i * 8 + 3] * rstd * g0[3] * gt[i * 8 + 3]);
        w.z = pg8::cvt_pk_bf16(y[i * 8 + 4] * rstd * g1[0] * gt[i * 8 + 4], y[i * 8 + 5] * rstd * g1[1] * gt[i * 8 + 5]);
        w.w = pg8::cvt_pk_bf16(y[i * 8 + 6] * rstd * g1[2] * gt[i * 8 + 6], y[i * 8 + 7] * rstd * g1[3] * gt[i * 8 + 7]);
        *(u32x4*)(op + i * 8) = w;
    }
}
__device__ void phase_comb(const KP& p, int l, int Mrows) {
    const int tid = otid(); const int lane = tid & 63, wid = tid >> 6;
    const int mixer = lane >> 4, ec0 = (lane & 15) * 32;
    const int gcol = (mixer == 0 ? U_MO : mixer == 1 ? U_SZ : mixer == 2 ? U_RG : U_GG) + ec0;
    const float* gain = (mixer == 0 ? p.in[I_MNORM] : mixer == 1 ? p.in[I_SNORM] : mixer == 2 ? p.in[I_RNORM] : p.in[I_GNORM]) + l * 512 + ec0;
    const float sd = p.in[I_SD][l * 8 + (ec0 >> 6)];
    const int stride = ogdim() * 8;
    for (int row = obid() * 8 + wid; row < Mrows; row += 2 * stride) {
        const int row1 = row + stride; const bool has1 = row1 < Mrows;
        CombRaw r0, r1;
        comb_load(p, row, lane, mixer, ec0, gcol, r0);
        if (has1) comb_load(p, row1, lane, mixer, ec0, gcol, r1);
        comb_compute(p, row, lane, mixer, ec0, gain, sd, r0);
        if (has1) comb_compute(p, row1, lane, mixer, ec0, gain, sd, r1);
    }
}

__device__ void run_phase(const KP& p, int ph, unsigned char* smem) {
    const float* mod = (const float*)(p.ws + WS_MOD);
    if (ph == 0) { phase_init(p, smem); return; }
    if (ph == 1) { phase_row<false, true, true>(p, T, nullptr, nullptr, mod, 0, 2048); return; }
    const int l = (ph - 2) / 9, k = (ph - 2) % 9;
    const bool last = l == 1;
    const int Mrows = last ? TL : T;
    const float* modl = mod + (size_t)l * 5 * NMOD;
    bf16_t* H = (bf16_t*)(p.ws + WS_H); bf16_t* U = (bf16_t*)(p.ws + WS_U);
    if (k == 0 || k == 4 || k == 6 || k == 7) {
        EpiAll E; E.kind = k == 0 ? 0 : (k == 6 ? 2 : 1); E.O = E.kind == 1 ? (bf16_t*)(p.ws + WS_YS) : U; E.G = (float*)(p.ws + WS_GATES); E.gmod = modl + (k == 4 ? 4096 : 10240);
        const bf16_t* A = k == 7 ? U : H;
        const bf16_t* Bt = (const bf16_t*)(p.ws + (k == 0 ? WS_WIN : k == 4 ? WS_WOUT : k == 6 ? WS_WUP : WS_WDN));
        const int N = k == 0 ? NINP : (k == 6 ? NUP : D), K = k == 7 ? DFF : D;
        const bool split = !last && (k == 4 || k == 7);
        const int M = (k == 0 || k == 6) ? (k == 0 ? T : Mrows) : TL;
        run_gemm(smem, A, Bt, M, N, K, E);
        if (split) {
            const int nsplit = k == 4 ? 8 : 4;
            EpiAll E2 = E; E2.kind = 3; E2.G = (float*)(p.ws + WS_YS + (size_t)T * D * 2);
            pg8::Gemm g; g.A = A + (size_t)TL * K; g.Bt = Bt; g.M = TC; g.N = D; g.K = K / nsplit; g.ld = K;
            SplitOrder S; S.nsplit = nsplit; S.G = ogdim(); S.c = obid();
            pg8::gemm_phase<EpiAll, SplitOrder, false>((PG8_LAS unsigned char*)smem, g, S, E2, nullptr);
        }
        return;
    }
    switch (k) {
    case 1: phase_pre(p, l, smem); break;
    case 2: phase_scan(p, l, smem); break;
    case 3: phase_comb(p, l, Mrows); break;
    case 5:
        if (l == 0) phase_row<true, true, true>(p, Mrows, p.in[I_POSTG] + (size_t)(l * 2 + 0) * D, p.in[I_POSTB] + (size_t)(l * 2 + 0) * D, modl, 6144, 8192, (const float*)(p.ws + WS_YS + (size_t)T * D * 2), 8);
        else phase_row<true, true, false>(p, Mrows, p.in[I_POSTG] + (size_t)(l * 2 + 0) * D, p.in[I_POSTB] + (size_t)(l * 2 + 0) * D, modl, 6144, 8192);
        break;
    case 8:
        if (!last) { phase_row<true, true>(p, T, p.in[I_POSTG] + (size_t)(l * 2 + 1) * D, p.in[I_POSTB] + (size_t)(l * 2 + 1) * D, modl + 5 * NMOD, 0, 2048, (const float*)(p.ws + WS_YS + (size_t)T * D * 2), 4); }
        else phase_row<true, false>(p, TL, p.in[I_POSTG] + (size_t)(l * 2 + 1) * D, p.in[I_POSTB] + (size_t)(l * 2 + 1) * D, modl, 0, 0);
        break;
    }
}

DI void grid_barrier(unsigned* bar, unsigned target) {
    asm volatile("s_waitcnt vmcnt(0) lgkmcnt(0)" ::: "memory");
    __syncthreads();
    if (threadIdx.x == 0) {
        __builtin_amdgcn_fence(__ATOMIC_RELEASE, "agent");
        asm volatile("s_waitcnt vmcnt(0)" ::: "memory");
        __hip_atomic_fetch_add(bar, 1u, __ATOMIC_RELAXED, __HIP_MEMORY_SCOPE_AGENT);
        while (__hip_atomic_load(bar, __ATOMIC_RELAXED, __HIP_MEMORY_SCOPE_AGENT) < target) __builtin_amdgcn_s_sleep(1);
        __builtin_amdgcn_fence(__ATOMIC_ACQUIRE, "agent");
        asm volatile("s_waitcnt vmcnt(0)" ::: "memory");
    }
    __syncthreads();
}
#ifndef PROBE_MASK
#define PROBE_MASK 0u
#endif
__global__ void __launch_bounds__(512, 2) mega(KP p) {
    extern __shared__ __attribute__((aligned(16))) unsigned char smem[];
    cg::grid_group grid = cg::this_grid();
    unsigned nbar = 0;
    unsigned long long tacc = 0ull;
    for (int ph = p.ph_lo; ph < p.ph_hi; ++ph) {
        unsigned long long t0 = 0ull;
        if (PROBE_MASK != 0u) t0 = __builtin_amdgcn_s_memrealtime();
        if (ph == 0 && blockIdx.x == 0 && threadIdx.x == 0) __hip_atomic_store((unsigned*)(p.ws + WS_BAR), 0u, __ATOMIC_RELAXED, __HIP_MEMORY_SCOPE_AGENT);
        run_phase(p, ph, smem);
        if (ph + 1 < p.ph_hi) {
            if (ph == 0) grid.sync();
            else { ++nbar; grid_barrier((unsigned*)(p.ws + WS_BAR), nbar * gridDim.x); }
        }
        if (PROBE_MASK != 0u && ((PROBE_MASK >> ph) & 1u)) tacc += __builtin_amdgcn_s_memrealtime() - t0;
    }
    if (PROBE_MASK != 0u && blockIdx.x == 0 && threadIdx.x == 0) {
        const unsigned long long t1 = __builtin_amdgcn_s_memrealtime();
        while (__builtin_amdgcn_s_memrealtime() - t1 < tacc) __builtin_amdgcn_s_sleep(8);
    }
}

#ifndef ONE_LAUNCH
#define ONE_LAUNCH 1
#endif
extern "C" void kernel_launch(void* const* d_in, const int* in_sizes, int n_in, void* d_out, int out_size, void* d_ws, size_t ws_size, hipStream_t stream) {
    static int grid = 0;
    if (grid == 0) {
        if (n_in != 26 || out_size != TL * D || ws_size < WS_END) { fprintf(stderr, "kernel_launch: unexpected shapes (n_in %d out %d ws %zu need %zu)\n", n_in, out_size, ws_size, (size_t)WS_END); grid = -1; return; }
        int dev = 0, cus = 0, per_cu = 0;
        hipGetDevice(&dev); hipDeviceGetAttribute(&cus, hipDeviceAttributeMultiprocessorCount, dev);
        if (hipFuncSetAttribute((const void*)mega, hipFuncAttributeMaxDynamicSharedMemorySize, LDS_BYTES) != hipSuccess) { fprintf(stderr, "kernel_launch: hipFuncSetAttribute failed\n"); grid = -1; return; }
        if (hipOccupancyMaxActiveBlocksPerMultiprocessor(&per_cu, (const void*)mega, 512, LDS_BYTES) != hipSuccess || per_cu < 1) { fprintf(stderr, "kernel_launch: occupancy query gives %d\n", per_cu); per_cu = 1; }
        (void)hipGetLastError();
        grid = cus;
    }
    if (grid < 0) return;
    KP p{};
    for (int i = 0; i < 26; ++i) p.in[i] = (const float*)d_in[i];
    p.out = (float*)d_out; p.ws = (unsigned char*)d_ws;
#if ONE_LAUNCH
    p.ph_lo = 0; p.ph_hi = NPHASE;
    void* args[] = {&p};
    hipError_t e = hipLaunchCooperativeKernel((const void*)mega, dim3(grid), dim3(512), args, LDS_BYTES, stream);
    if (e != hipSuccess) fprintf(stderr, "cooperative launch failed: %s (grid %d)\n", hipGetErrorString(e), grid);
#else
    for (int ph = 0; ph < NPHASE; ++ph) {
        p.ph_lo = ph; p.ph_hi = ph + 1;
        hipLaunchKernelGGL(mega, dim3(grid), dim3(512), LDS_BYTES, stream, p);
    }
#endif
}
```

```cpp
#include <hip/hip_runtime.h>
#include <hip/hip_cooperative_groups.h>
#include <cstdio>
namespace cg = cooperative_groups;
namespace pg8 {
#define PG8_LAS __attribute__((address_space(3)))
typedef unsigned short bf16_t;
typedef short bf16x8 __attribute__((ext_vector_type(8)));
typedef float f32x4 __attribute__((ext_vector_type(4)));
typedef unsigned u32x4 __attribute__((ext_vector_type(4)));
constexpr int BM = 256, BK = 64, HALF = 128, HTB = HALF * BK * 2  , STAGE_BYTES = 8 * HTB, NXCD = 8, WGM = 8;

__host__ __device__ __forceinline__ int lds_byte(int r, int c) { const int st = (r >> 4) * 2 + (c >> 5), rr = r & 15, cc = c & 31, ob = rr * 64 + cc * 2; return st * 1024 + (ob ^ (((ob >> 9) & 1) << 5)); }
__host__ __device__ __forceinline__ void stage_rc(int b, int& R, int& C) { const int st = b / 1024, sb = b % 1024, swz = sb ^ (((sb >> 9) & 1) << 5); R = (st >> 1) * 16 + swz / 64; C = (st & 1) * 32 + (swz % 64) / 2; }
__host__ __device__ __forceinline__ int perm32(int rho) { const int n = rho >> 4, i = rho & 15; return 8 * (i >> 2) + 4 * n + (i & 3); }

struct Unit { int pm, pn, ks; };
struct Gemm { const bf16_t* A; const bf16_t* Bt; int M, N, K, ld; };

struct StaticOrder {
    int nM, nN, nwg, G, c;
    __host__ __device__ void init(int M, int N, int G_, int c_) { nM = M / BM; nN = N / BM; nwg = nM * nN; G = G_; c = c_; }
    __host__ __device__ bool next(int i, Unit& u) const {
        const long L = (long)i * G + c; if (L >= nwg) return false;
        int wgid = (int)L; { const int q = nwg / NXCD, r = nwg % NXCD, xcd = wgid % NXCD, off = wgid / NXCD; wgid = (xcd < r ? xcd * (q + 1) : r * (q + 1) + (xcd - r) * q) + off; }
        const int nig = WGM * nN, gid = wgid / nig, fm = gid * WGM, gsz = (nM - fm) < WGM ? (nM - fm) : WGM;
        u.pm = fm + ((wgid % nig) % gsz); u.pn = (wgid % nig) / gsz; u.ks = 0; return true;
    }
    __device__ __forceinline__ void a_ready(const Unit&) const {}
    __device__ __forceinline__ void done(const Unit&) const {}
};
__device__ __forceinline__ unsigned cvt_pk_bf16(float lo, float hi) { unsigned r; asm volatile("v_cvt_pk_bf16_f32 %0, %1, %2" : "=v"(r) : "v"(lo), "v"(hi)); return r; }
template <class Epi, class Sched, bool STAMP = false>
__device__ __forceinline__ void gemm_phase(PG8_LAS unsigned char* lds, const Gemm g, const Sched& S, const Epi& E, unsigned long long* stamps) {
    int tid_ = threadIdx.x; asm volatile("" : "+v"(tid_)); const int tid = tid_, wid = __builtin_amdgcn_readfirstlane(tid >> 6), lane = tid & 63, wr = wid >> 2, wc = wid & 3, fr = lane & 15, fq = lane >> 4;
    const int K = g.ld, nt = g.K / BK; const size_t sstep = (size_t)g.K * 2;
    int ts_lo = 0, ts_hi = 0, nts = 0; const unsigned long long rt_entry = STAMP ? (unsigned long long)wall_clock64() : 0ull;
#define PG8_STAMP() do { if (STAMP && wid == 0 && nts < 64) { const unsigned long long _c = (unsigned long long)clock64(); \
        ts_lo = (lane == nts) ? (int)(unsigned)_c : ts_lo; ts_hi = (lane == nts) ? (int)(unsigned)(_c >> 32) : ts_hi; ++nts; } } while (0)
    PG8_STAMP();
    unsigned voffA[2], voffB[2];
#pragma unroll
    for (int i = 0; i < 2; ++i) { int R, C; stage_rc(tid * 16 + i * 8192, R, C); const int Rb = Epi::PERM ? ((R & ~31) + perm32(R & 31)) : R;
        voffA[i] = (unsigned)(R * K + C) * 2u; voffB[i] = (unsigned)(Rb * K + C) * 2u; }
    const size_t kstep = (size_t)(BK * 2);
    const size_t hstep = (size_t)HALF * K * 2;
    const size_t tstep = 2 * hstep;
    const unsigned ldsw = (unsigned)wid * 1024u;
    const int aoff = lds_byte(wr * 64 + fr, fq * 8), boff = lds_byte(wc * 32 + fr, fq * 8);
#define PG8_SA(b, h) (((b) * 2 + (h)) * HTB)
#define PG8_SB(b, h) ((4 + (b) * 2 + (h)) * HTB)
#define PG8_STAGE(bufoff, gbase, voff) do { _Pragma("unroll") for (int _i = 0; _i < 2; ++_i) \
        __builtin_amdgcn_global_load_lds((const unsigned*)((const char*)(gbase) + (voff)[_i]), (PG8_LAS unsigned*)(lds + (bufoff) + ldsw + _i * 8192), 16, 0, 0); } while (0)
#define PG8_LDA(dst, b, h) do { _Pragma("unroll") for (int m = 0; m < 4; ++m) _Pragma("unroll") for (int k = 0; k < 2; ++k) dst[m][k] = *(const PG8_LAS bf16x8*)(lds + PG8_SA(b, h) + aoff + m * 2048 + k * 1024); } while (0)
#define PG8_LDB(dst, b, h) do { _Pragma("unroll") for (int n = 0; n < 2; ++n) _Pragma("unroll") for (int k = 0; k < 2; ++k) dst[n][k] = *(const PG8_LAS bf16x8*)(lds + PG8_SB(b, h) + boff + n * 2048 + k * 1024); } while (0)
#define PG8_MMA(ai, bj, At, Bt) do { __builtin_amdgcn_s_setprio(1); _Pragma("unroll") for (int m = 0; m < 4; ++m) _Pragma("unroll") for (int n = 0; n < 2; ++n) _Pragma("unroll") for (int k = 0; k < 2; ++k) \
        acc[ai][bj][m][n] = __builtin_amdgcn_mfma_f32_16x16x32_bf16(Bt[n][k], At[m][k], acc[ai][bj][m][n], 0, 0, 0); __builtin_amdgcn_s_setprio(0); } while (0)
#define PG8_WAIT_V(n) asm volatile("s_waitcnt vmcnt(" #n ")" ::: "memory")
#define PG8_WAIT_L(n) asm volatile("s_waitcnt lgkmcnt(" #n ")" ::: "memory")
#define PG8_BAR __builtin_amdgcn_s_barrier()
#define PG8_SCHED __builtin_amdgcn_sched_barrier(0)
    Unit cur, nxt; int ui = 0;
    if (!S.next(0, cur)) return;
    f32x4 acc[2][2][4][2];
#pragma unroll
    for (int a = 0; a < 2; ++a)
#pragma unroll
        for (int b = 0; b < 2; ++b)
#pragma unroll
            for (int m = 0; m < 4; ++m)
#pragma unroll
                for (int n = 0; n < 2; ++n) acc[a][b][m][n] = (f32x4){0.f, 0.f, 0.f, 0.f};
    bf16x8 At[4][2], B0[2][2], B1[2][2];
    const char* cA = (const char*)g.A + (size_t)cur.pm * tstep + (size_t)cur.ks * sstep; const char* cB = (const char*)g.Bt + (size_t)cur.pn * tstep + (size_t)cur.ks * sstep;
    S.a_ready(cur);
    PG8_STAGE(PG8_SB(0, 0), cB, voffB); PG8_STAGE(PG8_SA(0, 0), cA, voffA); PG8_STAGE(PG8_SB(0, 1), cB + hstep, voffB); PG8_STAGE(PG8_SA(0, 1), cA + hstep, voffA);
    if (wr == 1) PG8_BAR;
    PG8_WAIT_V(4); PG8_BAR;
    PG8_STAGE(PG8_SB(1, 0), cB + kstep, voffB); PG8_STAGE(PG8_SA(1, 0), cA + kstep, voffA); PG8_STAGE(PG8_SB(1, 1), cB + hstep + kstep, voffB);
    PG8_WAIT_V(6); PG8_BAR;
    PG8_STAMP();
    for (;;) {
        const bool has_next = S.next(ui + 1, nxt);
        const char* nA = has_next ? (const char*)g.A + (size_t)nxt.pm * tstep + (size_t)nxt.ks * sstep : cA; const char* nB = has_next ? (const char*)g.Bt + (size_t)nxt.pn * tstep + (size_t)nxt.ks * sstep : cB;
        for (int t = 0; t < nt; t += 2) {
            const bool last = (t == nt - 2);
            const char* a1 = cA + (size_t)(t + 1) * kstep;
            const char* a2 = last ? nA : cA + (size_t)(t + 2) * kstep; const char* b2 = last ? nB : cB + (size_t)(t + 2) * kstep;
            const char* a3 = a2 + kstep; const char* b3 = b2 + kstep;
            if (last && has_next) S.a_ready(nxt);
            PG8_LDB(B0, 0, 0); PG8_SCHED; PG8_LDA(At, 0, 0); PG8_STAGE(PG8_SA(1, 1), a1 + hstep, voffA);
            PG8_WAIT_L(8); PG8_BAR; PG8_WAIT_L(0); PG8_MMA(0, 0, At, B0); PG8_BAR; PG8_SCHED;
            PG8_LDB(B1, 0, 1); PG8_STAGE(PG8_SB(0, 0), b2, voffB);
            PG8_BAR; PG8_WAIT_L(0); PG8_MMA(0, 1, At, B1); PG8_BAR;
            PG8_LDA(At, 0, 1); PG8_STAGE(PG8_SA(0, 0), a2, voffA);
            PG8_BAR; PG8_WAIT_L(0); PG8_MMA(1, 0, At, B0); PG8_BAR; PG8_SCHED;
            PG8_STAGE(PG8_SB(0, 1), b2 + hstep, voffB);
            PG8_WAIT_V(6); PG8_BAR; PG8_MMA(1, 1, At, B1); PG8_BAR;
            PG8_LDB(B0, 1, 0); PG8_SCHED; PG8_LDA(At, 1, 0); PG8_STAGE(PG8_SA(0, 1), a2 + hstep, voffA);
            PG8_WAIT_L(8); PG8_BAR; PG8_WAIT_L(0); PG8_MMA(0, 0, At, B0); PG8_BAR; PG8_SCHED;
            PG8_LDB(B1, 1, 1); PG8_STAGE(PG8_SB(1, 0), b3, voffB);
            PG8_BAR; PG8_WAIT_L(0); PG8_MMA(0, 1, At, B1); PG8_BAR;
            PG8_LDA(At, 1, 1); PG8_STAGE(PG8_SA(1, 0), a3, voffA);
            PG8_BAR; PG8_WAIT_L(0); PG8_MMA(1, 0, At, B0); PG8_BAR; PG8_SCHED;
            PG8_STAGE(PG8_SB(1, 1), b3 + hstep, voffB);
            PG8_WAIT_V(6); PG8_BAR; PG8_MMA(1, 1, At, B1); PG8_BAR;
        }
        PG8_STAMP();
        if constexpr (!Epi::AFTER_DRAIN) { E(acc, cur, wr, wc, fr, fq); S.done(cur); }
        PG8_STAMP();
        if (!has_next) break;
#pragma unroll
        for (int a = 0; a < 2; ++a)
#pragma unroll
            for (int b = 0; b < 2; ++b)
#pragma unroll
                for (int m = 0; m < 4; ++m)
#pragma unroll
                    for (int n = 0; n < 2; ++n) acc[a][b][m][n] = (f32x4){0.f, 0.f, 0.f, 0.f};
        cur = nxt; cA = nA; cB = nB; ++ui;
    }
    PG8_WAIT_V(0);
    if (wr == 0) PG8_BAR;
    PG8_BAR;
    if constexpr (Epi::AFTER_DRAIN) { E.fused(acc, cur, wr, wc, fr, fq, lds, wid, lane); S.done(cur); }
    PG8_STAMP();
    if (STAMP && wid == 0) { stamps[lane] = lane < nts ? (((unsigned long long)(unsigned)ts_hi << 32) | (unsigned)ts_lo) : 0ull;
        if (lane == 62) stamps[62] = rt_entry; if (lane == 63) stamps[63] = (unsigned long long)wall_clock64(); }
#undef PG8_STAMP
#undef PG8_SA
#undef PG8_SB
#undef PG8_STAGE
#undef PG8_LDA
#undef PG8_LDB
#undef PG8_MMA
#undef PG8_WAIT_V
#undef PG8_WAIT_L
#undef PG8_BAR
#undef PG8_SCHED
}
}

using pg8::bf16_t; using pg8::bf16x8; using pg8::f32x4; using pg8::u32x4;
#define DI __device__ __forceinline__
typedef unsigned u32x2 __attribute__((ext_vector_type(2)));
constexpr int D = 2048, NBATCH = 4, SEQ = 4096, CTXL = 256;
constexpr int TL = NBATCH * SEQ, TC = NBATCH * CTXL, T = TL + TC;
constexpr int NIN = 7232, NINP = 7424, NU = 7168, DFF = 5632, NUP = 2 * DFF, NMOD = 12288;
constexpr float EPS = 1e-5f, ALPHA = 1.41421356237309515f;
constexpr int U_MQ = 0, U_MK = 512, U_MV = 1024, U_MO = 1536, U_SZ = 2048, U_XBC = 2560, U_RQ = 3584, U_RK = 4096, U_RV = 4608, U_RG = 5120,
              U_GQ = 5632, U_GK = 5888, U_GV = 6144, U_GG = 6656;
constexpr size_t al256(size_t x) { return (x + 255) & ~(size_t)255; }
constexpr size_t WS_WIN = 0;
constexpr size_t WS_WOUT = WS_WIN + al256((size_t)NINP * D * 2);
constexpr size_t WS_WUP = WS_WOUT + al256((size_t)D * D * 2);
constexpr size_t WS_WDN = WS_WUP + al256((size_t)NUP * D * 2);
constexpr size_t WS_MOD = WS_WDN + al256((size_t)D * DFF * 2);
constexpr size_t WS_XC = WS_MOD + al256((size_t)2 * 5 * NMOD * 4);
constexpr size_t WS_H = WS_XC + al256((size_t)TC * D * 4);
constexpr size_t WS_U = WS_H + al256((size_t)T * D * 2);
constexpr size_t WS_GATES = WS_U + al256((size_t)T * NU * 2);
constexpr size_t WS_XBC = WS_GATES + al256((size_t)T * 64 * 4);
constexpr size_t WS_GL = WS_XBC + al256((size_t)T * 1024 * 2);
constexpr size_t WS_LA = WS_GL + al256((size_t)2 * 16 * T * 8);
constexpr size_t WS_YS = WS_LA + al256((size_t)2 * T * 256 * 4);
constexpr size_t WS_DEN = WS_YS + al256((size_t)2 * T * D * 2);
constexpr size_t WS_QG = WS_DEN + al256((size_t)2 * T * 4 * 4);
constexpr size_t WS_KG = WS_QG + al256((size_t)2 * T * 256 * 2);
constexpr size_t WS_EE = WS_KG + al256((size_t)2 * T * 256 * 2);
constexpr size_t WS_BAR = WS_EE + al256((size_t)2 * (T / 64) * 256 * 4);
constexpr size_t WS_YC = WS_BAR + 256;
constexpr size_t WS_END = WS_YC;
constexpr int LDS_BYTES = 131072;
constexpr int NPHASE = 20;
#ifndef SCAN_MFMA
#define SCAN_MFMA 15
#endif

struct KP { const float* in[26]; float* out; unsigned char* ws; int ph_lo, ph_hi; };
enum { I_X = 0, I_C, I_CTX, I_CCTX, I_ADAW, I_ADAB, I_WIN, I_MIGB, I_MFGB, I_MNORM, I_SCONVW, I_SCONVB, I_SDTB, I_SALOG, I_SD, I_SNORM, I_RDECAY, I_RNORM,
       I_GGW, I_GGB, I_GNORM, I_WOUT, I_POSTG, I_POSTB, I_WUP, I_WDN };

DI int obid() { int b = blockIdx.x; asm volatile("" : "+s"(b)); return b; }
DI int ogdim() { int g = gridDim.x; asm volatile("" : "+s"(g)); return g; }
DI int otid() { int t = threadIdx.x; asm volatile("" : "+v"(t)); return t; }
DI float bf2f(unsigned short h) { return __uint_as_float(((unsigned)h) << 16); }
DI unsigned short f2bf(float f) { unsigned u = __float_as_uint(f); u += 0x7fffu + ((u >> 16) & 1u); return (unsigned short)(u >> 16); }
DI unsigned pk2(float lo, float hi) { return (unsigned)f2bf(lo) | ((unsigned)f2bf(hi) << 16); }
DI float silu_f(float x) { return x * __builtin_amdgcn_rcpf(1.f + __expf(-x)); }
DI float sigmoid_f(float x) { return __builtin_amdgcn_rcpf(1.f + __expf(-x)); }
DI float softplus_f(float x) { return fmaxf(x, 0.f) + log1pf(__expf(-fabsf(x))); }
DI float logsigmoid_f(float x) { return fminf(x, 0.f) - log1pf(__expf(-fabsf(x))); }
DI float shx(float v, int m, int lane) { return __uint_as_float(__builtin_amdgcn_ds_bpermute((lane ^ m) << 2, __float_as_uint(v))); }
DI float wave_sum(float v, int lane) {
#pragma unroll
    for (int m = 32; m >= 1; m >>= 1) v += shx(v, m, lane);
    return v;
}
DI float* xrow_ptr(const KP& p, int row) { return row < TL ? p.out + (size_t)row * D : (float*)(p.ws + WS_XC) + (size_t)(row - TL) * D; }
DI const float* xin_ptr(const KP& p, int row) { return row < TL ? p.in[I_X] + (size_t)row * D : p.in[I_CTX] + (size_t)(row - TL) * D; }
DI int modidx(int row) { return row < TL ? (row >> 12) : 4; }
DI int scan_row(int b, int d, int s) { if (s < CTXL) { const int t = d ? CTXL - 1 - s : s; return TL + b * CTXL + t; } int t = s - CTXL; t = d ? SEQ - 1 - t : t; return b * SEQ + t; }

template <int KIND> DI int srccol(int n) {
    if (KIND == 0) {
        if (n < 2048) return n;
        if (n < 3584) return n + 16;
        if (n < 7168) return n + 32;
        if (n < 7184) return 2048 + (n - 7168);
        if (n < 7200) return 3600 + (n - 7184);
        if (n < 7232) return n;
        return -1;
    }
    if (KIND == 2) { const int pn = n >> 8, bj = (n >> 7) & 1, cl = n & 127; return bj * DFF + pn * 128 + cl; }
    return n;
}
constexpr int CT_IN = (NINP / 128) * (D / 64), CT_OUT = (D / 128) * (D / 64), CT_UP = (NUP / 128) * (D / 64), CT_DN = (D / 128) * (DFF / 64);
struct ConvTile { const float* W; bf16_t* dst; int Nsrc, Kd, n0, k0, kind; };
DI ConvTile conv_decode(const KP& p, int l, int t  ) {
    ConvTile c;
    if (t < CT_IN) { c.kind = 0; c.W = p.in[I_WIN] + (size_t)l * D * NIN; c.Nsrc = NIN; c.dst = (bf16_t*)(p.ws + WS_WIN); c.Kd = D; c.n0 = (t / (D / 64)) * 128; c.k0 = (t % (D / 64)) * 64; return c; }
    t -= CT_IN;
    if (t < CT_OUT) { c.kind = 1; c.W = p.in[I_WOUT] + (size_t)l * D * D; c.Nsrc = D; c.dst = (bf16_t*)(p.ws + WS_WOUT); c.Kd = D; c.n0 = (t / (D / 64)) * 128; c.k0 = (t % (D / 64)) * 64; return c; }
    t -= CT_OUT;
    if (t < CT_UP) { c.kind = 2; c.W = p.in[I_WUP] + (size_t)l * D * NUP; c.Nsrc = NUP; c.dst = (bf16_t*)(p.ws + WS_WUP); c.Kd = D; c.n0 = (t / (D / 64)) * 128; c.k0 = (t % (D / 64)) * 64; return c; }
    t -= CT_UP;
    c.kind = 3; c.W = p.in[I_WDN] + (size_t)l * DFF * D; c.Nsrc = D; c.dst = (bf16_t*)(p.ws + WS_WDN); c.Kd = DFF; c.n0 = (t / (DFF / 64)) * 128; c.k0 = (t % (DFF / 64)) * 64; return c;
}
DI int conv_srccol(int kind, int n) { return kind == 0 ? srccol<0>(n) : kind == 2 ? srccol<2>(n) : n; }
DI void conv_load(const ConvTile& c, int tid, f32x4 (&v)[4]) {
    const int r = tid >> 5, c4 = (tid & 31) * 4;
    const int sc = conv_srccol(c.kind, c.n0 + c4);
#pragma unroll
    for (int i = 0; i < 4; ++i) { v[i] = (f32x4){0.f, 0.f, 0.f, 0.f}; if (sc >= 0) v[i] = *(const f32x4*)(c.W + (size_t)(c.k0 + r + 16 * i) * c.Nsrc + sc); }
}
__device__ void convert_weights(const KP& p, int l, int t_lo, int t_hi, int w, int nw, unsigned char* smem) {
    float* tile = (float*)smem;
    const int tid = otid();
    int t = t_lo + w;
    if (t >= t_hi) return;
    ConvTile c = conv_decode(p, l, t);
    f32x4 v[4]; conv_load(c, tid, v);
    for (;;) {
        const int tn = t + nw; const bool more = tn < t_hi;
        ConvTile cn = c; f32x4 vn[4];
        if (more) { cn = conv_decode(p, l, tn); conv_load(cn, tid, vn); }
        {
            const int r = tid >> 5, c4 = (tid & 31) * 4;
#pragma unroll
            for (int i = 0; i < 4; ++i) { float* q = tile + (r + 16 * i) * 129 + c4; q[0] = v[i][0]; q[1] = v[i][1]; q[2] = v[i][2]; q[3] = v[i][3]; }
        }
        __syncthreads();
        {
            const int n = tid >> 2, ks = (tid & 3) * 16;
            float f[16];
#pragma unroll
            for (int j = 0; j < 16; ++j) f[j] = tile[(ks + j) * 129 + n];
            u32x4 w0, w1;
            w0.x = pk2(f[0], f[1]); w0.y = pk2(f[2], f[3]); w0.z = pk2(f[4], f[5]); w0.w = pk2(f[6], f[7]);
            w1.x = pk2(f[8], f[9]); w1.y = pk2(f[10], f[11]); w1.z = pk2(f[12], f[13]); w1.w = pk2(f[14], f[15]);
            bf16_t* q = c.dst + (size_t)(c.n0 + n) * c.Kd + c.k0 + ks;
            *(u32x4*)q = w0; *(u32x4*)(q + 8) = w1;
        }
        __syncthreads();
        if (!more) break;
        t = tn; c = cn;
#pragma unroll
        for (int i = 0; i < 4; ++i) v[i] = vn[i];
    }
}

__device__ void phase_init(const KP& p, unsigned char* smem) {
    const int tid = otid(), bid = obid(), nb = ogdim();
    float* sil = (float*)smem;
    float* red = sil + 5 * 2048;
    for (int i = tid; i < 5 * 2048; i += 512) { const int r = i >> 11, k = i & 2047; const float v = r < 4 ? p.in[I_C][r * 2048 + k] : p.in[I_CCTX][k]; sil[i] = silu_f(v); }
    __syncthreads();
    float* mod = (float*)(p.ws + WS_MOD);
    for (int chunk = bid; chunk < 256; chunk += nb) {
        const int l = chunk >> 7, n0 = (chunk & 127) * 96;
        const float* W = p.in[I_ADAW] + (size_t)l * D * NMOD;
        const int kp = tid >> 5, cc = tid & 31;
        float acc[3][5];
#pragma unroll
        for (int j = 0; j < 3; ++j)
#pragma unroll
            for (int r = 0; r < 5; ++r) acc[j][r] = 0.f;
#pragma unroll 8
        for (int k = kp; k < D; k += 16) {
            const float* wr = W + (size_t)k * NMOD + n0 + cc;
            const float w0 = wr[0], w1 = wr[32], w2 = wr[64];
#pragma unroll
            for (int r = 0; r < 5; ++r) { const float s = sil[r * 2048 + k]; acc[0][r] += s * w0; acc[1][r] += s * w1; acc[2][r] += s * w2; }
        }
#pragma unroll
        for (int j = 0; j < 3; ++j)
#pragma unroll
            for (int r = 0; r < 5; ++r) red[(kp * 96 + j * 32 + cc) * 5 + r] = acc[j][r];
        __syncthreads();
        if (tid < 480) {
            const int col = tid / 5, r = tid % 5; float s = 0.f;
#pragma unroll
            for (int k2 = 0; k2 < 16; ++k2) s += red[(k2 * 96 + col) * 5 + r];
            mod[(size_t)(l * 5 + r) * NMOD + n0 + col] = s + p.in[I_ADAB][l * NMOD + n0 + col];
        }
        __syncthreads();
    }
    convert_weights(p, 0, 0, CT_IN, bid, nb, smem);
}

DI void ln_stats(const f32x4 (&v)[8], int lane, float& mean, float& rstd) {
    float s = 0.f;
#pragma unroll
    for (int i = 0; i < 8; ++i) s += (v[i][0] + v[i][1]) + (v[i][2] + v[i][3]);
    s = wave_sum(s, lane); mean = s * (1.f / D);
    float q = 0.f;
#pragma unroll
    for (int i = 0; i < 8; ++i) { const f32x4 dd = v[i] - mean; q += (dd[0] * dd[0] + dd[1] * dd[1]) + (dd[2] * dd[2] + dd[3] * dd[3]); }
    q = wave_sum(q, lane); rstd = rsqrtf(q * (1.f / D) + EPS);
}
template <bool FIRST, bool MOD, bool FROM_INPUT>
DI void row_load(const KP& p, int row, int lane, const float* ycf, int nsplit, f32x4 (&v)[8], f32x4 (&y)[8]) {
    const float* xi = FROM_INPUT ? xin_ptr(p, row) : xrow_ptr(p, row);
#pragma unroll
    for (int i = 0; i < 8; ++i) v[i] = ((const f32x4*)xi)[i * 64 + lane];
    if (FIRST) {
        if (ycf != nullptr && row >= TL) {
            const float* yr = ycf + (size_t)(row - TL) * D;
#pragma unroll
            for (int i = 0; i < 8; ++i) y[i] = ((const f32x4*)yr)[i * 64 + lane];
            for (int sp = 1; sp < nsplit; ++sp) {
                yr += (size_t)TC * D;
#pragma unroll
                for (int i = 0; i < 8; ++i) y[i] += ((const f32x4*)yr)[i * 64 + lane];
            }
        } else {
            const bf16_t* yr = (const bf16_t*)(p.ws + WS_YS) + (size_t)row * D;
#pragma unroll
            for (int i = 0; i < 8; ++i) { const u32x2 t = ((const u32x2*)yr)[i * 64 + lane];
                y[i][0] = __uint_as_float(t[0] << 16); y[i][1] = __uint_as_float(t[0] & 0xffff0000u); y[i][2] = __uint_as_float(t[1] << 16); y[i][3] = __uint_as_float(t[1] & 0xffff0000u); }
        }
    }
}
template <bool FIRST, bool MOD>
DI void row_compute(const KP& p, int row, int lane, f32x4 (&v)[8], const f32x4 (&y)[8], const float* pg, const float* pb, const float* modl, int shoff, int scoff) {
    float mean, rstd;
    if (FIRST) {
        float* xr = xrow_ptr(p, row);
#pragma unroll
        for (int i = 0; i < 8; ++i) v[i] = ALPHA * v[i] + y[i];
        ln_stats(v, lane, mean, rstd);
#pragma unroll
        for (int i = 0; i < 8; ++i) {
            const f32x4 g = ((const f32x4*)pg)[i * 64 + lane], b = ((const f32x4*)pb)[i * 64 + lane];
            v[i] = (v[i] - mean) * rstd * g + b;
            ((f32x4*)xr)[i * 64 + lane] = v[i];
        }
    }
    if (MOD) {
        ln_stats(v, lane, mean, rstd);
        const float* mb = modl + (size_t)modidx(row) * NMOD;
        bf16_t* H = (bf16_t*)(p.ws + WS_H);
#pragma unroll
        for (int i = 0; i < 8; ++i) {
            const f32x4 sh = ((const f32x4*)(mb + shoff))[i * 64 + lane], sc = ((const f32x4*)(mb + scoff))[i * 64 + lane];
            const f32x4 o = (v[i] - mean) * rstd * (1.f + sc) + sh;
            u32x2 w; w[0] = pg8::cvt_pk_bf16(o[0], o[1]); w[1] = pg8::cvt_pk_bf16(o[2], o[3]);
            ((u32x2*)(H + (size_t)row * D))[i * 64 + lane] = w;
        }
    }
}
template <bool FIRST, bool MOD, bool FROM_INPUT = false>
__device__ void phase_row(const KP& p, int Mrows, const float* pg, const float* pb, const float* modl  , int shoff, int scoff, const float* ycf = nullptr, int nsplit = 0) {
    const int tid = otid(); const int lane = tid & 63, wid = tid >> 6;
    const int stride = ogdim() * 8;
    for (int row = obid() * 8 + wid; row < Mrows; row += 2 * stride) {
        const int row1 = row + stride; const bool has1 = row1 < Mrows;
        f32x4 v0[8], v1[8], y0[8], y1[8];
        row_load<FIRST, MOD, FROM_INPUT>(p, row, lane, ycf, nsplit, v0, y0);
        if (has1) row_load<FIRST, MOD, FROM_INPUT>(p, row1, lane, ycf, nsplit, v1, y1);
        row_compute<FIRST, MOD>(p, row, lane, v0, y0, pg, pb, modl, shoff, scoff);
        if (has1) row_compute<FIRST, MOD>(p, row1, lane, v1, y1, pg, pb, modl, shoff, scoff);
    }
}

struct EpiAll {
    static constexpr bool PERM = true, AFTER_DRAIN = false;
    int kind; bf16_t* O; float* G; const float* gmod;
    DI void operator()(const f32x4 (&acc)[2][2][4][2], const pg8::Unit& u, int wr, int wc, int fr, int fq) const {
        const int row0 = u.pm * 256 + wr * 64 + fr;
        if (kind == 0) {
            if (u.pn < 28) {
                const int col0 = u.pn * 256 + wc * 32 + 8 * fq;
#pragma unroll
                for (int ai = 0; ai < 2; ++ai)
#pragma unroll
                    for (int m = 0; m < 4; ++m) {
                        bf16_t* rowp = O + (size_t)(row0 + ai * 128 + m * 16) * NU + col0;
#pragma unroll
                        for (int bj = 0; bj < 2; ++bj) {
                            const f32x4 v0 = acc[ai][bj][m][0], v1 = acc[ai][bj][m][1];
                            u32x4 w; w.x = pg8::cvt_pk_bf16(v0[0], v0[1]); w.y = pg8::cvt_pk_bf16(v0[2], v0[3]); w.z = pg8::cvt_pk_bf16(v1[0], v1[1]); w.w = pg8::cvt_pk_bf16(v1[2], v1[3]);
                            *(u32x4*)(rowp + bj * 128) = w;
                        }
                    }
            } else if (wc < 2) {
                const int col0 = wc * 32 + 8 * fq;
#pragma unroll
                for (int ai = 0; ai < 2; ++ai)
#pragma unroll
                    for (int m = 0; m < 4; ++m) {
                        float* rowp = G + (size_t)(row0 + ai * 128 + m * 16) * 64 + col0;
                        *(f32x4*)rowp = acc[ai][0][m][0]; *(f32x4*)(rowp + 4) = acc[ai][0][m][1];
                    }
            }
        } else if (kind == 1) {
            const int col0 = u.pn * 256 + wc * 32 + 8 * fq;
            const int mi = u.pm < 64 ? (u.pm >> 4) : 4;
            const float* gp = gmod + (size_t)mi * NMOD + col0;
            f32x4 gv[2][2];
#pragma unroll
            for (int bj = 0; bj < 2; ++bj)
#pragma unroll
                for (int n = 0; n < 2; ++n) gv[bj][n] = *(const f32x4*)(gp + bj * 128 + n * 4);
#pragma unroll
            for (int ai = 0; ai < 2; ++ai)
#pragma unroll
                for (int m = 0; m < 4; ++m) {
                    bf16_t* rowp = O + (size_t)(row0 + ai * 128 + m * 16) * D + col0;
#pragma unroll
                    for (int bj = 0; bj < 2; ++bj) {
                        const f32x4 v0 = gv[bj][0] * acc[ai][bj][m][0], v1 = gv[bj][1] * acc[ai][bj][m][1];
                        u32x4 w; w.x = pg8::cvt_pk_bf16(v0[0], v0[1]); w.y = pg8::cvt_pk_bf16(v0[2], v0[3]); w.z = pg8::cvt_pk_bf16(v1[0], v1[1]); w.w = pg8::cvt_pk_bf16(v1[2], v1[3]);
                        *(u32x4*)(rowp + bj * 128) = w;
                    }
                }
        } else if (kind == 3) {
            const int col0 = u.pn * 256 + wc * 32 + 8 * fq;
            const float* gp = gmod + (size_t)4 * NMOD + col0;
            f32x4 gv[2][2];
#pragma unroll
            for (int bj = 0; bj < 2; ++bj)
#pragma unroll
                for (int n = 0; n < 2; ++n) gv[bj][n] = *(const f32x4*)(gp + bj * 128 + n * 4);
            float* Pk = G + (size_t)u.ks * TC * D;
#pragma unroll
            for (int ai = 0; ai < 2; ++ai)
#pragma unroll
                for (int m = 0; m < 4; ++m) {
                    float* rowp = Pk + (size_t)(row0 + ai * 128 + m * 16) * D + col0;
#pragma unroll
                    for (int bj = 0; bj < 2; ++bj)
#pragma unroll
                        for (int n = 0; n < 2; ++n) *(f32x4*)(rowp + bj * 128 + n * 4) = gv[bj][n] * acc[ai][bj][m][n];
                }
        } else {
            const int col0 = u.pn * 128 + wc * 32 + 8 * fq;
#pragma unroll
            for (int ai = 0; ai < 2; ++ai)
#pragma unroll
                for (int m = 0; m < 4; ++m) {
                    bf16_t* rowp = O + (size_t)(row0 + ai * 128 + m * 16) * DFF + col0;
                    f32x4 v0, v1;
#pragma unroll
                    for (int j = 0; j < 4; ++j) { v0[j] = silu_f(acc[ai][0][m][0][j]) * acc[ai][1][m][0][j]; v1[j] = silu_f(acc[ai][0][m][1][j]) * acc[ai][1][m][1][j]; }
                    u32x4 w; w.x = pg8::cvt_pk_bf16(v0[0], v0[1]); w.y = pg8::cvt_pk_bf16(v0[2], v0[3]); w.z = pg8::cvt_pk_bf16(v1[0], v1[1]); w.w = pg8::cvt_pk_bf16(v1[2], v1[3]);
                    *(u32x4*)rowp = w;
                }
        }
    }
};
struct SplitOrder {
    int nsplit, G, c;
    __device__ bool next(int i, pg8::Unit& u) const {
        const int L = i * G + c; if (L >= 32 * nsplit) return false;
        const int tile = L / nsplit; u.ks = L % nsplit; u.pm = tile >> 3; u.pn = tile & 7; return true;
    }
    DI void a_ready(const pg8::Unit&) const {}
    DI void done(const pg8::Unit&) const {}
};
template <class Epi> DI void run_gemm(unsigned char* smem, const bf16_t* A, const bf16_t* Bt, int M, int N, int K, const Epi& E) {
    pg8::Gemm g; g.A = A; g.Bt = Bt; g.M = M; g.N = N; g.K = K; g.ld = K;
    pg8::StaticOrder S; S.init(M, N, ogdim(), obid());
    pg8::gemm_phase<Epi, pg8::StaticOrder, false>((PG8_LAS unsigned char*)smem, g, S, E, nullptr);
}

__device__ void phase_pre(const KP& p, int l, unsigned char* smem) {
    const int tid = otid();
    bf16_t* U = (bf16_t*)(p.ws + WS_U);
    const float* G = (const float*)(p.ws + WS_GATES);
    bf16_t* X = (bf16_t*)(p.ws + WS_XBC);
    float2* GL = (float2*)(p.ws + WS_GL);
    constexpr int NGLA = 2 * (T / 64), NR16 = T / 16;
    for (int it = obid(); it < NGLA + 2 * NR16; it += ogdim()) {
        if (it < NGLA) {
            const int blk = it >> 1, gd = it & 1, r0 = blk * 64;
            const int half = tid >> 8, gch = tid & 255;
            float* as = (float*)smem;
            float* tot = as + 64 * 16;
            __syncthreads();
            if (tid < 256) { const int t = tid >> 2, c4 = (tid & 3) * 4; *(f32x4*)(as + t * 16 + c4) = *(const f32x4*)(G + (size_t)(r0 + t) * 64 + 32 + gd * 16 + c4); }
            float gw[16];
#pragma unroll
            for (int r = 0; r < 16; ++r) gw[r] = p.in[I_GGW][((size_t)(l * 2 + gd) * 16 + r) * 256 + gch];
            const float gb = p.in[I_GGB][(l * 2 + gd) * 256 + gch];
            bf16_t* QG = (bf16_t*)(p.ws + WS_QG) + (size_t)gd * T * 256 + gch;
            bf16_t* KG = (bf16_t*)(p.ws + WS_KG) + (size_t)gd * T * 256 + gch;
            __syncthreads();
            float* las = tot + 256;
            float lsum = 0.f;
#pragma unroll 2
            for (int j = 0; j < 32; ++j) {
                const int sp = half * 32 + j, t = gd ? 63 - sp : sp;
                const float* ar = as + t * 16;
                float x = gb;
#pragma unroll
                for (int r4 = 0; r4 < 4; ++r4) { const f32x4 a4 = *(const f32x4*)(ar + r4 * 4); x += a4[0] * gw[r4 * 4] + a4[1] * gw[r4 * 4 + 1] + a4[2] * gw[r4 * 4 + 2] + a4[3] * gw[r4 * 4 + 3]; }
                const float lv = logsigmoid_f(x) * (1.f / 16.f); las[j * 512 + tid] = lv; lsum += lv;
            }
            if (half == 0) tot[gch] = lsum;
            __syncthreads();
            float bsum = half ? tot[gch] : 0.f;
            if (half) ((float*)(p.ws + WS_EE))[((size_t)gd * (T / 64) + blk) * 256 + gch] = __expf(bsum + lsum);
            for (int tb = 0; tb < 32; tb += 8) {
                unsigned short qv[8], kv[8];
#pragma unroll
                for (int j = 0; j < 8; ++j) { const int sp = half * 32 + tb + j, t = gd ? 63 - sp : sp; qv[j] = U[(size_t)(r0 + t) * NU + U_GQ + gch]; kv[j] = U[(size_t)(r0 + t) * NU + U_GK + gch]; }
#pragma unroll
                for (int j = 0; j < 8; ++j) {
                    const int sp = half * 32 + tb + j, t = gd ? 63 - sp : sp;
                    bsum += las[(tb + j) * 512 + tid];
                    QG[(size_t)(r0 + t) * 256] = f2bf(bf2f(qv[j]) * __expf(bsum) * 0.125f);
                    KG[(size_t)(r0 + t) * 256] = f2bf(bf2f(kv[j]) * __expf(-bsum));
                }
            }
        } else if (it < NGLA + NR16) {
            const int r0 = (it - NGLA) * 16, c0 = 2 * tid;
            int t0, L; if (r0 < TL) { t0 = r0 & (SEQ - 1); L = SEQ; } else { t0 = (r0 - TL) & (CTXL - 1); L = CTXL; }
            const float* cw = p.in[I_SCONVW] + (size_t)l * 3 * 1024; const float* cb = p.in[I_SCONVB] + (size_t)l * 1024;
            const float2 w0 = *(const float2*)(cw + c0), w1 = *(const float2*)(cw + 1024 + c0), w2 = *(const float2*)(cw + 2048 + c0), bb = *(const float2*)(cb + c0);
            const bf16_t* up = U + (size_t)r0 * NU + U_XBC + c0;
            unsigned x[18];
            x[0] = t0 > 0 ? *(const unsigned*)(up - NU) : 0u;
#pragma unroll
            for (int j = 0; j < 16; ++j) x[j + 1] = *(const unsigned*)(up + (size_t)j * NU);
            x[17] = (t0 + 16 < L) ? *(const unsigned*)(up + (size_t)16 * NU) : 0u;
#pragma unroll
            for (int j = 0; j < 16; ++j) {
                const float o0 = bb.x + w0.x * bf2f(x[j] & 0xffff) + w1.x * bf2f(x[j + 1] & 0xffff) + w2.x * bf2f(x[j + 2] & 0xffff);
                const float o1 = bb.y + w0.y * bf2f(x[j] >> 16) + w1.y * bf2f(x[j + 1] >> 16) + w2.y * bf2f(x[j + 2] >> 16);
                *(unsigned*)(X + (size_t)(r0 + j) * 1024 + c0) = pk2(silu_f(o0), silu_f(o1));
            }
        } else {
            const int r0 = (it - NGLA - NR16) * 16;
            {
                const int rsel = tid >> 8, pp = tid & 255, isk = pp >> 7, idx = (2 * pp) & 255, rh = idx >> 6, rhalf = (idx >> 5) & 1, ri = idx & 31;
                const int rcol = (isk ? U_RK : U_RQ) + rh * 128 + rhalf * 64 + ri;
                const float rscale = isk ? 0.08838834764831845f : 1.f;
                const float f0 = exp2f(-(float)ri * (13.287712379549449f / 32.f)), f1 = exp2f(-(float)(ri + 1) * (13.287712379549449f / 32.f));
                unsigned a[8], b[8];
#pragma unroll
                for (int j = 0; j < 8; ++j) { const bf16_t* q = U + (size_t)(r0 + rsel * 8 + j) * NU + rcol; a[j] = *(const unsigned*)q; b[j] = *(const unsigned*)(q + 32); }
#pragma unroll
                for (int j = 0; j < 8; ++j) {
                    const int row = r0 + rsel * 8 + j;
                    float x1a = bf2f(a[j] & 0xffff), x1b = bf2f(a[j] >> 16), x2a = bf2f(b[j] & 0xffff), x2b = bf2f(b[j] >> 16);
                    if (row < TL) {
                        const int t = row & (SEQ - 1);
                        const float pos = (float)(rhalf ? (t & 63) : (t >> 6));
                        float ra = pos * f0 * 0.15915494309189535f, rb = pos * f1 * 0.15915494309189535f; ra -= floorf(ra); rb -= floorf(rb);
                        const float sa = __builtin_amdgcn_sinf(ra), ca = __builtin_amdgcn_cosf(ra), sb = __builtin_amdgcn_sinf(rb), cbv = __builtin_amdgcn_cosf(rb);
                        const float y1a = x1a * ca - x2a * sa, y2a = x1a * sa + x2a * ca, y1b = x1b * cbv - x2b * sb, y2b = x1b * sb + x2b * cbv;
                        x1a = y1a; x2a = y2a; x1b = y1b; x2b = y2b;
                    }
                    bf16_t* q = U + (size_t)row * NU + rcol;
                    *(unsigned*)q = pk2(x1a * rscale, x1b * rscale); *(unsigned*)(q + 32) = pk2(x2a * rscale, x2b * rscale);
                }
            }
            {
                const int row = r0 + (tid >> 5), ds = tid & 31, d = ds >> 4, slot = ds & 15;
                const float* gr = G + (size_t)row * 64;
                float loga, logw;
                if (slot < 4) {
                    const int h = slot;
                    logw = gr[d * 4 + h] + p.in[I_MIGB][(l * 2 + d) * 4 + h];
                    loga = logsigmoid_f(gr[8 + d * 4 + h] + p.in[I_MFGB][(l * 2 + d) * 4 + h]);
                } else if (slot < 12) {
                    const int h = slot - 4;
                    const float dt = softplus_f(gr[16 + d * 8 + h] + p.in[I_SDTB][(l * 2 + d) * 8 + h]);
                    loga = -dt * __expf(p.in[I_SALOG][(l * 2 + d) * 8 + h]); logw = __logf(dt);
                } else {
                    const int h = slot - 12;
                    loga = -__expf(p.in[I_RDECAY][(l * 2 + d) * 4 + h]); logw = 0.f;
                }
                GL[(size_t)(d * 16 + slot) * T + row] = make_float2(loga, logw);
            }
        }
    }
}

typedef short s16x4 __attribute__((ext_vector_type(4)));
#define LDSP(T_, ptr) ((__attribute__((address_space(3))) T_*)(ptr))
DI bf16x8 tr_frag(const bf16_t* lo_addr, int row_stride  ) {
    const s16x4 lo = __builtin_amdgcn_ds_read_tr16_b64_v4i16(LDSP(s16x4, lo_addr));
    const s16x4 hi = __builtin_amdgcn_ds_read_tr16_b64_v4i16(LDSP(s16x4, lo_addr + 4 * row_stride));
    return __builtin_shufflevector(lo, hi, 0, 1, 2, 3, 4, 5, 6, 7);
}
#define MFMA16(a, b, c) __builtin_amdgcn_mfma_f32_16x16x32_bf16((a), (b), (c), 0, 0, 0)
template <int MIX, bool DEN> struct ScanCfg {
    static constexpr int DK = MIX == 3 ? 64 : 128, NH = MIX == 1 ? 2 : 1, NT = DK / 16, KS2 = DK / 32;
    static constexpr int NVC = DEN ? 144 : 128;
    static constexpr int QST = DK + 8, VST = NVC + 8, PST = 72;
    static constexpr int SZQ = 64 * QST * 2, SZV = 64 * VST * 2, SZVEC = NH * 320 * 4;
    static constexpr int OFF_K = SZQ, OFF_V = 2 * SZQ, OFF_VEC = 2 * SZQ + SZV, BUF = 2 * SZQ + SZV + SZVEC;
    static constexpr int OFF_PW = 2 * BUF, SZP = NH * 64 * PST * 2;
    static_assert(OFF_PW + SZP <= LDS_BYTES, "scan LDS layout");
};
DI int chunk_base(int b, int d, int c) { if (c < 4) return TL + b * CTXL + (d ? 3 - c : c) * 64; const int cc = c - 4; return b * SEQ + (d ? 63 - cc : cc) * 64; }

template <int MIX, bool DEN>
__device__ void scan_item(const KP& p, int b, int d, int grp, unsigned char* smem) {
    using C = ScanCfg<MIX, DEN>;
    constexpr int DK = C::DK, NH = C::NH, NT = C::NT, KS2 = C::KS2, QST = C::QST, VST = C::VST, PST = C::PST;
    constexpr int QPR = DK / 8;
    constexpr int NQP = (64 * QPR) / 512;
    const int tid = otid(), lane = tid & 63, wid = __builtin_amdgcn_readfirstlane(tid >> 6);
    const int l15 = lane & 15, g4 = lane >> 4, tq = l15 >> 2, tp = l15 & 3;
    const bf16_t* U = (const bf16_t*)(p.ws + WS_U); const bf16_t* X = (const bf16_t*)(p.ws + WS_XBC);
    const bf16_t *qsrc, *ksrc, *vsrc; int qld, vld;
    if (MIX == 0) { qsrc = U + U_MQ + grp * 128; ksrc = U + U_MK + grp * 128; vsrc = U + U_MV + grp * 128; qld = NU; vld = NU; }
    if (MIX == 1) { qsrc = X + 768 + (grp >> 1) * 128; ksrc = X + 512 + (grp >> 1) * 128; vsrc = X + grp * 128; qld = 1024; vld = 1024; }
    if (MIX == 2) { qsrc = U + U_RQ + grp * 128; ksrc = U + U_RK + grp * 128; vsrc = U + U_RV + grp * 128; qld = NU; vld = NU; }
    if (MIX == 3) { qsrc = (const bf16_t*)(p.ws + WS_QG) + (size_t)d * T * 256 + grp * 64; ksrc = (const bf16_t*)(p.ws + WS_KG) + (size_t)d * T * 256 + grp * 64; vsrc = U + U_GV + grp * 128; qld = 256; vld = NU; }
    const int slot0 = MIX == 0 ? grp : MIX == 1 ? 4 + 2 * grp : 12 + grp;
    const float2* GL = (const float2*)(p.ws + WS_GL) + (size_t)(d * 16 + slot0 + (wid < NH ? wid : 0)) * T;
    const float* EE = (const float*)(p.ws + WS_EE) + (size_t)d * (T / 64) * 256 + grp * 64;
    bf16_t* YS = (bf16_t*)(p.ws + WS_YS) + (size_t)d * T * D + MIX * 512 + grp * 128;
    float* DENP = (float*)(p.ws + WS_DEN) + (size_t)d * T * 4 + grp;
    constexpr float LOGQS = MIX == 0 ? -2.4260151319598084f : 0.f;

    __syncthreads();
    for (int i = tid; i < C::SZP / 4; i += 512) ((unsigned*)(smem + C::OFF_PW))[i] = 0u;
    if (DEN) {
        for (int i = tid; i < 2 * 64 * 16; i += 512) { const int bf = i >> 10, r = (i >> 4) & 63, cc = i & 15; ((bf16_t*)(smem + bf * C::BUF + C::OFF_V))[r * VST + 128 + cc] = cc == 0 ? (bf16_t)0x3F80 : (bf16_t)0; }
    }
    f32x4 S0[NT];
#pragma unroll
    for (int t = 0; t < NT; ++t) S0[t] = (f32x4){0.f, 0.f, 0.f, 0.f};

    u32x4 rqA[NQP], rkA[NQP], rvA[2], rqB[NQP], rkB[NQP], rvB[2]; float gxA = 0.f, gyA = 0.f, eeA = 0.f, gxB = 0.f, gyB = 0.f, eeB = 0.f;
#define ISSUE_ALL(c_, S_) do { \
        const int base_ = chunk_base(b, d, (c_)); \
_Pragma("unroll") \
        for (int i = 0; i < NQP; ++i) { const int pc = tid + 512 * i, r = pc / QPR, c8 = pc % QPR; const size_t row = (size_t)(base_ + (d ? 63 - r : r)); \
            rq##S_[i] = *(const u32x4*)(qsrc + row * qld + c8 * 8); rk##S_[i] = *(const u32x4*)(ksrc + row * qld + c8 * 8); } \
_Pragma("unroll") \
        for (int i = 0; i < 2; ++i) { const int pc = tid + 512 * i, r = pc >> 4, c8 = pc & 15; const size_t row = (size_t)(base_ + (d ? 63 - r : r)); \
            rv##S_[i] = *(const u32x4*)(vsrc + row * vld + c8 * 8); } \
        if (MIX != 3) { if (wid < NH) { const float2 g_ = GL[base_ + (d ? 63 - lane : lane)]; gx##S_ = g_.x; gy##S_ = g_.y; } } \
        else if (wid == 0) ee##S_ = EE[(size_t)(base_ >> 6) * 256 + lane]; \
    } while (0)
#define STAGE_ALL(bufi, S_) do { \
        unsigned char* B_ = smem + (bufi) * C::BUF; \
_Pragma("unroll") \
        for (int i = 0; i < NQP; ++i) { const int pc = tid + 512 * i, r = pc / QPR, c8 = pc % QPR; \
            *(u32x4*)((bf16_t*)B_ + r * QST + c8 * 8) = rq##S_[i]; *(u32x4*)((bf16_t*)(B_ + C::OFF_K) + r * QST + c8 * 8) = rk##S_[i]; } \
_Pragma("unroll") \
        for (int i = 0; i < 2; ++i) { const int pc = tid + 512 * i, r = pc >> 4, c8 = pc & 15; *(u32x4*)((bf16_t*)(B_ + C::OFF_V) + r * VST + c8 * 8) = rv##S_[i]; } \
        float* vec_ = (float*)(B_ + C::OFF_VEC); \
        if (MIX != 3) { \
            if (wid < NH) { \
                float bc = gx##S_; \
                bc += __uint_as_float(__builtin_amdgcn_update_dpp(0, __float_as_uint(bc), 0x111, 0xf, 0xf, false)); \
                bc += __uint_as_float(__builtin_amdgcn_update_dpp(0, __float_as_uint(bc), 0x112, 0xf, 0xf, false)); \
                bc += __uint_as_float(__builtin_amdgcn_update_dpp(0, __float_as_uint(bc), 0x114, 0xf, 0xf, false)); \
                bc += __uint_as_float(__builtin_amdgcn_update_dpp(0, __float_as_uint(bc), 0x118, 0xf, 0xf, false)); \
                bc += __uint_as_float(__builtin_amdgcn_update_dpp(0, __float_as_uint(bc), 0x142, 0xa, 0xf, false)); \
                bc += __uint_as_float(__builtin_amdgcn_update_dpp(0, __float_as_uint(bc), 0x143, 0xc, 0xf, false)); \
                const float bend = __uint_as_float(__builtin_amdgcn_readlane(__float_as_uint(bc), 63)); \
                const float rt = bc + LOGQS, ct = gy##S_ - bc; \
                float* v = vec_ + wid * 320; \
                v[lane] = rt; v[64 + lane] = ct; v[128 + lane] = __expf(rt); v[192 + lane] = __expf(bend + ct); v[256 + lane] = __expf(bend); \
            } \
        } else if (wid == 0) vec_[256 + lane] = ee##S_; \
    } while (0)

    ISSUE_ALL(0, A);
    STAGE_ALL(0, A);
    ISSUE_ALL(1, B);
    __syncthreads();

    for (int c2 = 0; c2 < (CTXL + SEQ) / 64; c2 += 2) {
#pragma unroll
    for (int par = 0; par < 2; ++par) {
        const int c = c2 + par;
        const int cur = par;
        const int base = chunk_base(b, d, c);
        unsigned char* B = smem + cur * C::BUF;
        const bf16_t* Qs = (const bf16_t*)B; const bf16_t* Ks = (const bf16_t*)(B + C::OFF_K); const bf16_t* Vs = (const bf16_t*)(B + C::OFF_V);
        const float* vec = (const float*)(B + C::OFF_VEC);
        bf16_t* Pw = (bf16_t*)(smem + C::OFF_PW);
        bf16_t* ysb = YS + (size_t)base * D;
        if (c + 2 < (CTXL + SEQ) / 64) { if (par == 0) ISSUE_ALL(c + 2, A); else ISSUE_ALL(c + 2, B); }
#pragma unroll
        for (int rep = 0; rep < 2; ++rep) {
            const int tl = rep == 0 ? wid : wid + 2;
            if (rep == 1 && wid < 6) break;
            const int it = tl >= 6 ? 3 : tl >= 3 ? 2 : tl >= 1 ? 1 : 0, jt = tl - ((it * (it + 1)) >> 1);
            f32x4 acc = (f32x4){0.f, 0.f, 0.f, 0.f};
            bf16x8 pa[KS2], pb[KS2];
#pragma unroll
            for (int ks = 0; ks < KS2; ++ks) {
                pa[ks] = *LDSP(const bf16x8, Ks + (jt * 16 + l15) * QST + ks * 32 + g4 * 8);
                pb[ks] = *LDSP(const bf16x8, Qs + (it * 16 + l15) * QST + ks * 32 + g4 * 8);
            }
            __builtin_amdgcn_sched_barrier(0);
#pragma unroll
            for (int ks = 0; ks < KS2; ++ks) acc = MFMA16(pa[ks], pb[ks], acc);
            const int i = it * 16 + l15, j0 = jt * 16 + g4 * 4;
#pragma unroll
            for (int h = 0; h < NH; ++h) {
                float w[4];
                if (MIX != 3) {
                    const float rt = vec[h * 320 + i]; const f32x4 ct = *LDSP(const f32x4, vec + h * 320 + 64 + j0);
#pragma unroll
                    for (int r = 0; r < 4; ++r) w[r] = (j0 + r <= i) ? __expf(rt + ct[r]) : 0.f;
                } else {
#pragma unroll
                    for (int r = 0; r < 4; ++r) w[r] = (j0 + r <= i) ? 1.f : 0.f;
                }
                u32x2 o; o.x = pg8::cvt_pk_bf16(acc[0] * w[0], acc[1] * w[1]); o.y = pg8::cvt_pk_bf16(acc[2] * w[2], acc[3] * w[3]);
                *LDSP(u32x2, Pw + (h * 64 + i) * PST + j0) = o;
            }
        }
        __syncthreads();
#define SB_() __builtin_amdgcn_sched_barrier(0)
#define QFRAG(dst, it_, ks_) do { \
            const s16x4 a0_ = *LDSP(const s16x4, Qs + ((it_) * 16 + l15) * QST + (ks_) * 32 + g4 * 4); \
            const s16x4 a1_ = *LDSP(const s16x4, Qs + ((it_) * 16 + l15) * QST + (ks_) * 32 + 16 + g4 * 4); \
            dst = __builtin_shufflevector(a0_, a1_, 0, 1, 2, 3, 4, 5, 6, 7); } while (0)
#define SPACK(dst, S, ks_) do { u32x4 sb_; sb_.x = pg8::cvt_pk_bf16(S[2 * (ks_)][0], S[2 * (ks_)][1]); sb_.y = pg8::cvt_pk_bf16(S[2 * (ks_)][2], S[2 * (ks_)][3]); \
            sb_.z = pg8::cvt_pk_bf16(S[2 * (ks_) + 1][0], S[2 * (ks_) + 1][1]); sb_.w = pg8::cvt_pk_bf16(S[2 * (ks_) + 1][2], S[2 * (ks_) + 1][3]); dst = __builtin_bit_cast(bf16x8, sb_); } while (0)
#define SLICE(S, sl) do { \
            const int hh = MIX == 1 ? (sl) >> 2 : 0, vc0 = (sl) * 16; \
            const float* vh = vec + hh * 320; \
            f32x4 Y[4]; \
_Pragma("unroll") \
            for (int it = 0; it < 4; ++it) Y[it] = (f32x4){0.f, 0.f, 0.f, 0.f}; \
              \
            { bf16x8 QA[2][4]; \
_Pragma("unroll") \
              for (int ks = 0; ks < 2; ++ks) \
_Pragma("unroll") \
                for (int it = 0; it < 4; ++it) QFRAG(QA[ks][it], it, ks); \
              SB_(); \
_Pragma("unroll") \
              for (int ks = 0; ks < 2; ++ks) { bf16x8 sbf; SPACK(sbf, S, ks); \
_Pragma("unroll") \
                for (int it = 0; it < 4; ++it) Y[it] = MFMA16(sbf, QA[ks][it], Y[it]); } } \
            SB_(); \
            if (KS2 == 4) { bf16x8 QB[2][4]; \
_Pragma("unroll") \
              for (int ks = 0; ks < 2; ++ks) \
_Pragma("unroll") \
                for (int it = 0; it < 4; ++it) QFRAG(QB[ks][it], it, ks + 2); \
              SB_(); \
_Pragma("unroll") \
              for (int ks = 0; ks < 2; ++ks) { bf16x8 sbf; SPACK(sbf, S, ks + 2); \
_Pragma("unroll") \
                for (int it = 0; it < 4; ++it) Y[it] = MFMA16(sbf, QB[ks][it], Y[it]); } } \
            SB_(); \
              \
            bf16x8 Vf[2], PA[6]; \
_Pragma("unroll") \
            for (int ks = 0; ks < 2; ++ks) Vf[ks] = tr_frag(Vs + (ks * 32 + g4 * 8 + tq) * VST + vc0 + 4 * tp, VST); \
            PA[0] = *LDSP(const bf16x8, Pw + (hh * 64 + 0 * 16 + l15) * PST + 0 * 32 + g4 * 8); \
            PA[1] = *LDSP(const bf16x8, Pw + (hh * 64 + 1 * 16 + l15) * PST + 0 * 32 + g4 * 8); \
            PA[2] = *LDSP(const bf16x8, Pw + (hh * 64 + 2 * 16 + l15) * PST + 0 * 32 + g4 * 8); \
            PA[3] = *LDSP(const bf16x8, Pw + (hh * 64 + 2 * 16 + l15) * PST + 1 * 32 + g4 * 8); \
            PA[4] = *LDSP(const bf16x8, Pw + (hh * 64 + 3 * 16 + l15) * PST + 0 * 32 + g4 * 8); \
            PA[5] = *LDSP(const bf16x8, Pw + (hh * 64 + 3 * 16 + l15) * PST + 1 * 32 + g4 * 8); \
            if (MIX != 3) { \
_Pragma("unroll") \
                for (int it = 0; it < 4; ++it) Y[it] = Y[it] * vh[128 + it * 16 + l15]; \
            } \
            SB_(); \
            Y[0] = MFMA16(Vf[0], PA[0], Y[0]); Y[1] = MFMA16(Vf[0], PA[1], Y[1]); Y[2] = MFMA16(Vf[0], PA[2], Y[2]); Y[3] = MFMA16(Vf[0], PA[4], Y[3]); \
            Y[2] = MFMA16(Vf[1], PA[3], Y[2]); Y[3] = MFMA16(Vf[1], PA[5], Y[3]); \
            SB_(); \
              \
_Pragma("unroll") \
            for (int it = 0; it < 4; ++it) { \
                const int i = it * 16 + l15; const int ro = (d ? 63 - i : i); \
                const f32x4 y = Y[it]; \
                if (DEN) { if (g4 == 0) DENP[((size_t)base + ro) * 4] = y[0]; } \
                else { u32x2 o; o.x = pg8::cvt_pk_bf16(y[0], y[1]); o.y = pg8::cvt_pk_bf16(y[2], y[3]); *(u32x2*)(ysb + ro * D + vc0 + g4 * 4) = o; } \
            } \
            SB_(); \
            bf16x8 Vw[2]; float dec = 1.f; \
            if (MIX != 3) { \
                dec = vh[256]; \
_Pragma("unroll") \
                for (int ks = 0; ks < 2; ++ks) { \
                    const f32x4 w0 = *LDSP(const f32x4, vh + 192 + ks * 32 + g4 * 8), w1 = *LDSP(const f32x4, vh + 192 + ks * 32 + g4 * 8 + 4); \
                    u32x4 o; \
                    o.x = pg8::cvt_pk_bf16(bf2f((unsigned short)Vf[ks][0]) * w0[0], bf2f((unsigned short)Vf[ks][1]) * w0[1]); \
                    o.y = pg8::cvt_pk_bf16(bf2f((unsigned short)Vf[ks][2]) * w0[2], bf2f((unsigned short)Vf[ks][3]) * w0[3]); \
                    o.z = pg8::cvt_pk_bf16(bf2f((unsigned short)Vf[ks][4]) * w1[0], bf2f((unsigned short)Vf[ks][5]) * w1[1]); \
                    o.w = pg8::cvt_pk_bf16(bf2f((unsigned short)Vf[ks][6]) * w1[2], bf2f((unsigned short)Vf[ks][7]) * w1[3]); \
                    Vw[ks] = __builtin_bit_cast(bf16x8, o); \
                } \
            } else { Vw[0] = Vf[0]; Vw[1] = Vf[1]; } \
              \
_Pragma("unroll") \
            for (int th = 0; th < NT / 4; ++th) { \
                bf16x8 KA[4][2]; \
_Pragma("unroll") \
                for (int t = 0; t < 4; ++t) \
_Pragma("unroll") \
                    for (int ks = 0; ks < 2; ++ks) KA[t][ks] = tr_frag(Ks + (ks * 32 + g4 * 8 + tq) * QST + (th * 4 + t) * 16 + 4 * tp, QST); \
                SB_(); \
_Pragma("unroll") \
                for (int t = 0; t < 4; ++t) { \
                    f32x4 acc = S[th * 4 + t] * dec; \
                    acc = MFMA16(KA[t][0], Vw[0], acc); acc = MFMA16(KA[t][1], Vw[1], acc); \
                    if (MIX == 3) { const f32x4 e4 = *LDSP(const f32x4, vec + 256 + (th * 4 + t) * 16 + g4 * 4); acc = acc * e4; } \
                    S[th * 4 + t] = acc; \
                } \
                SB_(); \
            } \
    } while (0)
        if (!DEN) SLICE(S0, wid);
        else if (wid == 0) SLICE(S0, 8);
        if (c + 1 < (CTXL + SEQ) / 64) { if (par == 0) STAGE_ALL(1, B); else STAGE_ALL(0, A); }
        __syncthreads();
    }
    }
}
__device__ void phase_scan(const KP& p, int l, unsigned char* smem) {
    if (ogdim() > 160 && obid() >= 160) {
        const int w = obid() - 160, nw = ogdim() - 160;
        convert_weights(p, l, CT_IN, CT_IN + CT_OUT + CT_UP + CT_DN, w, nw, smem);
        if (l == 0) convert_weights(p, 1, 0, CT_IN, w, nw, smem);
        return;
    }
    for (int item = obid(); item < 160; item += ogdim()) {
        if (item >= 128) { const int idx = item - 128; scan_item<0, true>(p, idx >> 3, (idx >> 2) & 1, idx & 3, smem); continue; }
        const int grp = item & 3, mix = (item >> 2) & 3, d = (item >> 4) & 1, b = item >> 5;
        if (mix == 0) scan_item<0, false>(p, b, d, grp, smem);
        else if (mix == 1) scan_item<1, false>(p, b, d, grp, smem);
        else if (mix == 2) scan_item<2, false>(p, b, d, grp, smem);
        else scan_item<3, false>(p, b, d, grp, smem);
    }
    if (ogdim() <= 160) {
        convert_weights(p, l, CT_IN, CT_IN + CT_OUT + CT_UP + CT_DN, obid(), ogdim(), smem);
        if (l == 0) convert_weights(p, 1, 0, CT_IN, obid(), ogdim(), smem);
    }
}

struct CombRaw { bf16x8 a[4], b[4], g[4], xs[4]; float s0, s1; };
DI void comb_load(const KP& p, int row, int lane, int mixer, int ec0, int gcol, CombRaw& r) {
    const bf16_t* U = (const bf16_t*)(p.ws + WS_U); const bf16_t* X = (const bf16_t*)(p.ws + WS_XBC);
    const bf16_t* YS = (const bf16_t*)(p.ws + WS_YS); const float* DEN = (const float*)(p.ws + WS_DEN);
    const bf16_t* y0p = YS + (size_t)row * D + mixer * 512 + ec0; const bf16_t* y1p = y0p + (size_t)T * D;
    r.s0 = 1.f; r.s1 = 1.f;
    if (mixer == 0) { const int h = (lane & 15) >> 2; r.s0 = DEN[(size_t)row * 4 + h]; r.s1 = DEN[((size_t)T + row) * 4 + h]; }
#pragma unroll
    for (int i = 0; i < 4; ++i) { r.a[i] = *(const bf16x8*)(y0p + i * 8); r.b[i] = *(const bf16x8*)(y1p + i * 8); r.g[i] = *(const bf16x8*)(U + (size_t)row * NU + gcol + i * 8); }
    if (mixer == 1) {
#pragma unroll
        for (int i = 0; i < 4; ++i) r.xs[i] = *(const bf16x8*)(X + (size_t)row * 1024 + ec0 + i * 8);
    }
}
DI void comb_compute(const KP& p, int row, int lane, int mixer, int ec0, const float* gain, float sd, const CombRaw& r) {
    bf16_t* H = (bf16_t*)(p.ws + WS_H);
    float y[32], gt[32];
    float s0 = 1.f, s1 = 1.f;
    if (mixer == 0) { s0 = 1.f / fmaxf(fabsf(r.s0), 1.f); s1 = 1.f / fmaxf(fabsf(r.s1), 1.f); }
#pragma unroll
    for (int i = 0; i < 4; ++i) {
#pragma unroll
        for (int j = 0; j < 8; ++j) {
            y[i * 8 + j] = bf2f((unsigned short)r.a[i][j]) * s0 + bf2f((unsigned short)r.b[i][j]) * s1;
            const float gv = bf2f((unsigned short)r.g[i][j]);
            gt[i * 8 + j] = mixer == 0 ? sigmoid_f(gv) : silu_f(gv);
        }
    }
    if (mixer == 1) {
#pragma unroll
        for (int i = 0; i < 4; ++i) {
#pragma unroll
            for (int j = 0; j < 8; ++j) { y[i * 8 + j] = (y[i * 8 + j] + sd * bf2f((unsigned short)r.xs[i][j])) * gt[i * 8 + j]; gt[i * 8 + j] = 1.f; }
        }
    }
    float s = 0.f;
#pragma unroll
    for (int j = 0; j < 32; ++j) s += y[j];
    s += shx(s, 1, lane); s += shx(s, 2, lane);
    const float mean = (mixer == 0 || mixer == 2) ? s * (1.f / 128.f) : 0.f;
    float q = 0.f;
#pragma unroll
    for (int j = 0; j < 32; ++j) { y[j] -= mean; q += y[j] * y[j]; }
    q += shx(q, 1, lane); q += shx(q, 2, lane);
    float q16 = q; q16 += shx(q16, 4, lane); q16 += shx(q16, 8, lane);
    const float rstd = rsqrtf((mixer == 1 ? q16 * (1.f / 512.f) : q * (1.f / 128.f)) + EPS);
    bf16_t* op = H + (size_t)row * D + mixer * 512 + ec0;
#pragma unroll
    for (int i = 0; i < 4; ++i) {
        const f32x4 g0 = *(const f32x4*)(gain + i * 8), g1 = *(const f32x4*)(gain + i * 8 + 4);
        u32x4 w;
        w.x = pg8::cvt_pk_bf16(y[i * 8 + 0] * rstd * g0[0] * gt[i * 8 + 0], y[i * 8 + 1] * rstd * g0[1] * gt[i * 8 + 1]);
        w.y = pg8::cvt_pk_bf16(y[i * 8 + 2] * rstd * g0[2] * gt[i * 8 + 2], y[i * 8 + 3] * rstd * g0[3] * gt[i * 8 + 3]);
        w.z = pg8::cvt_pk_bf16(y[i * 8 + 4] * rstd * g1[0] * gt[i * 8 + 4], y[i * 8 + 5] * rstd * g1[1] * gt[i * 8 + 5]);
        w.w = pg8::cvt_pk_bf16(y[i * 8 + 6] * rstd * g1[2] * gt[i * 8 + 6], y[i * 8 + 7] * rstd * g1[3] * gt[i * 8 + 7]);
        *(u32x4*)(op + i * 8) = w;
    }
}
__device__ void phase_comb(const KP& p, int l, int Mrows) {
    const int tid = otid(); const int lane = tid & 63, wid = tid >> 6;
    const int mixer = lane >> 4, ec0 = (lane & 15) * 32;
    const int gcol = (mixer == 0 ? U_MO : mixer == 1 ? U_SZ : mixer == 2 ? U_RG : U_GG) + ec0;
    const float* gain = (mixer == 0 ? p.in[I_MNORM] : mixer == 1 ? p.in[I_SNORM] : mixer == 2 ? p.in[I_RNORM] : p.in[I_GNORM]) + l * 512 + ec0;
    const float sd = p.in[I_SD][l * 8 + (ec0 >> 6)];
    const int stride = ogdim() * 8;
    for (int row = obid() * 8 + wid; row < Mrows; row += 2 * stride) {
        const int row1 = row + stride; const bool has1 = row1 < Mrows;
        CombRaw r0, r1;
        comb_load(p, row, lane, mixer, ec0, gcol, r0);
        if (has1) comb_load(p, row1, lane, mixer, ec0, gcol, r1);
        comb_compute(p, row, lane, mixer, ec0, gain, sd, r0);
        if (has1) comb_compute(p, row1, lane, mixer, ec0, gain, sd, r1);
    }
}

__device__ void run_phase(const KP& p, int ph, unsigned char* smem) {
    const float* mod = (const float*)(p.ws + WS_MOD);
    if (ph == 0) { phase_init(p, smem); return; }
    if (ph == 1) { phase_row<false, true, true>(p, T, nullptr, nullptr, mod, 0, 2048); return; }
    const int l = (ph - 2) / 9, k = (ph - 2) % 9;
    const bool last = l == 1;
    const int Mrows = last ? TL : T;
    const float* modl = mod + (size_t)l * 5 * NMOD;
    bf16_t* H = (bf16_t*)(p.ws + WS_H); bf16_t* U = (bf16_t*)(p.ws + WS_U);
    if (k == 0 || k == 4 || k == 6 || k == 7) {
        EpiAll E; E.kind = k == 0 ? 0 : (k == 6 ? 2 : 1); E.O = E.kind == 1 ? (bf16_t*)(p.ws + WS_YS) : U; E.G = (float*)(p.ws + WS_GATES); E.gmod = modl + (k == 4 ? 4096 : 10240);
        const bf16_t* A = k == 7 ? U : H;
        const bf16_t* Bt = (const bf16_t*)(p.ws + (k == 0 ? WS_WIN : k == 4 ? WS_WOUT : k == 6 ? WS_WUP : WS_WDN));
        const int N = k == 0 ? NINP : (k == 6 ? NUP : D), K = k == 7 ? DFF : D;
        const bool split = !last && (k == 4 || k == 7);
        const int M = (k == 0 || k == 6) ? (k == 0 ? T : Mrows) : TL;
        run_gemm(smem, A, Bt, M, N, K, E);
        if (split) {
            const int nsplit = k == 4 ? 8 : 4;
            EpiAll E2 = E; E2.kind = 3; E2.G = (float*)(p.ws + WS_YS + (size_t)T * D * 2);
            pg8::Gemm g; g.A = A + (size_t)TL * K; g.Bt = Bt; g.M = TC; g.N = D; g.K = K / nsplit; g.ld = K;
            SplitOrder S; S.nsplit = nsplit; S.G = ogdim(); S.c = obid();
            pg8::gemm_phase<EpiAll, SplitOrder, false>((PG8_LAS unsigned char*)smem, g, S, E2, nullptr);
        }
        return;
    }
    switch (k) {
    case 1: phase_pre(p, l, smem); break;
    case 2: phase_scan(p, l, smem); break;
    case 3: phase_comb(p, l, Mrows); break;
    case 5:
        if (l == 0) phase_row<true, true, true>(p, Mrows, p.in[I_POSTG] + (size_t)(l * 2 + 0) * D, p.in[I_POSTB] + (size_t)(l * 2 + 0) * D, modl, 6144, 8192, (const float*)(p.ws + WS_YS + (size_t)T * D * 2), 8);
        else phase_row<true, true, false>(p, Mrows, p.in[I_POSTG] + (size_t)(l * 2 + 0) * D, p.in[I_POSTB] + (size_t)(l * 2 + 0) * D, modl, 6144, 8192);
        break;
    case 8:
        if (!last) { phase_row<true, true>(p, T, p.in[I_POSTG] + (size_t)(l * 2 + 1) * D, p.in[I_POSTB] + (size_t)(l * 2 + 1) * D, modl + 5 * NMOD, 0, 2048, (const float*)(p.ws + WS_YS + (size_t)T * D * 2), 4); }
        else phase_row<true, false>(p, TL, p.in[I_POSTG] + (size_t)(l * 2 + 1) * D, p.in[I_POSTB] + (size_t)(l * 2 + 1) * D, modl, 0, 0);
        break;
    }
}

DI void grid_barrier(unsigned* bar, unsigned target) {
    asm volatile("s_waitcnt vmcnt(0) lgkmcnt(0)" ::: "memory");
    __syncthreads();
    if (threadIdx.x == 0) {
        __builtin_amdgcn_fence(__ATOMIC_RELEASE, "agent");
        asm volatile("s_waitcnt vmcnt(0)" ::: "memory");
        __hip_atomic_fetch_add(bar, 1u, __ATOMIC_RELAXED, __HIP_MEMORY_SCOPE_AGENT);
        while (__hip_atomic_load(bar, __ATOMIC_RELAXED, __HIP_MEMORY_SCOPE_AGENT) < target) __builtin_amdgcn_s_sleep(1);
        __builtin_amdgcn_fence(__ATOMIC_ACQUIRE, "agent");
        asm volatile("s_waitcnt vmcnt(0)" ::: "memory");
    }
    __syncthreads();
}
#ifndef PROBE_MASK
#define PROBE_MASK 0u
#endif
__global__ void __launch_bounds__(512, 2) mega(KP p) {
    extern __shared__ __attribute__((aligned(16))) unsigned char smem[];
    cg::grid_group grid = cg::this_grid();
    unsigned nbar = 0;
    unsigned long long tacc = 0ull;
    for (int ph = p.ph_lo; ph < p.ph_hi; ++ph) {
        unsigned long long t0 = 0ull;
        if (PROBE_MASK != 0u) t0 = __builtin_amdgcn_s_memrealtime();
        if (ph == 0 && blockIdx.x == 0 && threadIdx.x == 0) __hip_atomic_store((unsigned*)(p.ws + WS_BAR), 0u, __ATOMIC_RELAXED, __HIP_MEMORY_SCOPE_AGENT);
        run_phase(p, ph, smem);
        if (ph + 1 < p.ph_hi) {
            if (ph == 0) grid.sync();
            else { ++nbar; grid_barrier((unsigned*)(p.ws + WS_BAR), nbar * gridDim.x); }
        }
        if (PROBE_MASK != 0u && ((PROBE_MASK >> ph) & 1u)) tacc += __builtin_amdgcn_s_memrealtime() - t0;
    }
    if (PROBE_MASK != 0u && blockIdx.x == 0 && threadIdx.x == 0) {
        const unsigned long long t1 = __builtin_amdgcn_s_memrealtime();
        while (__builtin_amdgcn_s_memrealtime() - t1 < tacc) __builtin_amdgcn_s_sleep(8);
    }
}

#ifndef ONE_LAUNCH
#define ONE_LAUNCH 1
#endif
extern "C" void kernel_launch(void* const* d_in, const int* in_sizes, int n_in, void* d_out, int out_size, void* d_ws, size_t ws_size, hipStream_t stream) {
    static int grid = 0;
    if (grid == 0) {
        if (n_in != 26 || out_size != TL * D || ws_size < WS_END) { fprintf(stderr, "kernel_launch: unexpected shapes (n_in %d out %d ws %zu need %zu)\n", n_in, out_size, ws_size, (size_t)WS_END); grid = -1; return; }
        int dev = 0, cus = 0, per_cu = 0;
        hipGetDevice(&dev); hipDeviceGetAttribute(&cus, hipDeviceAttributeMultiprocessorCount, dev);
        if (hipFuncSetAttribute((const void*)mega, hipFuncAttributeMaxDynamicSharedMemorySize, LDS_BYTES) != hipSuccess) { fprintf(stderr, "kernel_launch: hipFuncSetAttribute failed\n"); grid = -1; return; }
        if (hipOccupancyMaxActiveBlocksPerMultiprocessor(&per_cu, (const void*)mega, 512, LDS_BYTES) != hipSuccess || per_cu < 1) { fprintf(stderr, "kernel_launch: occupancy query gives %d\n", per_cu); per_cu = 1; }
        (void)hipGetLastError();
        grid = cus;
    }
    if (grid < 0) return;
    KP p{};
    for (int i = 0; i < 26; ++i) p.in[i] = (const float*)d_in[i];
    p.out = (float*)d_out; p.ws = (unsigned char*)d_ws;
#if ONE_LAUNCH
    p.ph_lo = 0; p.ph_hi = NPHASE;
    void* args[] = {&p};
    hipError_t e = hipLaunchCooperativeKernel((const void*)mega, dim3(grid), dim3(512), args, LDS_BYTES, stream);
    if (e != hipSuccess) fprintf(stderr, "cooperative launch failed: %s (grid %d)\n", hipGetErrorString(e), grid);
#else
    for (int ph = 0; ph < NPHASE; ++ph) {
        p.ph_lo = ph; p.ph_hi = ph + 1;
        hipLaunchKernelGGL(mega, dim3(grid), dim3(512), LDS_BYTES, stream, p);
    }
#endif
}
```

```cpp
#include <hip/hip_runtime.h>
#include <hip/hip_cooperative_groups.h>
#include <cstdio>
namespace cg = cooperative_groups;
namespace pg8 {
#define PG8_LAS __attribute__((address_space(3)))
typedef unsigned short bf16_t;
typedef short bf16x8 __attribute__((ext_vector_type(8)));
typedef float f32x4 __attribute__((ext_vector_type(4)));
typedef unsigned u32x4 __attribute__((ext_vector_type(4)));
constexpr int BM = 256, BK = 64, HALF = 128, HTB = HALF * BK * 2  , STAGE_BYTES = 8 * HTB, NXCD = 8, WGM = 8;

__host__ __device__ __forceinline__ int lds_byte(int r, int c) { const int st = (r >> 4) * 2 + (c >> 5), rr = r & 15, cc = c & 31, ob = rr * 64 + cc * 2; return st * 1024 + (ob ^ (((ob >> 9) & 1) << 5)); }
__host__ __device__ __forceinline__ void stage_rc(int b, int& R, int& C) { const int st = b / 1024, sb = b % 1024, swz = sb ^ (((sb >> 9) & 1) << 5); R = (st >> 1) * 16 + swz / 64; C = (st & 1) * 32 + (swz % 64) / 2; }
__host__ __device__ __forceinline__ int perm32(int rho) { const int n = rho >> 4, i = rho & 15; return 8 * (i >> 2) + 4 * n + (i & 3); }

struct Unit { int pm, pn, ks; };
struct Gemm { const bf16_t* A; const bf16_t* Bt; int M, N, K, ld; };

struct StaticOrder {
    int nM, nN, nwg, G, c;
    __host__ __device__ void init(int M, int N, int G_, int c_) { nM = M / BM; nN = N / BM; nwg = nM * nN; G = G_; c = c_; }
    __host__ __device__ bool next(int i, Unit& u) const {
        const long L = (long)i * G + c; if (L >= nwg) return false;
        int wgid = (int)L; { const int q = nwg / NXCD, r = nwg % NXCD, xcd = wgid % NXCD, off = wgid / NXCD; wgid = (xcd < r ? xcd * (q + 1) : r * (q + 1) + (xcd - r) * q) + off; }
        const int nig = WGM * nN, gid = wgid / nig, fm = gid * WGM, gsz = (nM - fm) < WGM ? (nM - fm) : WGM;
        u.pm = fm + ((wgid % nig) % gsz); u.pn = (wgid % nig) / gsz; u.ks = 0; return true;
    }
    __device__ __forceinline__ void a_ready(const Unit&) const {}
    __device__ __forceinline__ void done(const Unit&) const {}
};
__device__ __forceinline__ unsigned cvt_pk_bf16(float lo, float hi) { unsigned r; asm volatile("v_cvt_pk_bf16_f32 %0, %1, %2" : "=v"(r) : "v"(lo), "v"(hi)); return r; }
template <class Epi, class Sched, bool STAMP = false>
__device__ __forceinline__ void gemm_phase(PG8_LAS unsigned char* lds, const Gemm g, const Sched& S, const Epi& E, unsigned long long* stamps) {
    int tid_ = threadIdx.x; asm volatile("" : "+v"(tid_)); const int tid = tid_, wid = __builtin_amdgcn_readfirstlane(tid >> 6), lane = tid & 63, wr = wid >> 2, wc = wid & 3, fr = lane & 15, fq = lane >> 4;
    const int K = g.ld, nt = g.K / BK; const size_t sstep = (size_t)g.K * 2;
    int ts_lo = 0, ts_hi = 0, nts = 0; const unsigned long long rt_entry = STAMP ? (unsigned long long)wall_clock64() : 0ull;
#define PG8_STAMP() do { if (STAMP && wid == 0 && nts < 64) { const unsigned long long _c = (unsigned long long)clock64(); \
        ts_lo = (lane == nts) ? (int)(unsigned)_c : ts_lo; ts_hi = (lane == nts) ? (int)(unsigned)(_c >> 32) : ts_hi; ++nts; } } while (0)
    PG8_STAMP();
    unsigned voffA[2], voffB[2];
#pragma unroll
    for (int i = 0; i < 2; ++i) { int R, C; stage_rc(tid * 16 + i * 8192, R, C); const int Rb = Epi::PERM ? ((R & ~31) + perm32(R & 31)) : R;
        voffA[i] = (unsigned)(R * K + C) * 2u; voffB[i] = (unsigned)(Rb * K + C) * 2u; }
    const size_t kstep = (size_t)(BK * 2);
    const size_t hstep = (size_t)HALF * K * 2;
    const size_t tstep = 2 * hstep;
    const unsigned ldsw = (unsigned)wid * 1024u;
    const int aoff = lds_byte(wr * 64 + fr, fq * 8), boff = lds_byte(wc * 32 + fr, fq * 8);
#define PG8_SA(b, h) (((b) * 2 + (h)) * HTB)
#define PG8_SB(b, h) ((4 + (b) * 2 + (h)) * HTB)
#define PG8_STAGE(bufoff, gbase, voff) do { _Pragma("unroll") for (int _i = 0; _i < 2; ++_i) \
        __builtin_amdgcn_global_load_lds((const unsigned*)((const char*)(gbase) + (voff)[_i]), (PG8_LAS unsigned*)(lds + (bufoff) + ldsw + _i * 8192), 16, 0, 0); } while (0)
#define PG8_LDA(dst, b, h) do { _Pragma("unroll") for (int m = 0; m < 4; ++m) _Pragma("unroll") for (int k = 0; k < 2; ++k) dst[m][k] = *(const PG8_LAS bf16x8*)(lds + PG8_SA(b, h) + aoff + m * 2048 + k * 1024); } while (0)
#define PG8_LDB(dst, b, h) do { _Pragma("unroll") for (int n = 0; n < 2; ++n) _Pragma("unroll") for (int k = 0; k < 2; ++k) dst[n][k] = *(const PG8_LAS bf16x8*)(lds + PG8_SB(b, h) + boff + n * 2048 + k * 1024); } while (0)
#define PG8_MMA(ai, bj, At, Bt) do { __builtin_amdgcn_s_setprio(1); _Pragma("unroll") for (int m = 0; m < 4; ++m) _Pragma("unroll") for (int n = 0; n < 2; ++n) _Pragma("unroll") for (int k = 0; k < 2; ++k) \
        acc[ai][bj][m][n] = __builtin_amdgcn_mfma_f32_16x16x32_bf16(Bt[n][k], At[m][k], acc[ai][bj][m][n], 0, 0, 0); __builtin_amdgcn_s_setprio(0); } while (0)
#define PG8_WAIT_V(n) asm volatile("s_waitcnt vmcnt(" #n ")" ::: "memory")
#define PG8_WAIT_L(n) asm volatile("s_waitcnt lgkmcnt(" #n ")" ::: "memory")
#define PG8_BAR __builtin_amdgcn_s_barrier()
#define PG8_SCHED __builtin_amdgcn_sched_barrier(0)
    Unit cur, nxt; int ui = 0;
    if (!S.next(0, cur)) return;
    f32x4 acc[2][2][4][2];
#pragma unroll
    for (int a = 0; a < 2; ++a)
#pragma unroll
        for (int b = 0; b < 2; ++b)
#pragma unroll
            for (int m = 0; m < 4; ++m)
#pragma unroll
                for (int n = 0; n < 2; ++n) acc[a][b][m][n] = (f32x4){0.f, 0.f, 0.f, 0.f};
    bf16x8 At[4][2], B0[2][2], B1[2][2];
    const char* cA = (const char*)g.A + (size_t)cur.pm * tstep + (size_t)cur.ks * sstep; const char* cB = (const char*)g.Bt + (size_t)cur.pn * tstep + (size_t)cur.ks * sstep;
    S.a_ready(cur);
    PG8_STAGE(PG8_SB(0, 0), cB, voffB); PG8_STAGE(PG8_SA(0, 0), cA, voffA); PG8_STAGE(PG8_SB(0, 1), cB + hstep, voffB); PG8_STAGE(PG8_SA(0, 1), cA + hstep, voffA);
    if (wr == 1) PG8_BAR;
    PG8_WAIT_V(4); PG8_BAR;
    PG8_STAGE(PG8_SB(1, 0), cB + kstep, voffB); PG8_STAGE(PG8_SA(1, 0), cA + kstep, voffA); PG8_STAGE(PG8_SB(1, 1), cB + hstep + kstep, voffB);
    PG8_WAIT_V(6); PG8_BAR;
    PG8_STAMP();
    for (;;) {
        const bool has_next = S.next(ui + 1, nxt);
        const char* nA = has_next ? (const char*)g.A + (size_t)nxt.pm * tstep + (size_t)nxt.ks * sstep : cA; const char* nB = has_next ? (const char*)g.Bt + (size_t)nxt.pn * tstep + (size_t)nxt.ks * sstep : cB;
        for (int t = 0; t < nt; t += 2) {
            const bool last = (t == nt - 2);
            const char* a1 = cA + (size_t)(t + 1) * kstep;
            const char* a2 = last ? nA : cA + (size_t)(t + 2) * kstep; const char* b2 = last ? nB : cB + (size_t)(t + 2) * kstep;
            const char* a3 = a2 + kstep; const char* b3 = b2 + kstep;
            if (last && has_next) S.a_ready(nxt);
            PG8_LDB(B0, 0, 0); PG8_SCHED; PG8_LDA(At, 0, 0); PG8_STAGE(PG8_SA(1, 1), a1 + hstep, voffA);
            PG8_WAIT_L(8); PG8_BAR; PG8_WAIT_L(0); PG8_MMA(0, 0, At, B0); PG8_BAR; PG8_SCHED;
            PG8_LDB(B1, 0, 1); PG8_STAGE(PG8_SB(0, 0), b2, voffB);
            PG8_BAR; PG8_WAIT_L(0); PG8_MMA(0, 1, At, B1); PG8_BAR;
            PG8_LDA(At, 0, 1); PG8_STAGE(PG8_SA(0, 0), a2, voffA);
            PG8_BAR; PG8_WAIT_L(0); PG8_MMA(1, 0, At, B0); PG8_BAR; PG8_SCHED;
            PG8_STAGE(PG8_SB(0, 1), b2 + hstep, voffB);
            PG8_WAIT_V(6); PG8_BAR; PG8_MMA(1, 1, At, B1); PG8_BAR;
            PG8_LDB(B0, 1, 0); PG8_SCHED; PG8_LDA(At, 1, 0); PG8_STAGE(PG8_SA(0, 1), a2 + hstep, voffA);
            PG8_WAIT_L(8); PG8_BAR; PG8_WAIT_L(0); PG8_MMA(0, 0, At, B0); PG8_BAR; PG8_SCHED;
            PG8_LDB(B1, 1, 1); PG8_STAGE(PG8_SB(1, 0), b3, voffB);
            PG8_BAR; PG8_WAIT_L(0); PG8_MMA(0, 1, At, B1); PG8_BAR;
            PG8_LDA(At, 1, 1); PG8_STAGE(PG8_SA(1, 0), a3, voffA);
            PG8_BAR; PG8_WAIT_L(0); PG8_MMA(1, 0, At, B0); PG8_BAR; PG8_SCHED;
            PG8_STAGE(PG8_SB(1, 1), b3 + hstep, voffB);
            PG8_WAIT_V(6); PG8_BAR; PG8_MMA(1, 1, At, B1); PG8_BAR;
        }
        PG8_STAMP();
        if constexpr (!Epi::AFTER_DRAIN) { E(acc, cur, wr, wc, fr, fq); S.done(cur); }
        PG8_STAMP();
        if (!has_next) break;
#pragma unroll
        for (int a = 0; a < 2; ++a)
#pragma unroll
            for (int b = 0; b < 2; ++b)
#pragma unroll
                for (int m = 0; m < 4; ++m)
#pragma unroll
                    for (int n = 0; n < 2; ++n) acc[a][b][m][n] = (f32x4){0.f, 0.f, 0.f, 0.f};
        cur = nxt; cA = nA; cB = nB; ++ui;
    }
    PG8_WAIT_V(0);
    if (wr == 0) PG8_BAR;
    PG8_BAR;
    if constexpr (Epi::AFTER_DRAIN) { E.fused(acc, cur, wr, wc, fr, fq, lds, wid, lane); S.done(cur); }
    PG8_STAMP();
    if (STAMP && wid == 0) { stamps[lane] = lane < nts ? (((unsigned long long)(unsigned)ts_hi << 32) | (unsigned)ts_lo) : 0ull;
        if (lane == 62) stamps[62] = rt_entry; if (lane == 63) stamps[63] = (unsigned long long)wall_clock64(); }
#undef PG8_STAMP
#undef PG8_SA
#undef PG8_SB
#undef PG8_STAGE
#undef PG8_LDA
#undef PG8_LDB
#undef PG8_MMA
#undef PG8_WAIT_V
#undef PG8_WAIT_L
#undef PG8_BAR
#undef PG8_SCHED
}
}

using pg8::bf16_t; using pg8::bf16x8; using pg8::f32x4; using pg8::u32x4;
#define DI __device__ __forceinline__
typedef unsigned u32x2 __attribute__((ext_vector_type(2)));
constexpr int D = 2048, NBATCH = 4, SEQ = 4096, CTXL = 256;
constexpr int TL = NBATCH * SEQ, TC = NBATCH * CTXL, T = TL + TC;
constexpr int NIN = 7232, NINP = 7424, NU = 7168, DFF = 5632, NUP = 2 * DFF, NMOD = 12288;
constexpr float EPS = 1e-5f, ALPHA = 1.41421356237309515f;
constexpr int U_MQ = 0, U_MK = 512, U_MV = 1024, U_MO = 1536, U_SZ = 2048, U_XBC = 2560, U_RQ = 3584, U_RK = 4096, U_RV = 4608, U_RG = 5120,
              U_GQ = 5632, U_GK = 5888, U_GV = 6144, U_GG = 6656;
constexpr size_t al256(size_t x) { return (x + 255) & ~(size_t)255; }
constexpr size_t WS_WIN = 0;
constexpr size_t WS_WOUT = WS_WIN + al256((size_t)NINP * D * 2);
constexpr size_t WS_WUP = WS_WOUT + al256((size_t)D * D * 2);
constexpr size_t WS_WDN = WS_WUP + al256((size_t)NUP * D * 2);
constexpr size_t WS_MOD = WS_WDN + al256((size_t)D * DFF * 2);
constexpr size_t WS_XC = WS_MOD + al256((size_t)2 * 5 * NMOD * 4);
constexpr size_t WS_H = WS_XC + al256((size_t)TC * D * 4);
constexpr size_t WS_U = WS_H + al256((size_t)T * D * 2);
constexpr size_t WS_GATES = WS_U + al256((size_t)T * NU * 2);
constexpr size_t WS_XBC = WS_GATES + al256((size_t)T * 64 * 4);
constexpr size_t WS_GL = WS_XBC + al256((size_t)T * 1024 * 2);
constexpr size_t WS_LA = WS_GL + al256((size_t)2 * 16 * T * 8);
constexpr size_t WS_YS = WS_LA + al256((size_t)2 * T * 256 * 4);
constexpr size_t WS_DEN = WS_YS + al256((size_t)2 * T * D * 2);
constexpr size_t WS_QG = WS_DEN + al256((size_t)2 * T * 4 * 4);
constexpr size_t WS_KG = WS_QG + al256((size_t)2 * T * 256 * 2);
constexpr size_t WS_EE = WS_KG + al256((size_t)2 * T * 256 * 2);
constexpr size_t WS_BAR = WS_EE + al256((size_t)2 * (T / 64) * 256 * 4);
constexpr size_t WS_YC = WS_BAR + 256;
constexpr size_t WS_END = WS_YC;
constexpr int LDS_BYTES = 131072;
constexpr int NPHASE = 20;
#ifndef SCAN_MFMA
#define SCAN_MFMA 15
#endif

struct KP { const float* in[26]; float* out; unsigned char* ws; int ph_lo, ph_hi; };
enum { I_X = 0, I_C, I_CTX, I_CCTX, I_ADAW, I_ADAB, I_WIN, I_MIGB, I_MFGB, I_MNORM, I_SCONVW, I_SCONVB, I_SDTB, I_SALOG, I_SD, I_SNORM, I_RDECAY, I_RNORM,
       I_GGW, I_GGB, I_GNORM, I_WOUT, I_POSTG, I_POSTB, I_WUP, I_WDN };

DI int obid() { int b = blockIdx.x; asm volatile("" : "+s"(b)); return b; }
DI int ogdim() { int g = gridDim.x; asm volatile("" : "+s"(g)); return g; }
DI int otid() { int t = threadIdx.x; asm volatile("" : "+v"(t)); return t; }
DI float bf2f(unsigned short h) { return __uint_as_float(((unsigned)h) << 16); }
DI unsigned short f2bf(float f) { unsigned u = __float_as_uint(f); u += 0x7fffu + ((u >> 16) & 1u); return (unsigned short)(u >> 16); }
DI unsigned pk2(float lo, float hi) { return (unsigned)f2bf(lo) | ((unsigned)f2bf(hi) << 16); }
DI float silu_f(float x) { return x * __builtin_amdgcn_rcpf(1.f + __expf(-x)); }
DI float sigmoid_f(float x) { return __builtin_amdgcn_rcpf(1.f + __expf(-x)); }
DI float softplus_f(float x) { return fmaxf(x, 0.f) + __logf(1.f + __expf(-fabsf(x))); }
DI float logsigmoid_f(float x) { return fminf(x, 0.f) - __logf(1.f + __expf(-fabsf(x))); }
DI float shx(float v, int m, int lane) { return __uint_as_float(__builtin_amdgcn_ds_bpermute((lane ^ m) << 2, __float_as_uint(v))); }
DI float wave_sum(float v, int lane) {
#pragma unroll
    for (int m = 32; m >= 1; m >>= 1) v += shx(v, m, lane);
    return v;
}
DI float* xrow_ptr(const KP& p, int row) { return row < TL ? p.out + (size_t)row * D : (float*)(p.ws + WS_XC) + (size_t)(row - TL) * D; }
DI const float* xin_ptr(const KP& p, int row) { return row < TL ? p.in[I_X] + (size_t)row * D : p.in[I_CTX] + (size_t)(row - TL) * D; }
DI int modidx(int row) { return row < TL ? (row >> 12) : 4; }
DI int scan_row(int b, int d, int s) { if (s < CTXL) { const int t = d ? CTXL - 1 - s : s; return TL + b * CTXL + t; } int t = s - CTXL; t = d ? SEQ - 1 - t : t; return b * SEQ + t; }

template <int KIND> DI int srccol(int n) {
    if (KIND == 0) {
        if (n < 2048) return n;
        if (n < 3584) return n + 16;
        if (n < 7168) return n + 32;
        if (n < 7184) return 2048 + (n - 7168);
        if (n < 7200) return 3600 + (n - 7184);
        if (n < 7232) return n;
        return -1;
    }
    if (KIND == 2) { const int pn = n >> 8, bj = (n >> 7) & 1, cl = n & 127; return bj * DFF + pn * 128 + cl; }
    return n;
}
constexpr int CT_IN = (NINP / 128) * (D / 64), CT_OUT = (D / 128) * (D / 64), CT_UP = (NUP / 128) * (D / 64), CT_DN = (D / 128) * (DFF / 64);
struct ConvTile { const float* W; bf16_t* dst; int Nsrc, Kd, n0, k0, kind; };
DI ConvTile conv_decode(const KP& p, int l, int t  ) {
    ConvTile c;
    if (t < CT_IN) { c.kind = 0; c.W = p.in[I_WIN] + (size_t)l * D * NIN; c.Nsrc = NIN; c.dst = (bf16_t*)(p.ws + WS_WIN); c.Kd = D; c.n0 = (t / (D / 64)) * 128; c.k0 = (t % (D / 64)) * 64; return c; }
    t -= CT_IN;
    if (t < CT_OUT) { c.kind = 1; c.W = p.in[I_WOUT] + (size_t)l * D * D; c.Nsrc = D; c.dst = (bf16_t*)(p.ws + WS_WOUT); c.Kd = D; c.n0 = (t / (D / 64)) * 128; c.k0 = (t % (D / 64)) * 64; return c; }
    t -= CT_OUT;
    if (t < CT_UP) { c.kind = 2; c.W = p.in[I_WUP] + (size_t)l * D * NUP; c.Nsrc = NUP; c.dst = (bf16_t*)(p.ws + WS_WUP); c.Kd = D; c.n0 = (t / (D / 64)) * 128; c.k0 = (t % (D / 64)) * 64; return c; }
    t -= CT_UP;
    c.kind = 3; c.W = p.in[I_WDN] + (size_t)l * DFF * D; c.Nsrc = D; c.dst = (bf16_t*)(p.ws + WS_WDN); c.Kd = DFF; c.n0 = (t / (DFF / 64)) * 128; c.k0 = (t % (DFF / 64)) * 64; return c;
}
DI int conv_srccol(int kind, int n) { return kind == 0 ? srccol<0>(n) : kind == 2 ? srccol<2>(n) : n; }
DI void conv_load(const ConvTile& c, int tid, f32x4 (&v)[4]) {
    const int r = tid >> 5, c4 = (tid & 31) * 4;
    const int sc = conv_srccol(c.kind, c.n0 + c4);
#pragma unroll
    for (int i = 0; i < 4; ++i) { v[i] = (f32x4){0.f, 0.f, 0.f, 0.f}; if (sc >= 0) v[i] = *(const f32x4*)(c.W + (size_t)(c.k0 + r + 16 * i) * c.Nsrc + sc); }
}
__device__ void convert_weights(const KP& p, int l, int t_lo, int t_hi, int w, int nw, unsigned char* smem) {
    float* tile = (float*)smem;
    const int tid = otid();
    int t = t_lo + w;
    if (t >= t_hi) return;
    ConvTile c = conv_decode(p, l, t);
    f32x4 v[4]; conv_load(c, tid, v);
    for (;;) {
        const int tn = t + nw; const bool more = tn < t_hi;
        ConvTile cn = c; f32x4 vn[4];
        if (more) { cn = conv_decode(p, l, tn); conv_load(cn, tid, vn); }
        {
            const int r = tid >> 5, c4 = (tid & 31) * 4;
#pragma unroll
            for (int i = 0; i < 4; ++i) { float* q = tile + (r + 16 * i) * 129 + c4; q[0] = v[i][0]; q[1] = v[i][1]; q[2] = v[i][2]; q[3] = v[i][3]; }
        }
        __syncthreads();
        {
            const int n = tid >> 2, ks = (tid & 3) * 16;
            float f[16];
#pragma unroll
            for (int j = 0; j < 16; ++j) f[j] = tile[(ks + j) * 129 + n];
            u32x4 w0, w1;
            w0.x = pk2(f[0], f[1]); w0.y = pk2(f[2], f[3]); w0.z = pk2(f[4], f[5]); w0.w = pk2(f[6], f[7]);
            w1.x = pk2(f[8], f[9]); w1.y = pk2(f[10], f[11]); w1.z = pk2(f[12], f[13]); w1.w = pk2(f[14], f[15]);
            bf16_t* q = c.dst + (size_t)(c.n0 + n) * c.Kd + c.k0 + ks;
            *(u32x4*)q = w0; *(u32x4*)(q + 8) = w1;
        }
        __syncthreads();
        if (!more) break;
        t = tn; c = cn;
#pragma unroll
        for (int i = 0; i < 4; ++i) v[i] = vn[i];
    }
}

__device__ void phase_init(const KP& p, unsigned char* smem) {
    const int tid = otid(), bid = obid(), nb = ogdim();
    float* sil = (float*)smem;
    float* red = sil + 5 * 2048;
    for (int i = tid; i < 5 * 2048; i += 512) { const int r = i >> 11, k = i & 2047; const float v = r < 4 ? p.in[I_C][r * 2048 + k] : p.in[I_CCTX][k]; sil[i] = silu_f(v); }
    __syncthreads();
    float* mod = (float*)(p.ws + WS_MOD);
    for (int chunk = bid; chunk < 256; chunk += nb) {
        const int l = chunk >> 7, n0 = (chunk & 127) * 96;
        const float* W = p.in[I_ADAW] + (size_t)l * D * NMOD;
        const int kp = tid >> 5, cc = tid & 31;
        float acc[3][5];
#pragma unroll
        for (int j = 0; j < 3; ++j)
#pragma unroll
            for (int r = 0; r < 5; ++r) acc[j][r] = 0.f;
#pragma unroll 8
        for (int k = kp; k < D; k += 16) {
            const float* wr = W + (size_t)k * NMOD + n0 + cc;
            const float w0 = wr[0], w1 = wr[32], w2 = wr[64];
#pragma unroll
            for (int r = 0; r < 5; ++r) { const float s = sil[r * 2048 + k]; acc[0][r] += s * w0; acc[1][r] += s * w1; acc[2][r] += s * w2; }
        }
#pragma unroll
        for (int j = 0; j < 3; ++j)
#pragma unroll
            for (int r = 0; r < 5; ++r) red[(kp * 96 + j * 32 + cc) * 5 + r] = acc[j][r];
        __syncthreads();
        if (tid < 480) {
            const int col = tid / 5, r = tid % 5; float s = 0.f;
#pragma unroll
            for (int k2 = 0; k2 < 16; ++k2) s += red[(k2 * 96 + col) * 5 + r];
            mod[(size_t)(l * 5 + r) * NMOD + n0 + col] = s + p.in[I_ADAB][l * NMOD + n0 + col];
        }
        __syncthreads();
    }
    convert_weights(p, 0, 0, CT_IN, bid, nb, smem);
}

DI void ln_stats(const f32x4 (&v)[8], int lane, float& mean, float& rstd) {
    float s = 0.f;
#pragma unroll
    for (int i = 0; i < 8; ++i) s += (v[i][0] + v[i][1]) + (v[i][2] + v[i][3]);
    s = wave_sum(s, lane); mean = s * (1.f / D);
    float q = 0.f;
#pragma unroll
    for (int i = 0; i < 8; ++i) { const f32x4 dd = v[i] - mean; q += (dd[0] * dd[0] + dd[1] * dd[1]) + (dd[2] * dd[2] + dd[3] * dd[3]); }
    q = wave_sum(q, lane); rstd = rsqrtf(q * (1.f / D) + EPS);
}
template <bool FIRST, bool MOD, bool FROM_INPUT>
DI void row_load(const KP& p, int row, int lane, const float* ycf, int nsplit, f32x4 (&v)[8], f32x4 (&y)[8]) {
    const float* xi = FROM_INPUT ? xin_ptr(p, row) : xrow_ptr(p, row);
#pragma unroll
    for (int i = 0; i < 8; ++i) v[i] = ((const f32x4*)xi)[i * 64 + lane];
    if (FIRST) {
        if (ycf != nullptr && row >= TL) {
            const float* yr = ycf + (size_t)(row - TL) * D;
#pragma unroll
            for (int i = 0; i < 8; ++i) y[i] = ((const f32x4*)yr)[i * 64 + lane];
            for (int sp = 1; sp < nsplit; ++sp) {
                yr += (size_t)TC * D;
#pragma unroll
                for (int i = 0; i < 8; ++i) y[i] += ((const f32x4*)yr)[i * 64 + lane];
            }
        } else {
            const bf16_t* yr = (const bf16_t*)(p.ws + WS_YS) + (size_t)row * D;
#pragma unroll
            for (int i = 0; i < 8; ++i) { const u32x2 t = ((const u32x2*)yr)[i * 64 + lane];
                y[i][0] = __uint_as_float(t[0] << 16); y[i][1] = __uint_as_float(t[0] & 0xffff0000u); y[i][2] = __uint_as_float(t[1] << 16); y[i][3] = __uint_as_float(t[1] & 0xffff0000u); }
        }
    }
}
template <bool FIRST, bool MOD>
DI void row_compute(const KP& p, int row, int lane, f32x4 (&v)[8], const f32x4 (&y)[8], const float* pg, const float* pb, const float* modl, int shoff, int scoff) {
    float mean, rstd;
    if (FIRST) {
        float* xr = xrow_ptr(p, row);
#pragma unroll
        for (int i = 0; i < 8; ++i) v[i] = ALPHA * v[i] + y[i];
        ln_stats(v, lane, mean, rstd);
#pragma unroll
        for (int i = 0; i < 8; ++i) {
            const f32x4 g = ((const f32x4*)pg)[i * 64 + lane], b = ((const f32x4*)pb)[i * 64 + lane];
            v[i] = (v[i] - mean) * rstd * g + b;
            ((f32x4*)xr)[i * 64 + lane] = v[i];
        }
    }
    if (MOD) {
        ln_stats(v, lane, mean, rstd);
        const float* mb = modl + (size_t)modidx(row) * NMOD;
        bf16_t* H = (bf16_t*)(p.ws + WS_H);
#pragma unroll
        for (int i = 0; i < 8; ++i) {
            const f32x4 sh = ((const f32x4*)(mb + shoff))[i * 64 + lane], sc = ((const f32x4*)(mb + scoff))[i * 64 + lane];
            const f32x4 o = (v[i] - mean) * rstd * (1.f + sc) + sh;
            u32x2 w; w[0] = pg8::cvt_pk_bf16(o[0], o[1]); w[1] = pg8::cvt_pk_bf16(o[2], o[3]);
            ((u32x2*)(H + (size_t)row * D))[i * 64 + lane] = w;
        }
    }
}
template <bool FIRST, bool MOD, bool FROM_INPUT = false>
__device__ void phase_row(const KP& p, int Mrows, const float* pg, const float* pb, const float* modl  , int shoff, int scoff, const float* ycf = nullptr, int nsplit = 0) {
    const int tid = otid(); const int lane = tid & 63, wid = tid >> 6;
    const int stride = ogdim() * 8;
    for (int row = obid() * 8 + wid; row < Mrows; row += 2 * stride) {
        const int row1 = row + stride; const bool has1 = row1 < Mrows;
        f32x4 v0[8], v1[8], y0[8], y1[8];
        row_load<FIRST, MOD, FROM_INPUT>(p, row, lane, ycf, nsplit, v0, y0);
        if (has1) row_load<FIRST, MOD, FROM_INPUT>(p, row1, lane, ycf, nsplit, v1, y1);
        row_compute<FIRST, MOD>(p, row, lane, v0, y0, pg, pb, modl, shoff, scoff);
        if (has1) row_compute<FIRST, MOD>(p, row1, lane, v1, y1, pg, pb, modl, shoff, scoff);
    }
}

struct EpiAll {
    static constexpr bool PERM = true, AFTER_DRAIN = false;
    int kind; bf16_t* O; float* G; const float* gmod;
    DI void operator()(const f32x4 (&acc)[2][2][4][2], const pg8::Unit& u, int wr, int wc, int fr, int fq) const {
        const int row0 = u.pm * 256 + wr * 64 + fr;
        if (kind == 0) {
            if (u.pn < 28) {
                const int col0 = u.pn * 256 + wc * 32 + 8 * fq;
#pragma unroll
                for (int ai = 0; ai < 2; ++ai)
#pragma unroll
                    for (int m = 0; m < 4; ++m) {
                        bf16_t* rowp = O + (size_t)(row0 + ai * 128 + m * 16) * NU + col0;
#pragma unroll
                        for (int bj = 0; bj < 2; ++bj) {
                            const f32x4 v0 = acc[ai][bj][m][0], v1 = acc[ai][bj][m][1];
                            u32x4 w; w.x = pg8::cvt_pk_bf16(v0[0], v0[1]); w.y = pg8::cvt_pk_bf16(v0[2], v0[3]); w.z = pg8::cvt_pk_bf16(v1[0], v1[1]); w.w = pg8::cvt_pk_bf16(v1[2], v1[3]);
                            *(u32x4*)(rowp + bj * 128) = w;
                        }
                    }
            } else if (wc < 2) {
                const int col0 = wc * 32 + 8 * fq;
#pragma unroll
                for (int ai = 0; ai < 2; ++ai)
#pragma unroll
                    for (int m = 0; m < 4; ++m) {
                        float* rowp = G + (size_t)(row0 + ai * 128 + m * 16) * 64 + col0;
                        *(f32x4*)rowp = acc[ai][0][m][0]; *(f32x4*)(rowp + 4) = acc[ai][0][m][1];
                    }
            }
        } else if (kind == 1) {
            const int col0 = u.pn * 256 + wc * 32 + 8 * fq;
            const int mi = u.pm < 64 ? (u.pm >> 4) : 4;
            const float* gp = gmod + (size_t)mi * NMOD + col0;
            f32x4 gv[2][2];
#pragma unroll
            for (int bj = 0; bj < 2; ++bj)
#pragma unroll
                for (int n = 0; n < 2; ++n) gv[bj][n] = *(const f32x4*)(gp + bj * 128 + n * 4);
#pragma unroll
            for (int ai = 0; ai < 2; ++ai)
#pragma unroll
                for (int m = 0; m < 4; ++m) {
                    bf16_t* rowp = O + (size_t)(row0 + ai * 128 + m * 16) * D + col0;
#pragma unroll
                    for (int bj = 0; bj < 2; ++bj) {
                        const f32x4 v0 = gv[bj][0] * acc[ai][bj][m][0], v1 = gv[bj][1] * acc[ai][bj][m][1];
                        u32x4 w; w.x = pg8::cvt_pk_bf16(v0[0], v0[1]); w.y = pg8::cvt_pk_bf16(v0[2], v0[3]); w.z = pg8::cvt_pk_bf16(v1[0], v1[1]); w.w = pg8::cvt_pk_bf16(v1[2], v1[3]);
                        *(u32x4*)(rowp + bj * 128) = w;
                    }
                }
        } else if (kind == 3) {
            const int col0 = u.pn * 256 + wc * 32 + 8 * fq;
            const float* gp = gmod + (size_t)4 * NMOD + col0;
            f32x4 gv[2][2];
#pragma unroll
            for (int bj = 0; bj < 2; ++bj)
#pragma unroll
                for (int n = 0; n < 2; ++n) gv[bj][n] = *(const f32x4*)(gp + bj * 128 + n * 4);
            float* Pk = G + (size_t)u.ks * TC * D;
#pragma unroll
            for (int ai = 0; ai < 2; ++ai)
#pragma unroll
                for (int m = 0; m < 4; ++m) {
                    float* rowp = Pk + (size_t)(row0 + ai * 128 + m * 16) * D + col0;
#pragma unroll
                    for (int bj = 0; bj < 2; ++bj)
#pragma unroll
                        for (int n = 0; n < 2; ++n) *(f32x4*)(rowp + bj * 128 + n * 4) = gv[bj][n] * acc[ai][bj][m][n];
                }
        } else {
            const int col0 = u.pn * 128 + wc * 32 + 8 * fq;
#pragma unroll
            for (int ai = 0; ai < 2; ++ai)
#pragma unroll
                for (int m = 0; m < 4; ++m) {
                    bf16_t* rowp = O + (size_t)(row0 + ai * 128 + m * 16) * DFF + col0;
                    f32x4 v0, v1;
#pragma unroll
                    for (int j = 0; j < 4; ++j) { v0[j] = silu_f(acc[ai][0][m][0][j]) * acc[ai][1][m][0][j]; v1[j] = silu_f(acc[ai][0][m][1][j]) * acc[ai][1][m][1][j]; }
                    u32x4 w; w.x = pg8::cvt_pk_bf16(v0[0], v0[1]); w.y = pg8::cvt_pk_bf16(v0[2], v0[3]); w.z = pg8::cvt_pk_bf16(v1[0], v1[1]); w.w = pg8::cvt_pk_bf16(v1[2], v1[3]);
                    *(u32x4*)rowp = w;
                }
        }
    }
};
struct SplitOrder {
    int nsplit, G, c;
    __device__ bool next(int i, pg8::Unit& u) const {
        const int L = i * G + c; if (L >= 32 * nsplit) return false;
        const int tile = L / nsplit; u.ks = L % nsplit; u.pm = tile >> 3; u.pn = tile & 7; return true;
    }
    DI void a_ready(const pg8::Unit&) const {}
    DI void done(const pg8::Unit&) const {}
};
template <class Epi> DI void run_gemm(unsigned char* smem, const bf16_t* A, const bf16_t* Bt, int M, int N, int K, const Epi& E) {
    pg8::Gemm g; g.A = A; g.Bt = Bt; g.M = M; g.N = N; g.K = K; g.ld = K;
    pg8::StaticOrder S; S.init(M, N, ogdim(), obid());
    pg8::gemm_phase<Epi, pg8::StaticOrder, false>((PG8_LAS unsigned char*)smem, g, S, E, nullptr);
}

__device__ void phase_pre(const KP& p, int l, unsigned char* smem) {
    const int tid = otid();
    bf16_t* U = (bf16_t*)(p.ws + WS_U);
    const float* G = (const float*)(p.ws + WS_GATES);
    bf16_t* X = (bf16_t*)(p.ws + WS_XBC);
    float2* GL = (float2*)(p.ws + WS_GL);
    constexpr int NGLA = 2 * (T / 64), NR16 = T / 16;
    for (int it = obid(); it < NGLA + 2 * NR16; it += ogdim()) {
        if (it < NGLA) {
            const int blk = it >> 1, gd = it & 1, r0 = blk * 64;
            const int half = tid >> 8, gch = tid & 255;
            float* as = (float*)smem;
            float* tot = as + 64 * 16;
            __syncthreads();
            if (tid < 256) { const int t = tid >> 2, c4 = (tid & 3) * 4; *(f32x4*)(as + t * 16 + c4) = *(const f32x4*)(G + (size_t)(r0 + t) * 64 + 32 + gd * 16 + c4); }
            float gw[16];
#pragma unroll
            for (int r = 0; r < 16; ++r) gw[r] = p.in[I_GGW][((size_t)(l * 2 + gd) * 16 + r) * 256 + gch];
            const float gb = p.in[I_GGB][(l * 2 + gd) * 256 + gch];
            bf16_t* QG = (bf16_t*)(p.ws + WS_QG) + (size_t)gd * T * 256 + gch;
            bf16_t* KG = (bf16_t*)(p.ws + WS_KG) + (size_t)gd * T * 256 + gch;
            __syncthreads();
            float* las = tot + 256;
            float lsum = 0.f;
#pragma unroll 2
            for (int j = 0; j < 32; ++j) {
                const int sp = half * 32 + j, t = gd ? 63 - sp : sp;
                const float* ar = as + t * 16;
                float x = gb;
#pragma unroll
                for (int r4 = 0; r4 < 4; ++r4) { const f32x4 a4 = *(const f32x4*)(ar + r4 * 4); x += a4[0] * gw[r4 * 4] + a4[1] * gw[r4 * 4 + 1] + a4[2] * gw[r4 * 4 + 2] + a4[3] * gw[r4 * 4 + 3]; }
                const float lv = logsigmoid_f(x) * (1.f / 16.f); las[j * 512 + tid] = lv; lsum += lv;
            }
            if (half == 0) tot[gch] = lsum;
            __syncthreads();
            float bsum = half ? tot[gch] : 0.f;
            if (half) ((float*)(p.ws + WS_EE))[((size_t)gd * (T / 64) + blk) * 256 + gch] = __expf(bsum + lsum);
            for (int tb = 0; tb < 32; tb += 8) {
                unsigned short qv[8], kv[8];
#pragma unroll
                for (int j = 0; j < 8; ++j) { const int sp = half * 32 + tb + j, t = gd ? 63 - sp : sp; qv[j] = U[(size_t)(r0 + t) * NU + U_GQ + gch]; kv[j] = U[(size_t)(r0 + t) * NU + U_GK + gch]; }
#pragma unroll
                for (int j = 0; j < 8; ++j) {
                    const int sp = half * 32 + tb + j, t = gd ? 63 - sp : sp;
                    bsum += las[(tb + j) * 512 + tid];
                    QG[(size_t)(r0 + t) * 256] = f2bf(bf2f(qv[j]) * __expf(bsum) * 0.125f);
                    KG[(size_t)(r0 + t) * 256] = f2bf(bf2f(kv[j]) * __expf(-bsum));
                }
            }
        } else if (it < NGLA + NR16) {
            const int r0 = (it - NGLA) * 16, c0 = 2 * tid;
            int t0, L; if (r0 < TL) { t0 = r0 & (SEQ - 1); L = SEQ; } else { t0 = (r0 - TL) & (CTXL - 1); L = CTXL; }
            const float* cw = p.in[I_SCONVW] + (size_t)l * 3 * 1024; const float* cb = p.in[I_SCONVB] + (size_t)l * 1024;
            const float2 w0 = *(const float2*)(cw + c0), w1 = *(const float2*)(cw + 1024 + c0), w2 = *(const float2*)(cw + 2048 + c0), bb = *(const float2*)(cb + c0);
            const bf16_t* up = U + (size_t)r0 * NU + U_XBC + c0;
            unsigned x[18];
            x[0] = t0 > 0 ? *(const unsigned*)(up - NU) : 0u;
#pragma unroll
            for (int j = 0; j < 16; ++j) x[j + 1] = *(const unsigned*)(up + (size_t)j * NU);
            x[17] = (t0 + 16 < L) ? *(const unsigned*)(up + (size_t)16 * NU) : 0u;
#pragma unroll
            for (int j = 0; j < 16; ++j) {
                const float o0 = bb.x + w0.x * bf2f(x[j] & 0xffff) + w1.x * bf2f(x[j + 1] & 0xffff) + w2.x * bf2f(x[j + 2] & 0xffff);
                const float o1 = bb.y + w0.y * bf2f(x[j] >> 16) + w1.y * bf2f(x[j + 1] >> 16) + w2.y * bf2f(x[j + 2] >> 16);
                *(unsigned*)(X + (size_t)(r0 + j) * 1024 + c0) = pk2(silu_f(o0), silu_f(o1));
            }
        } else {
            const int r0 = (it - NGLA - NR16) * 16;
            {
                const int rsel = tid >> 8, pp = tid & 255, isk = pp >> 7, idx = (2 * pp) & 255, rh = idx >> 6, rhalf = (idx >> 5) & 1, ri = idx & 31;
                const int rcol = (isk ? U_RK : U_RQ) + rh * 128 + rhalf * 64 + ri;
                const float rscale = isk ? 0.08838834764831845f : 1.f;
                const float f0 = exp2f(-(float)ri * (13.287712379549449f / 32.f)), f1 = exp2f(-(float)(ri + 1) * (13.287712379549449f / 32.f));
                unsigned a[8], b[8];
#pragma unroll
                for (int j = 0; j < 8; ++j) { const bf16_t* q = U + (size_t)(r0 + rsel * 8 + j) * NU + rcol; a[j] = *(const unsigned*)q; b[j] = *(const unsigned*)(q + 32); }
#pragma unroll
                for (int j = 0; j < 8; ++j) {
                    const int row = r0 + rsel * 8 + j;
                    float x1a = bf2f(a[j] & 0xffff), x1b = bf2f(a[j] >> 16), x2a = bf2f(b[j] & 0xffff), x2b = bf2f(b[j] >> 16);
                    if (row < TL) {
                        const int t = row & (SEQ - 1);
                        const float pos = (float)(rhalf ? (t & 63) : (t >> 6));
                        float ra = pos * f0 * 0.15915494309189535f, rb = pos * f1 * 0.15915494309189535f; ra -= floorf(ra); rb -= floorf(rb);
                        const float sa = __builtin_amdgcn_sinf(ra), ca = __builtin_amdgcn_cosf(ra), sb = __builtin_amdgcn_sinf(rb), cbv = __builtin_amdgcn_cosf(rb);
                        const float y1a = x1a * ca - x2a * sa, y2a = x1a * sa + x2a * ca, y1b = x1b * cbv - x2b * sb, y2b = x1b * sb + x2b * cbv;
                        x1a = y1a; x2a = y2a; x1b = y1b; x2b = y2b;
                    }
                    bf16_t* q = U + (size_t)row * NU + rcol;
                    *(unsigned*)q = pk2(x1a * rscale, x1b * rscale); *(unsigned*)(q + 32) = pk2(x2a * rscale, x2b * rscale);
                }
            }
            {
                const int row = r0 + (tid >> 5), ds = tid & 31, d = ds >> 4, slot = ds & 15;
                const float* gr = G + (size_t)row * 64;
                float loga, logw;
                if (slot < 4) {
                    const int h = slot;
                    logw = gr[d * 4 + h] + p.in[I_MIGB][(l * 2 + d) * 4 + h];
                    loga = logsigmoid_f(gr[8 + d * 4 + h] + p.in[I_MFGB][(l * 2 + d) * 4 + h]);
                } else if (slot < 12) {
                    const int h = slot - 4;
                    const float dt = softplus_f(gr[16 + d * 8 + h] + p.in[I_SDTB][(l * 2 + d) * 8 + h]);
                    loga = -dt * __expf(p.in[I_SALOG][(l * 2 + d) * 8 + h]); logw = __logf(dt);
                } else {
                    const int h = slot - 12;
                    loga = -__expf(p.in[I_RDECAY][(l * 2 + d) * 4 + h]); logw = 0.f;
                }
                GL[(size_t)(d * 16 + slot) * T + row] = make_float2(loga, logw);
            }
        }
    }
}

typedef short s16x4 __attribute__((ext_vector_type(4)));
#define LDSP(T_, ptr) ((__attribute__((address_space(3))) T_*)(ptr))
DI bf16x8 tr_frag(const bf16_t* lo_addr, int row_stride  ) {
    const s16x4 lo = __builtin_amdgcn_ds_read_tr16_b64_v4i16(LDSP(s16x4, lo_addr));
    const s16x4 hi = __builtin_amdgcn_ds_read_tr16_b64_v4i16(LDSP(s16x4, lo_addr + 4 * row_stride));
    return __builtin_shufflevector(lo, hi, 0, 1, 2, 3, 4, 5, 6, 7);
}
#define MFMA16(a, b, c) __builtin_amdgcn_mfma_f32_16x16x32_bf16((a), (b), (c), 0, 0, 0)
template <int MIX, bool DEN> struct ScanCfg {
    static constexpr int DK = MIX == 3 ? 64 : 128, NH = MIX == 1 ? 2 : 1, NT = DK / 16, KS2 = DK / 32;
    static constexpr int NVC = DEN ? 144 : 128;
    static constexpr int QST = DK + 8, VST = NVC + 8, PST = 72;
    static constexpr int SZQ = 64 * QST * 2, SZV = 64 * VST * 2, SZVEC = NH * 320 * 4;
    static constexpr int OFF_K = SZQ, OFF_V = 2 * SZQ, OFF_VEC = 2 * SZQ + SZV, BUF = 2 * SZQ + SZV + SZVEC;
    static constexpr int OFF_PW = 2 * BUF, SZP = NH * 64 * PST * 2;
    static_assert(OFF_PW + SZP <= LDS_BYTES, "scan LDS layout");
};
DI int chunk_base(int b, int d, int c) { if (c < 4) return TL + b * CTXL + (d ? 3 - c : c) * 64; const int cc = c - 4; return b * SEQ + (d ? 63 - cc : cc) * 64; }

template <int MIX, bool DEN>
__device__ void scan_item(const KP& p, int b, int d, int grp, unsigned char* smem) {
    using C = ScanCfg<MIX, DEN>;
    constexpr int DK = C::DK, NH = C::NH, NT = C::NT, KS2 = C::KS2, QST = C::QST, VST = C::VST, PST = C::PST;
    constexpr int QPR = DK / 8;
    constexpr int NQP = (64 * QPR) / 512;
    const int tid = otid(), lane = tid & 63, wid = __builtin_amdgcn_readfirstlane(tid >> 6);
    const int l15 = lane & 15, g4 = lane >> 4, tq = l15 >> 2, tp = l15 & 3;
    const bf16_t* U = (const bf16_t*)(p.ws + WS_U); const bf16_t* X = (const bf16_t*)(p.ws + WS_XBC);
    const bf16_t *qsrc, *ksrc, *vsrc; int qld, vld;
    if (MIX == 0) { qsrc = U + U_MQ + grp * 128; ksrc = U + U_MK + grp * 128; vsrc = U + U_MV + grp * 128; qld = NU; vld = NU; }
    if (MIX == 1) { qsrc = X + 768 + (grp >> 1) * 128; ksrc = X + 512 + (grp >> 1) * 128; vsrc = X + grp * 128; qld = 1024; vld = 1024; }
    if (MIX == 2) { qsrc = U + U_RQ + grp * 128; ksrc = U + U_RK + grp * 128; vsrc = U + U_RV + grp * 128; qld = NU; vld = NU; }
    if (MIX == 3) { qsrc = (const bf16_t*)(p.ws + WS_QG) + (size_t)d * T * 256 + grp * 64; ksrc = (const bf16_t*)(p.ws + WS_KG) + (size_t)d * T * 256 + grp * 64; vsrc = U + U_GV + grp * 128; qld = 256; vld = NU; }
    const int slot0 = MIX == 0 ? grp : MIX == 1 ? 4 + 2 * grp : 12 + grp;
    const float2* GL = (const float2*)(p.ws + WS_GL) + (size_t)(d * 16 + slot0 + (wid < NH ? wid : 0)) * T;
    const float* EE = (const float*)(p.ws + WS_EE) + (size_t)d * (T / 64) * 256 + grp * 64;
    bf16_t* YS = (bf16_t*)(p.ws + WS_YS) + (size_t)d * T * D + MIX * 512 + grp * 128;
    float* DENP = (float*)(p.ws + WS_DEN) + (size_t)d * T * 4 + grp;
    constexpr float LOGQS = MIX == 0 ? -2.4260151319598084f : 0.f;

    __syncthreads();
    for (int i = tid; i < C::SZP / 4; i += 512) ((unsigned*)(smem + C::OFF_PW))[i] = 0u;
    if (DEN) {
        for (int i = tid; i < 2 * 64 * 16; i += 512) { const int bf = i >> 10, r = (i >> 4) & 63, cc = i & 15; ((bf16_t*)(smem + bf * C::BUF + C::OFF_V))[r * VST + 128 + cc] = cc == 0 ? (bf16_t)0x3F80 : (bf16_t)0; }
    }
    f32x4 S0[NT];
#pragma unroll
    for (int t = 0; t < NT; ++t) S0[t] = (f32x4){0.f, 0.f, 0.f, 0.f};

    u32x4 rqA[NQP], rkA[NQP], rvA[2], rqB[NQP], rkB[NQP], rvB[2]; float gxA = 0.f, gyA = 0.f, eeA = 0.f, gxB = 0.f, gyB = 0.f, eeB = 0.f;
#define ISSUE_ALL(c_, S_) do { \
        const int base_ = chunk_base(b, d, (c_)); \
_Pragma("unroll") \
        for (int i = 0; i < NQP; ++i) { const int pc = tid + 512 * i, r = pc / QPR, c8 = pc % QPR; const size_t row = (size_t)(base_ + (d ? 63 - r : r)); \
            rq##S_[i] = *(const u32x4*)(qsrc + row * qld + c8 * 8); rk##S_[i] = *(const u32x4*)(ksrc + row * qld + c8 * 8); } \
_Pragma("unroll") \
        for (int i = 0; i < 2; ++i) { const int pc = tid + 512 * i, r = pc >> 4, c8 = pc & 15; const size_t row = (size_t)(base_ + (d ? 63 - r : r)); \
            rv##S_[i] = *(const u32x4*)(vsrc + row * vld + c8 * 8); } \
        if (MIX != 3) { if (wid < NH) { const float2 g_ = GL[base_ + (d ? 63 - lane : lane)]; gx##S_ = g_.x; gy##S_ = g_.y; } } \
        else if (wid == 0) ee##S_ = EE[(size_t)(base_ >> 6) * 256 + lane]; \
    } while (0)
#define STAGE_ALL(bufi, S_) do { \
        unsigned char* B_ = smem + (bufi) * C::BUF; \
_Pragma("unroll") \
        for (int i = 0; i < NQP; ++i) { const int pc = tid + 512 * i, r = pc / QPR, c8 = pc % QPR; \
            *(u32x4*)((bf16_t*)B_ + r * QST + c8 * 8) = rq##S_[i]; *(u32x4*)((bf16_t*)(B_ + C::OFF_K) + r * QST + c8 * 8) = rk##S_[i]; } \
_Pragma("unroll") \
        for (int i = 0; i < 2; ++i) { const int pc = tid + 512 * i, r = pc >> 4, c8 = pc & 15; *(u32x4*)((bf16_t*)(B_ + C::OFF_V) + r * VST + c8 * 8) = rv##S_[i]; } \
        float* vec_ = (float*)(B_ + C::OFF_VEC); \
        if (MIX != 3) { \
            if (wid < NH) { \
                float bc = gx##S_; \
                bc += __uint_as_float(__builtin_amdgcn_update_dpp(0, __float_as_uint(bc), 0x111, 0xf, 0xf, false)); \
                bc += __uint_as_float(__builtin_amdgcn_update_dpp(0, __float_as_uint(bc), 0x112, 0xf, 0xf, false)); \
                bc += __uint_as_float(__builtin_amdgcn_update_dpp(0, __float_as_uint(bc), 0x114, 0xf, 0xf, false)); \
                bc += __uint_as_float(__builtin_amdgcn_update_dpp(0, __float_as_uint(bc), 0x118, 0xf, 0xf, false)); \
                bc += __uint_as_float(__builtin_amdgcn_update_dpp(0, __float_as_uint(bc), 0x142, 0xa, 0xf, false)); \
                bc += __uint_as_float(__builtin_amdgcn_update_dpp(0, __float_as_uint(bc), 0x143, 0xc, 0xf, false)); \
                const float bend = __uint_as_float(__builtin_amdgcn_readlane(__float_as_uint(bc), 63)); \
                const float rt = bc + LOGQS, ct = gy##S_ - bc; \
                float* v = vec_ + wid * 320; \
                v[lane] = rt; v[64 + lane] = ct; v[128 + lane] = __expf(rt); v[192 + lane] = __expf(bend + ct); v[256 + lane] = __expf(bend); \
            } \
        } else if (wid == 0) vec_[256 + lane] = ee##S_; \
    } while (0)

    ISSUE_ALL(0, A);
    STAGE_ALL(0, A);
    ISSUE_ALL(1, B);
    __syncthreads();

    for (int c2 = 0; c2 < (CTXL + SEQ) / 64; c2 += 2) {
#pragma unroll
    for (int par = 0; par < 2; ++par) {
        const int c = c2 + par;
        const int cur = par;
        const int base = chunk_base(b, d, c);
        unsigned char* B = smem + cur * C::BUF;
        const bf16_t* Qs = (const bf16_t*)B; const bf16_t* Ks = (const bf16_t*)(B + C::OFF_K); const bf16_t* Vs = (const bf16_t*)(B + C::OFF_V);
        const float* vec = (const float*)(B + C::OFF_VEC);
        bf16_t* Pw = (bf16_t*)(smem + C::OFF_PW);
        bf16_t* ysb = YS + (size_t)base * D;
        if (c + 2 < (CTXL + SEQ) / 64) { if (par == 0) ISSUE_ALL(c + 2, A); else ISSUE_ALL(c + 2, B); }
#pragma unroll
        for (int rep = 0; rep < 2; ++rep) {
            const int tl = rep == 0 ? wid : wid + 2;
            if (rep == 1 && wid < 6) break;
            const int it = tl >= 6 ? 3 : tl >= 3 ? 2 : tl >= 1 ? 1 : 0, jt = tl - ((it * (it + 1)) >> 1);
            f32x4 acc = (f32x4){0.f, 0.f, 0.f, 0.f};
            bf16x8 pa[KS2], pb[KS2];
#pragma unroll
            for (int ks = 0; ks < KS2; ++ks) {
                pa[ks] = *LDSP(const bf16x8, Ks + (jt * 16 + l15) * QST + ks * 32 + g4 * 8);
                pb[ks] = *LDSP(const bf16x8, Qs + (it * 16 + l15) * QST + ks * 32 + g4 * 8);
            }
            __builtin_amdgcn_sched_barrier(0);
#pragma unroll
            for (int ks = 0; ks < KS2; ++ks) acc = MFMA16(pa[ks], pb[ks], acc);
            const int i = it * 16 + l15, j0 = jt * 16 + g4 * 4;
#pragma unroll
            for (int h = 0; h < NH; ++h) {
                float w[4];
                if (MIX != 3) {
                    const float rt = vec[h * 320 + i]; const f32x4 ct = *LDSP(const f32x4, vec + h * 320 + 64 + j0);
#pragma unroll
                    for (int r = 0; r < 4; ++r) w[r] = (j0 + r <= i) ? __expf(rt + ct[r]) : 0.f;
                } else {
#pragma unroll
                    for (int r = 0; r < 4; ++r) w[r] = (j0 + r <= i) ? 1.f : 0.f;
                }
                u32x2 o; o.x = pg8::cvt_pk_bf16(acc[0] * w[0], acc[1] * w[1]); o.y = pg8::cvt_pk_bf16(acc[2] * w[2], acc[3] * w[3]);
                *LDSP(u32x2, Pw + (h * 64 + i) * PST + j0) = o;
            }
        }
        __syncthreads();
#define SB_() __builtin_amdgcn_sched_barrier(0)
#define QFRAG(dst, it_, ks_) do { \
            const s16x4 a0_ = *LDSP(const s16x4, Qs + ((it_) * 16 + l15) * QST + (ks_) * 32 + g4 * 4); \
            const s16x4 a1_ = *LDSP(const s16x4, Qs + ((it_) * 16 + l15) * QST + (ks_) * 32 + 16 + g4 * 4); \
            dst = __builtin_shufflevector(a0_, a1_, 0, 1, 2, 3, 4, 5, 6, 7); } while (0)
#define SPACK(dst, S, ks_) do { u32x4 sb_; sb_.x = pg8::cvt_pk_bf16(S[2 * (ks_)][0], S[2 * (ks_)][1]); sb_.y = pg8::cvt_pk_bf16(S[2 * (ks_)][2], S[2 * (ks_)][3]); \
            sb_.z = pg8::cvt_pk_bf16(S[2 * (ks_) + 1][0], S[2 * (ks_) + 1][1]); sb_.w = pg8::cvt_pk_bf16(S[2 * (ks_) + 1][2], S[2 * (ks_) + 1][3]); dst = __builtin_bit_cast(bf16x8, sb_); } while (0)
#define SLICE(S, sl) do { \
            const int hh = MIX == 1 ? (sl) >> 2 : 0, vc0 = (sl) * 16; \
            const float* vh = vec + hh * 320; \
            f32x4 Y[4]; \
_Pragma("unroll") \
            for (int it = 0; it < 4; ++it) Y[it] = (f32x4){0.f, 0.f, 0.f, 0.f}; \
              \
            { bf16x8 QA[2][4]; \
_Pragma("unroll") \
              for (int ks = 0; ks < 2; ++ks) \
_Pragma("unroll") \
                for (int it = 0; it < 4; ++it) QFRAG(QA[ks][it], it, ks); \
              SB_(); \
_Pragma("unroll") \
              for (int ks = 0; ks < 2; ++ks) { bf16x8 sbf; SPACK(sbf, S, ks); \
_Pragma("unroll") \
                for (int it = 0; it < 4; ++it) Y[it] = MFMA16(sbf, QA[ks][it], Y[it]); } } \
            SB_(); \
            if (KS2 == 4) { bf16x8 QB[2][4]; \
_Pragma("unroll") \
              for (int ks = 0; ks < 2; ++ks) \
_Pragma("unroll") \
                for (int it = 0; it < 4; ++it) QFRAG(QB[ks][it], it, ks + 2); \
              SB_(); \
_Pragma("unroll") \
              for (int ks = 0; ks < 2; ++ks) { bf16x8 sbf; SPACK(sbf, S, ks + 2); \
_Pragma("unroll") \
                for (int it = 0; it < 4; ++it) Y[it] = MFMA16(sbf, QB[ks][it], Y[it]); } } \
            SB_(); \
              \
            bf16x8 Vf[2], PA[6]; \
_Pragma("unroll") \
            for (int ks = 0; ks < 2; ++ks) Vf[ks] = tr_frag(Vs + (ks * 32 + g4 * 8 + tq) * VST + vc0 + 4 * tp, VST); \
            PA[0] = *LDSP(const bf16x8, Pw + (hh * 64 + 0 * 16 + l15) * PST + 0 * 32 + g4 * 8); \
            PA[1] = *LDSP(const bf16x8, Pw + (hh * 64 + 1 * 16 + l15) * PST + 0 * 32 + g4 * 8); \
            PA[2] = *LDSP(const bf16x8, Pw + (hh * 64 + 2 * 16 + l15) * PST + 0 * 32 + g4 * 8); \
            PA[3] = *LDSP(const bf16x8, Pw + (hh * 64 + 2 * 16 + l15) * PST + 1 * 32 + g4 * 8); \
            PA[4] = *LDSP(const bf16x8, Pw + (hh * 64 + 3 * 16 + l15) * PST + 0 * 32 + g4 * 8); \
            PA[5] = *LDSP(const bf16x8, Pw + (hh * 64 + 3 * 16 + l15) * PST + 1 * 32 + g4 * 8); \
            if (MIX != 3) { \
_Pragma("unroll") \
                for (int it = 0; it < 4; ++it) Y[it] = Y[it] * vh[128 + it * 16 + l15]; \
            } \
            SB_(); \
            Y[0] = MFMA16(Vf[0], PA[0], Y[0]); Y[1] = MFMA16(Vf[0], PA[1], Y[1]); Y[2] = MFMA16(Vf[0], PA[2], Y[2]); Y[3] = MFMA16(Vf[0], PA[4], Y[3]); \
            Y[2] = MFMA16(Vf[1], PA[3], Y[2]); Y[3] = MFMA16(Vf[1], PA[5], Y[3]); \
            SB_(); \
              \
_Pragma("unroll") \
            for (int it = 0; it < 4; ++it) { \
                const int i = it * 16 + l15; const int ro = (d ? 63 - i : i); \
                const f32x4 y = Y[it]; \
                if (DEN) { if (g4 == 0) DENP[((size_t)base + ro) * 4] = y[0]; } \
                else { u32x2 o; o.x = pg8::cvt_pk_bf16(y[0], y[1]); o.y = pg8::cvt_pk_bf16(y[2], y[3]); *(u32x2*)(ysb + ro * D + vc0 + g4 * 4) = o; } \
            } \
            SB_(); \
            bf16x8 Vw[2]; float dec = 1.f; \
            if (MIX != 3) { \
                dec = vh[256]; \
_Pragma("unroll") \
                for (int ks = 0; ks < 2; ++ks) { \
                    const f32x4 w0 = *LDSP(const f32x4, vh + 192 + ks * 32 + g4 * 8), w1 = *LDSP(const f32x4, vh + 192 + ks * 32 + g4 * 8 + 4); \
                    u32x4 o; \
                    o.x = pg8::cvt_pk_bf16(bf2f((unsigned short)Vf[ks][0]) * w0[0], bf2f((unsigned short)Vf[ks][1]) * w0[1]); \
                    o.y = pg8::cvt_pk_bf16(bf2f((unsigned short)Vf[ks][2]) * w0[2], bf2f((unsigned short)Vf[ks][3]) * w0[3]); \
                    o.z = pg8::cvt_pk_bf16(bf2f((unsigned short)Vf[ks][4]) * w1[0], bf2f((unsigned short)Vf[ks][5]) * w1[1]); \
                    o.w = pg8::cvt_pk_bf16(bf2f((unsigned short)Vf[ks][6]) * w1[2], bf2f((unsigned short)Vf[ks][7]) * w1[3]); \
                    Vw[ks] = __builtin_bit_cast(bf16x8, o); \
                } \
            } else { Vw[0] = Vf[0]; Vw[1] = Vf[1]; } \
              \
_Pragma("unroll") \
            for (int th = 0; th < NT / 4; ++th) { \
                bf16x8 KA[4][2]; \
_Pragma("unroll") \
                for (int t = 0; t < 4; ++t) \
_Pragma("unroll") \
                    for (int ks = 0; ks < 2; ++ks) KA[t][ks] = tr_frag(Ks + (ks * 32 + g4 * 8 + tq) * QST + (th * 4 + t) * 16 + 4 * tp, QST); \
                SB_(); \
_Pragma("unroll") \
                for (int t = 0; t < 4; ++t) { \
                    f32x4 acc = S[th * 4 + t] * dec; \
                    acc = MFMA16(KA[t][0], Vw[0], acc); acc = MFMA16(KA[t][1], Vw[1], acc); \
                    if (MIX == 3) { const f32x4 e4 = *LDSP(const f32x4, vec + 256 + (th * 4 + t) * 16 + g4 * 4); acc = acc * e4; } \
                    S[th * 4 + t] = acc; \
                } \
                SB_(); \
            } \
    } while (0)
        if (!DEN) SLICE(S0, wid);
        else if (wid == 0) SLICE(S0, 8);
        if (c + 1 < (CTXL + SEQ) / 64) { if (par == 0) STAGE_ALL(1, B); else STAGE_ALL(0, A); }
        __syncthreads();
    }
    }
}
__device__ void phase_scan(const KP& p, int l, unsigned char* smem) {
    if (ogdim() > 160 && obid() >= 160) {
        const int w = obid() - 160, nw = ogdim() - 160;
        convert_weights(p, l, CT_IN, CT_IN + CT_OUT + CT_UP + CT_DN, w, nw, smem);
        if (l == 0) convert_weights(p, 1, 0, CT_IN, w, nw, smem);
        return;
    }
    for (int item = obid(); item < 160; item += ogdim()) {
        if (item >= 128) { const int idx = item - 128; scan_item<0, true>(p, idx >> 3, (idx >> 2) & 1, idx & 3, smem); continue; }
        const int grp = item & 3, mix = (item >> 2) & 3, d = (item >> 4) & 1, b = item >> 5;
        if (mix == 0) scan_item<0, false>(p, b, d, grp, smem);
        else if (mix == 1) scan_item<1, false>(p, b, d, grp, smem);
        else if (mix == 2) scan_item<2, false>(p, b, d, grp, smem);
        else scan_item<3, false>(p, b, d, grp, smem);
    }
    if (ogdim() <= 160) {
        convert_weights(p, l, CT_IN, CT_IN + CT_OUT + CT_UP + CT_DN, obid(), ogdim(), smem);
        if (l == 0) convert_weights(p, 1, 0, CT_IN, obid(), ogdim(), smem);
    }
}

struct CombRaw { bf16x8 a[4], b[4], g[4], xs[4]; float s0, s1; };
DI void comb_load(const KP& p, int row, int lane, int mixer, int ec0, int gcol, CombRaw& r) {
    const bf16_t* U = (const bf16_t*)(p.ws + WS_U); const bf16_t* X = (const bf16_t*)(p.ws + WS_XBC);
    const bf16_t* YS = (const bf16_t*)(p.ws + WS_YS); const float* DEN = (const float*)(p.ws + WS_DEN);
    const bf16_t* y0p = YS + (size_t)row * D + mixer * 512 + ec0; const bf16_t* y1p = y0p + (size_t)T * D;
    r.s0 = 1.f; r.s1 = 1.f;
    if (mixer == 0) { const int h = (lane & 15) >> 2; r.s0 = DEN[(size_t)row * 4 + h]; r.s1 = DEN[((size_t)T + row) * 4 + h]; }
#pragma unroll
    for (int i = 0; i < 4; ++i) { r.a[i] = *(const bf16x8*)(y0p + i * 8); r.b[i] = *(const bf16x8*)(y1p + i * 8); r.g[i] = *(const bf16x8*)(U + (size_t)row * NU + gcol + i * 8); }
    if (mixer == 1) {
#pragma unroll
        for (int i = 0; i < 4; ++i) r.xs[i] = *(const bf16x8*)(X + (size_t)row * 1024 + ec0 + i * 8);
    }
}
DI void comb_compute(const KP& p, int row, int lane, int mixer, int ec0, const float* gain, float sd, const CombRaw& r) {
    bf16_t* H = (bf16_t*)(p.ws + WS_H);
    float y[32], gt[32];
    float s0 = 1.f, s1 = 1.f;
    if (mixer == 0) { s0 = 1.f / fmaxf(fabsf(r.s0), 1.f); s1 = 1.f / fmaxf(fabsf(r.s1), 1.f); }
#pragma unroll
    for (int i = 0; i < 4; ++i) {
#pragma unroll
        for (int j = 0; j < 8; ++j) {
            y[i * 8 + j] = bf2f((unsigned short)r.a[i][j]) * s0 + bf2f((unsigned short)r.b[i][j]) * s1;
            const float gv = bf2f((unsigned short)r.g[i][j]);
            gt[i * 8 + j] = mixer == 0 ? sigmoid_f(gv) : silu_f(gv);
        }
    }
    if (mixer == 1) {
#pragma unroll
        for (int i = 0; i < 4; ++i) {
#pragma unroll
            for (int j = 0; j < 8; ++j) { y[i * 8 + j] = (y[i * 8 + j] + sd * bf2f((unsigned short)r.xs[i][j])) * gt[i * 8 + j]; gt[i * 8 + j] = 1.f; }
        }
    }
    float s = 0.f;
#pragma unroll
    for (int j = 0; j < 32; ++j) s += y[j];
    s += shx(s, 1, lane); s += shx(s, 2, lane);
    const float mean = (mixer == 0 || mixer == 2) ? s * (1.f / 128.f) : 0.f;
    float q = 0.f;
#pragma unroll
    for (int j = 0; j < 32; ++j) { y[j] -= mean; q += y[j] * y[j]; }
    q += shx(q, 1, lane); q += shx(q, 2, lane);
    float q16 = q; q16 += shx(q16, 4, lane); q16 += shx(q16, 8, lane);
    const float rstd = rsqrtf((mixer == 1 ? q16 * (1.f / 512.f) : q * (1.f / 128.f)) + EPS);
    bf16_t* op = H + (size_t)row * D + mixer * 512 + ec0;
#pragma unroll
    for (int i = 0; i < 4; ++i) {
        const f32x4 g0 = *(const f32x4*)(gain + i * 8), g1 = *(const f32x4*)(gain + i * 8 + 4);
        u32x4 w;
        w.x = pg8::cvt_pk_bf16(y[i * 8 + 0] * rstd * g0[0] * gt[i * 8 + 0], y[i * 8 + 1] * rstd * g0[1] * gt[i * 8 + 1]);
        w.y = pg8::cvt_pk_bf16(y[i * 8 + 2] * rstd * g0[2] * gt[i * 8 + 2], y[i * 8 + 3] * rstd * g0[3] * gt[i * 8 + 3]);
        w.z = pg8::cvt_pk_bf16(y[i * 8 + 4] * rstd * g1[0] * gt[i * 8 + 4], y[i * 8 + 5] * rstd * g1[1] * gt[i * 8 + 5]);
        w.w = pg8::cvt_pk_bf16(y[i * 8 + 6] * rstd * g1[2] * gt[i * 8 + 6], y[i * 8 + 7] * rstd * g1[3] * gt[i * 8 + 7]);
        *(u32x4*)(op + i * 8) = w;
    }
}
__device__ void phase_comb(const KP& p, int l, int Mrows) {
    const int tid = otid(); const int lane = tid & 63, wid = tid >> 6;
    const int mixer = lane >> 4, ec0 = (lane & 15) * 32;
    const int gcol = (mixer == 0 ? U_MO : mixer == 1 ? U_SZ : mixer == 2 ? U_RG : U_GG) + ec0;
    const float* gain = (mixer == 0 ? p.in[I_MNORM] : mixer == 1 ? p.in[I_SNORM] : mixer == 2 ? p.in[I_RNORM] : p.in[I_GNORM]) + l * 512 + ec0;
    const float sd = p.in[I_SD][l * 8 + (ec0 >> 6)];
    const int stride = ogdim() * 8;
    for (int row = obid() * 8 + wid; row < Mrows; row += 2 * stride) {
        const int row1 = row + stride; const bool has1 = row1 < Mrows;
        CombRaw r0, r1;
        comb_load(p, row, lane, mixer, ec0, gcol, r0);
        if (has1) comb_load(p, row1, lane, mixer, ec0, gcol, r1);
        comb_compute(p, row, lane, mixer, ec0, gain, sd, r0);
        if (has1) comb_compute(p, row1, lane, mixer, ec0, gain, sd, r1);
    }
}

__device__ void run_phase(const KP& p, int ph, unsigned char* smem) {
    const float* mod = (const float*)(p.ws + WS_MOD);
    if (ph == 0) { phase_init(p, smem); return; }
    if (ph == 1) { phase_row<false, true, true>(p, T, nullptr, nullptr, mod, 0, 2048); return; }
    const int l = (ph - 2) / 9, k = (ph - 2) % 9;
    const bool last = l == 1;
    const int Mrows = last ? TL : T;
    const float* modl = mod + (size_t)l * 5 * NMOD;
    bf16_t* H = (bf16_t*)(p.ws + WS_H); bf16_t* U = (bf16_t*)(p.ws + WS_U);
    if (k == 0 || k == 4 || k == 6 || k == 7) {
        EpiAll E; E.kind = k == 0 ? 0 : (k == 6 ? 2 : 1); E.O = E.kind == 1 ? (bf16_t*)(p.ws + WS_YS) : U; E.G = (float*)(p.ws + WS_GATES); E.gmod = modl + (k == 4 ? 4096 : 10240);
        const bf16_t* A = k == 7 ? U : H;
        const bf16_t* Bt = (const bf16_t*)(p.ws + (k == 0 ? WS_WIN : k == 4 ? WS_WOUT : k == 6 ? WS_WUP : WS_WDN));
        const int N = k == 0 ? NINP : (k == 6 ? NUP : D), K = k == 7 ? DFF : D;
        const bool split = !last && (k == 4 || k == 7);
        const int M = (k == 0 || k == 6) ? (k == 0 ? T : Mrows) : TL;
        run_gemm(smem, A, Bt, M, N, K, E);
        if (split) {
            const int nsplit = k == 4 ? 8 : 4;
            EpiAll E2 = E; E2.kind = 3; E2.G = (float*)(p.ws + WS_YS + (size_t)T * D * 2);
            pg8::Gemm g; g.A = A + (size_t)TL * K; g.Bt = Bt; g.M = TC; g.N = D; g.K = K / nsplit; g.ld = K;
            SplitOrder S; S.nsplit = nsplit; S.G = ogdim(); S.c = obid();
            pg8::gemm_phase<EpiAll, SplitOrder, false>((PG8_LAS unsigned char*)smem, g, S, E2, nullptr);
        }
        return;
    }
    switch (k) {
    case 1: phase_pre(p, l, smem); break;
    case 2: phase_scan(p, l, smem); break;
    case 3: phase_comb(p, l, Mrows); break;
    case 5:
        if (l == 0) phase_row<true, true, true>(p, Mrows, p.in[I_POSTG] + (size_t)(l * 2 + 0) * D, p.in[I_POSTB] + (size_t)(l * 2 + 0) * D, modl, 6144, 8192, (const float*)(p.ws + WS_YS + (size_t)T * D * 2), 8);
        else phase_row<true, true, false>(p, Mrows, p.in[I_POSTG] + (size_t)(l * 2 + 0) * D, p.in[I_POSTB] + (size_t)(l * 2 + 0) * D, modl, 6144, 8192);
        break;
    case 8:
        if (!last) { phase_row<true, true>(p, T, p.in[I_POSTG] + (size_t)(l * 2 + 1) * D, p.in[I_POSTB] + (size_t)(l * 2 + 1) * D, modl + 5 * NMOD, 0, 2048, (const float*)(p.ws + WS_YS + (size_t)T * D * 2), 4); }
        else phase_row<true, false>(p, TL, p.in[I_POSTG] + (size_t)(l * 2 + 1) * D, p.in[I_POSTB] + (size_t)(l * 2 + 1) * D, modl, 0, 0);
        break;
    }
}

DI void grid_barrier(unsigned* bar, unsigned target) {
    asm volatile("s_waitcnt vmcnt(0) lgkmcnt(0)" ::: "memory");
    __syncthreads();
    if (threadIdx.x == 0) {
        __builtin_amdgcn_fence(__ATOMIC_RELEASE, "agent");
        asm volatile("s_waitcnt vmcnt(0)" ::: "memory");
        __hip_atomic_fetch_add(bar, 1u, __ATOMIC_RELAXED, __HIP_MEMORY_SCOPE_AGENT);
        while (__hip_atomic_load(bar, __ATOMIC_RELAXED, __HIP_MEMORY_SCOPE_AGENT) < target) __builtin_amdgcn_s_sleep(1);
        __builtin_amdgcn_fence(__ATOMIC_ACQUIRE, "agent");
        asm volatile("s_waitcnt vmcnt(0)" ::: "memory");
    }
    __syncthreads();
}
#ifndef PROBE_MASK
#define PROBE_MASK 0u
#endif
__global__ void __launch_bounds__(512, 2) mega(KP p) {
    extern __shared__ __attribute__((aligned(16))) unsigned char smem[];
    cg::grid_group grid = cg::this_grid();
    unsigned nbar = 0;
    unsigned long long tacc = 0ull;
    for (int ph = p.ph_lo; ph < p.ph_hi; ++ph) {
        unsigned long long t0 = 0ull;
        if (PROBE_MASK != 0u) t0 = __builtin_amdgcn_s_memrealtime();
        if (ph == 0 && blockIdx.x == 0 && threadIdx.x == 0) __hip_atomic_store((unsigned*)(p.ws + WS_BAR), 0u, __ATOMIC_RELAXED, __HIP_MEMORY_SCOPE_AGENT);
        run_phase(p, ph, smem);
        if (ph + 1 < p.ph_hi) {
            if (ph == 0) grid.sync();
            else { ++nbar; grid_barrier((unsigned*)(p.ws + WS_BAR), nbar * gridDim.x); }
        }
        if (PROBE_MASK != 0u && ((PROBE_MASK >> ph) & 1u)) tacc += __builtin_amdgcn_s_memrealtime() - t0;
    }
    if (PROBE_MASK != 0u && blockIdx.x == 0 && threadIdx.x == 0) {
        const unsigned long long t1 = __builtin_amdgcn_s_memrealtime();
        while (__builtin_amdgcn_s_memrealtime() - t1 < tacc) __builtin_amdgcn_s_sleep(8);
    }
}

#ifndef ONE_LAUNCH
#define ONE_LAUNCH 1
#endif
extern "C" void kernel_launch(void* const* d_in, const int* in_sizes, int n_in, void* d_out, int out_size, void* d_ws, size_t ws_size, hipStream_t stream) {
    static int grid = 0;
    if (grid == 0) {
        if (n_in != 26 || out_size != TL * D || ws_size < WS_END) { fprintf(stderr, "kernel_launch: unexpected shapes (n_in %d out %d ws %zu need %zu)\n", n_in, out_size, ws_size, (size_t)WS_END); grid = -1; return; }
        int dev = 0, cus = 0, per_cu = 0;
        hipGetDevice(&dev); hipDeviceGetAttribute(&cus, hipDeviceAttributeMultiprocessorCount, dev);
        if (hipFuncSetAttribute((const void*)mega, hipFuncAttributeMaxDynamicSharedMemorySize, LDS_BYTES) != hipSuccess) { fprintf(stderr, "kernel_launch: hipFuncSetAttribute failed\n"); grid = -1; return; }
        if (hipOccupancyMaxActiveBlocksPerMultiprocessor(&per_cu, (const void*)mega, 512, LDS_BYTES) != hipSuccess || per_cu < 1) { fprintf(stderr, "kernel_launch: occupancy query gives %d\n", per_cu); per_cu = 1; }
        (void)hipGetLastError();
        grid = cus;
    }
    if (grid < 0) return;
    KP p{};
    for (int i = 0; i < 26; ++i) p.in[i] = (const float*)d_in[i];
    p.out = (float*)d_out; p.ws = (unsigned char*)d_ws;
#if ONE_LAUNCH
    p.ph_lo = 0; p.ph_hi = NPHASE;
    void* args[] = {&p};
    hipError_t e = hipLaunchCooperativeKernel((const void*)mega, dim3(grid), dim3(512), args, LDS_BYTES, stream);
    if (e != hipSuccess) fprintf(stderr, "cooperative launch failed: %s (grid %d)\n", hipGetErrorString(e), grid);
#else
    for (int ph = 0; ph < NPHASE; ++ph) {
        p.ph_lo = ph; p.ph_hi = ph + 1;
        hipLaunchKernelGGL(mega, dim3(grid), dim3(512), LDS_BYTES, stream, p);
    }
#endif
}
```

```cpp
#include <hip/hip_runtime.h>
#include <hip/hip_cooperative_groups.h>
#include <cstdio>
namespace cg = cooperative_groups;
namespace pg8 {
#define PG8_LAS __attribute__((address_space(3)))
typedef unsigned short bf16_t;
typedef short bf16x8 __attribute__((ext_vector_type(8)));
typedef float f32x4 __attribute__((ext_vector_type(4)));
typedef unsigned u32x4 __attribute__((ext_vector_type(4)));
constexpr int BM = 256, BK = 64, HALF = 128, HTB = HALF * BK * 2  , STAGE_BYTES = 8 * HTB, NXCD = 8, WGM = 8;

__host__ __device__ __forceinline__ int lds_byte(int r, int c) { const int st = (r >> 4) * 2 + (c >> 5), rr = r & 15, cc = c & 31, ob = rr * 64 + cc * 2; return st * 1024 + (ob ^ (((ob >> 9) & 1) << 5)); }
__host__ __device__ __forceinline__ void stage_rc(int b, int& R, int& C) { const int st = b / 1024, sb = b % 1024, swz = sb ^ (((sb >> 9) & 1) << 5); R = (st >> 1) * 16 + swz / 64; C = (st & 1) * 32 + (swz % 64) / 2; }
__host__ __device__ __forceinline__ int perm32(int rho) { const int n = rho >> 4, i = rho & 15; return 8 * (i >> 2) + 4 * n + (i & 3); }

struct Unit { int pm, pn, ks; };
struct Gemm { const bf16_t* A; const bf16_t* Bt; int M, N, K, ld; };

struct StaticOrder {
    int nM, nN, nwg, G, c;
    __host__ __device__ void init(int M, int N, int G_, int c_) { nM = M / BM; nN = N / BM; nwg = nM * nN; G = G_; c = c_; }
    __host__ __device__ bool next(int i, Unit& u) const {
        const long L = (long)i * G + c; if (L >= nwg) return false;
        int wgid = (int)L; { const int q = nwg / NXCD, r = nwg % NXCD, xcd = wgid % NXCD, off = wgid / NXCD; wgid = (xcd < r ? xcd * (q + 1) : r * (q + 1) + (xcd - r) * q) + off; }
        const int nig = WGM * nN, gid = wgid / nig, fm = gid * WGM, gsz = (nM - fm) < WGM ? (nM - fm) : WGM;
        u.pm = fm + ((wgid % nig) % gsz); u.pn = (wgid % nig) / gsz; u.ks = 0; return true;
    }
    __device__ __forceinline__ void a_ready(const Unit&) const {}
    __device__ __forceinline__ void done(const Unit&) const {}
};
__device__ __forceinline__ unsigned cvt_pk_bf16(float lo, float hi) { unsigned r; asm volatile("v_cvt_pk_bf16_f32 %0, %1, %2" : "=v"(r) : "v"(lo), "v"(hi)); return r; }
template <class Epi, class Sched, bool STAMP = false>
__device__ __forceinline__ void gemm_phase(PG8_LAS unsigned char* lds, const Gemm g, const Sched& S, const Epi& E, unsigned long long* stamps) {
    int tid_ = threadIdx.x; asm volatile("" : "+v"(tid_)); const int tid = tid_, wid = __builtin_amdgcn_readfirstlane(tid >> 6), lane = tid & 63, wr = wid >> 2, wc = wid & 3, fr = lane & 15, fq = lane >> 4;
    const int K = g.ld, nt = g.K / BK; const size_t sstep = (size_t)g.K * 2;
    int ts_lo = 0, ts_hi = 0, nts = 0; const unsigned long long rt_entry = STAMP ? (unsigned long long)wall_clock64() : 0ull;
#define PG8_STAMP() do { if (STAMP && wid == 0 && nts < 64) { const unsigned long long _c = (unsigned long long)clock64(); \
        ts_lo = (lane == nts) ? (int)(unsigned)_c : ts_lo; ts_hi = (lane == nts) ? (int)(unsigned)(_c >> 32) : ts_hi; ++nts; } } while (0)
    PG8_STAMP();
    unsigned voffA[2], voffB[2];
#pragma unroll
    for (int i = 0; i < 2; ++i) { int R, C; stage_rc(tid * 16 + i * 8192, R, C); const int Rb = Epi::PERM ? ((R & ~31) + perm32(R & 31)) : R;
        voffA[i] = (unsigned)(R * K + C) * 2u; voffB[i] = (unsigned)(Rb * K + C) * 2u; }
    const size_t kstep = (size_t)(BK * 2);
    const size_t hstep = (size_t)HALF * K * 2;
    const size_t tstep = 2 * hstep;
    const unsigned ldsw = (unsigned)wid * 1024u;
    const int aoff = lds_byte(wr * 64 + fr, fq * 8), boff = lds_byte(wc * 32 + fr, fq * 8);
#define PG8_SA(b, h) (((b) * 2 + (h)) * HTB)
#define PG8_SB(b, h) ((4 + (b) * 2 + (h)) * HTB)
#define PG8_STAGE(bufoff, gbase, voff) do { _Pragma("unroll") for (int _i = 0; _i < 2; ++_i) \
        __builtin_amdgcn_global_load_lds((const unsigned*)((const char*)(gbase) + (voff)[_i]), (PG8_LAS unsigned*)(lds + (bufoff) + ldsw + _i * 8192), 16, 0, 0); } while (0)
#define PG8_LDA(dst, b, h) do { _Pragma("unroll") for (int m = 0; m < 4; ++m) _Pragma("unroll") for (int k = 0; k < 2; ++k) dst[m][k] = *(const PG8_LAS bf16x8*)(lds + PG8_SA(b, h) + aoff + m * 2048 + k * 1024); } while (0)
#define PG8_LDB(dst, b, h) do { _Pragma("unroll") for (int n = 0; n < 2; ++n) _Pragma("unroll") for (int k = 0; k < 2; ++k) dst[n][k] = *(const PG8_LAS bf16x8*)(lds + PG8_SB(b, h) + boff + n * 2048 + k * 1024); } while (0)
#define PG8_MMA(ai, bj, At, Bt) do { __builtin_amdgcn_s_setprio(1); _Pragma("unroll") for (int m = 0; m < 4; ++m) _Pragma("unroll") for (int n = 0; n < 2; ++n) _Pragma("unroll") for (int k = 0; k < 2; ++k) \
        acc[ai][bj][m][n] = __builtin_amdgcn_mfma_f32_16x16x32_bf16(Bt[n][k], At[m][k], acc[ai][bj][m][n], 0, 0, 0); __builtin_amdgcn_s_setprio(0); } while (0)
#define PG8_WAIT_V(n) asm volatile("s_waitcnt vmcnt(" #n ")" ::: "memory")
#define PG8_WAIT_L(n) asm volatile("s_waitcnt lgkmcnt(" #n ")" ::: "memory")
#define PG8_BAR __builtin_amdgcn_s_barrier()
#define PG8_SCHED __builtin_amdgcn_sched_barrier(0)
    Unit cur, nxt; int ui = 0;
    if (!S.next(0, cur)) return;
    f32x4 acc[2][2][4][2];
#pragma unroll
    for (int a = 0; a < 2; ++a)
#pragma unroll
        for (int b = 0; b < 2; ++b)
#pragma unroll
            for (int m = 0; m < 4; ++m)
#pragma unroll
                for (int n = 0; n < 2; ++n) acc[a][b][m][n] = (f32x4){0.f, 0.f, 0.f, 0.f};
    bf16x8 At[4][2], B0[2][2], B1[2][2];
    const char* cA = (const char*)g.A + (size_t)cur.pm * tstep + (size_t)cur.ks * sstep; const char* cB = (const char*)g.Bt + (size_t)cur.pn * tstep + (size_t)cur.ks * sstep;
    S.a_ready(cur);
    PG8_STAGE(PG8_SB(0, 0), cB, voffB); PG8_STAGE(PG8_SA(0, 0), cA, voffA); PG8_STAGE(PG8_SB(0, 1), cB + hstep, voffB); PG8_STAGE(PG8_SA(0, 1), cA + hstep, voffA);
    if (wr == 1) PG8_BAR;
    PG8_WAIT_V(4); PG8_BAR;
    PG8_STAGE(PG8_SB(1, 0), cB + kstep, voffB); PG8_STAGE(PG8_SA(1, 0), cA + kstep, voffA); PG8_STAGE(PG8_SB(1, 1), cB + hstep + kstep, voffB);
    PG8_WAIT_V(6); PG8_BAR;
    PG8_STAMP();
    for (;;) {
        const bool has_next = S.next(ui + 1, nxt);
        const char* nA = has_next ? (const char*)g.A + (size_t)nxt.pm * tstep + (size_t)nxt.ks * sstep : cA; const char* nB = has_next ? (const char*)g.Bt + (size_t)nxt.pn * tstep + (size_t)nxt.ks * sstep : cB;
        for (int t = 0; t < nt; t += 2) {
            const bool last = (t == nt - 2);
            const char* a1 = cA + (size_t)(t + 1) * kstep;
            const char* a2 = last ? nA : cA + (size_t)(t + 2) * kstep; const char* b2 = last ? nB : cB + (size_t)(t + 2) * kstep;
            const char* a3 = a2 + kstep; const char* b3 = b2 + kstep;
            if (last && has_next) S.a_ready(nxt);
            PG8_LDB(B0, 0, 0); PG8_SCHED; PG8_LDA(At, 0, 0); PG8_STAGE(PG8_SA(1, 1), a1 + hstep, voffA);
            PG8_WAIT_L(8); PG8_BAR; PG8_WAIT_L(0); PG8_MMA(0, 0, At, B0); PG8_BAR; PG8_SCHED;
            PG8_LDB(B1, 0, 1); PG8_STAGE(PG8_SB(0, 0), b2, voffB);
            PG8_BAR; PG8_WAIT_L(0); PG8_MMA(0, 1, At, B1); PG8_BAR;
            PG8_LDA(At, 0, 1); PG8_STAGE(PG8_SA(0, 0), a2, voffA);
            PG8_BAR; PG8_WAIT_L(0); PG8_MMA(1, 0, At, B0); PG8_BAR; PG8_SCHED;
            PG8_STAGE(PG8_SB(0, 1), b2 + hstep, voffB);
            PG8_WAIT_V(6); PG8_BAR; PG8_MMA(1, 1, At, B1); PG8_BAR;
            PG8_LDB(B0, 1, 0); PG8_SCHED; PG8_LDA(At, 1, 0); PG8_STAGE(PG8_SA(0, 1), a2 + hstep, voffA);
            PG8_WAIT_L(8); PG8_BAR; PG8_WAIT_L(0); PG8_MMA(0, 0, At, B0); PG8_BAR; PG8_SCHED;
            PG8_LDB(B1, 1, 1); PG8_STAGE(PG8_SB(1, 0), b3, voffB);
            PG8_BAR; PG8_WAIT_L(0); PG8_MMA(0, 1, At, B1); PG8_BAR;
            PG8_LDA(At, 1, 1); PG8_STAGE(PG8_SA(1, 0), a3, voffA);
            PG8_BAR; PG8_WAIT_L(0); PG8_MMA(1, 0, At, B0); PG8_BAR; PG8_SCHED;
            PG8_STAGE(PG8_SB(1, 1), b3 + hstep, voffB);
            PG8_WAIT_V(6); PG8_BAR; PG8_MMA(1, 1, At, B1); PG8_BAR;
        }
        PG8_STAMP();
        if constexpr (!Epi::AFTER_DRAIN) { E(acc, cur, wr, wc, fr, fq); S.done(cur); }
        PG8_STAMP();
        if (!has_next) break;
#pragma unroll
        for (int a = 0; a < 2; ++a)
#pragma unroll
            for (int b = 0; b < 2; ++b)
#pragma unroll
                for (int m = 0; m < 4; ++m)
#pragma unroll
                    for (int n = 0; n < 2; ++n) acc[a][b][m][n] = (f32x4){0.f, 0.f, 0.f, 0.f};
        cur = nxt; cA = nA; cB = nB; ++ui;
    }
    PG8_WAIT_V(0);
    if (wr == 0) PG8_BAR;
    PG8_BAR;
    if constexpr (Epi::AFTER_DRAIN) { E.fused(acc, cur, wr, wc, fr, fq, lds, wid, lane); S.done(cur); }
    PG8_STAMP();
    if (STAMP && wid == 0) { stamps[lane] = lane < nts ? (((unsigned long long)(unsigned)ts_hi << 32) | (unsigned)ts_lo) : 0ull;
        if (lane == 62) stamps[62] = rt_entry; if (lane == 63) stamps[63] = (unsigned long long)wall_clock64(); }
#undef PG8_STAMP
#undef PG8_SA
#undef PG8_SB
#undef PG8_STAGE
#undef PG8_LDA
#undef PG8_LDB
#undef PG8_MMA
#undef PG8_WAIT_V
#undef PG8_WAIT_L
#undef PG8_BAR
#undef PG8_SCHED
}
}

using pg8::bf16_t; using pg8::bf16x8; using pg8::f32x4; using pg8::u32x4;
#define DI __device__ __forceinline__
typedef unsigned u32x2 __attribute__((ext_vector_type(2)));
constexpr int D = 2048, NBATCH = 4, SEQ = 4096, CTXL = 256;
constexpr int TL = NBATCH * SEQ, TC = NBATCH * CTXL, T = TL + TC;
constexpr int NIN = 7232, NINP = 7424, NU = 7168, DFF = 5632, NUP = 2 * DFF, NMOD = 12288;
constexpr float EPS = 1e-5f, ALPHA = 1.41421356237309515f;
constexpr int U_MQ = 0, U_MK = 512, U_MV = 1024, U_MO = 1536, U_SZ = 2048, U_XBC = 2560, U_RQ = 3584, U_RK = 4096, U_RV = 4608, U_RG = 5120,
              U_GQ = 5632, U_GK = 5888, U_GV = 6144, U_GG = 6656;
constexpr size_t al256(size_t x) { return (x + 255) & ~(size_t)255; }
constexpr size_t WS_WIN = 0;
constexpr size_t WS_WOUT = WS_WIN + al256((size_t)NINP * D * 2);
constexpr size_t WS_WUP = WS_WOUT + al256((size_t)D * D * 2);
constexpr size_t WS_WDN = WS_WUP + al256((size_t)NUP * D * 2);
constexpr size_t WS_MOD = WS_WDN + al256((size_t)D * DFF * 2);
constexpr size_t WS_XC = WS_MOD + al256((size_t)2 * 5 * NMOD * 4);
constexpr size_t WS_H = WS_XC + al256((size_t)TC * D * 4);
constexpr size_t WS_U = WS_H + al256((size_t)T * D * 2);
constexpr size_t WS_GATES = WS_U + al256((size_t)T * NU * 2);
constexpr size_t WS_XBC = WS_GATES + al256((size_t)T * 64 * 4);
constexpr size_t WS_GL = WS_XBC + al256((size_t)T * 1024 * 2);
constexpr size_t WS_LA = WS_GL + al256((size_t)2 * 16 * T * 8);
constexpr size_t WS_YS = WS_LA + al256((size_t)2 * T * 256 * 4);
constexpr size_t WS_DEN = WS_YS + al256((size_t)2 * T * D * 2);
constexpr size_t WS_QG = WS_DEN + al256((size_t)2 * T * 4 * 4);
constexpr size_t WS_KG = WS_QG + al256((size_t)2 * T * 256 * 2);
constexpr size_t WS_EE = WS_KG + al256((size_t)2 * T * 256 * 2);
constexpr size_t WS_BAR = WS_EE + al256((size_t)2 * (T / 64) * 256 * 4);
constexpr size_t WS_YC = WS_BAR + 256;
constexpr size_t WS_END = WS_YC;
constexpr int LDS_BYTES = 131072;
constexpr int NPHASE = 20;
#ifndef SCAN_MFMA
#define SCAN_MFMA 15
#endif

struct KP { const float* in[26]; float* out; unsigned char* ws; int ph_lo, ph_hi; };
enum { I_X = 0, I_C, I_CTX, I_CCTX, I_ADAW, I_ADAB, I_WIN, I_MIGB, I_MFGB, I_MNORM, I_SCONVW, I_SCONVB, I_SDTB, I_SALOG, I_SD, I_SNORM, I_RDECAY, I_RNORM,
       I_GGW, I_GGB, I_GNORM, I_WOUT, I_POSTG, I_POSTB, I_WUP, I_WDN };

DI int obid() { int b = blockIdx.x; asm volatile("" : "+s"(b)); return b; }
DI int ogdim() { int g = gridDim.x; asm volatile("" : "+s"(g)); return g; }
DI int otid() { int t = threadIdx.x; asm volatile("" : "+v"(t)); return t; }
DI float bf2f(unsigned short h) { return __uint_as_float(((unsigned)h) << 16); }
DI unsigned short f2bf(float f) { return (unsigned short)pg8::cvt_pk_bf16(f, f); }
DI unsigned pk2(float lo, float hi) { return pg8::cvt_pk_bf16(lo, hi); }
DI float silu_f(float x) { return x * __builtin_amdgcn_rcpf(1.f + __expf(-x)); }
DI float sigmoid_f(float x) { return __builtin_amdgcn_rcpf(1.f + __expf(-x)); }
DI float softplus_f(float x) { return fmaxf(x, 0.f) + __logf(1.f + __expf(-fabsf(x))); }
DI float logsigmoid_f(float x) { return fminf(x, 0.f) - __logf(1.f + __expf(-fabsf(x))); }
DI float shx(float v, int m, int lane) { return __uint_as_float(__builtin_amdgcn_ds_bpermute((lane ^ m) << 2, __float_as_uint(v))); }
DI float wave_sum(float v, int lane) {
#pragma unroll
    for (int m = 32; m >= 1; m >>= 1) v += shx(v, m, lane);
    return v;
}
DI float* xrow_ptr(const KP& p, int row) { return row < TL ? p.out + (size_t)row * D : (float*)(p.ws + WS_XC) + (size_t)(row - TL) * D; }
DI const float* xin_ptr(const KP& p, int row) { return row < TL ? p.in[I_X] + (size_t)row * D : p.in[I_CTX] + (size_t)(row - TL) * D; }
DI int modidx(int row) { return row < TL ? (row >> 12) : 4; }
DI int scan_row(int b, int d, int s) { if (s < CTXL) { const int t = d ? CTXL - 1 - s : s; return TL + b * CTXL + t; } int t = s - CTXL; t = d ? SEQ - 1 - t : t; return b * SEQ + t; }

template <int KIND> DI int srccol(int n) {
    if (KIND == 0) {
        if (n < 2048) return n;
        if (n < 3584) return n + 16;
        if (n < 7168) return n + 32;
        if (n < 7184) return 2048 + (n - 7168);
        if (n < 7200) return 3600 + (n - 7184);
        if (n < 7232) return n;
        return -1;
    }
    if (KIND == 2) { const int pn = n >> 8, bj = (n >> 7) & 1, cl = n & 127; return bj * DFF + pn * 128 + cl; }
    return n;
}
constexpr int CT_IN = (NINP / 128) * (D / 64), CT_OUT = (D / 128) * (D / 64), CT_UP = (NUP / 128) * (D / 64), CT_DN = (D / 128) * (DFF / 64);
struct ConvTile { const float* W; bf16_t* dst; int Nsrc, Kd, n0, k0, kind; };
DI ConvTile conv_decode(const KP& p, int l, int t  ) {
    ConvTile c;
    if (t < CT_IN) { c.kind = 0; c.W = p.in[I_WIN] + (size_t)l * D * NIN; c.Nsrc = NIN; c.dst = (bf16_t*)(p.ws + WS_WIN); c.Kd = D; c.n0 = (t / (D / 64)) * 128; c.k0 = (t % (D / 64)) * 64; return c; }
    t -= CT_IN;
    if (t < CT_OUT) { c.kind = 1; c.W = p.in[I_WOUT] + (size_t)l * D * D; c.Nsrc = D; c.dst = (bf16_t*)(p.ws + WS_WOUT); c.Kd = D; c.n0 = (t / (D / 64)) * 128; c.k0 = (t % (D / 64)) * 64; return c; }
    t -= CT_OUT;
    if (t < CT_UP) { c.kind = 2; c.W = p.in[I_WUP] + (size_t)l * D * NUP; c.Nsrc = NUP; c.dst = (bf16_t*)(p.ws + WS_WUP); c.Kd = D; c.n0 = (t / (D / 64)) * 128; c.k0 = (t % (D / 64)) * 64; return c; }
    t -= CT_UP;
    c.kind = 3; c.W = p.in[I_WDN] + (size_t)l * DFF * D; c.Nsrc = D; c.dst = (bf16_t*)(p.ws + WS_WDN); c.Kd = DFF; c.n0 = (t / (DFF / 64)) * 128; c.k0 = (t % (DFF / 64)) * 64; return c;
}
DI int conv_srccol(int kind, int n) { return kind == 0 ? srccol<0>(n) : kind == 2 ? srccol<2>(n) : n; }
DI void conv_load(const ConvTile& c, int tid, f32x4 (&v)[4]) {
    const int r = tid >> 5, c4 = (tid & 31) * 4;
    const int sc = conv_srccol(c.kind, c.n0 + c4);
#pragma unroll
    for (int i = 0; i < 4; ++i) { v[i] = (f32x4){0.f, 0.f, 0.f, 0.f}; if (sc >= 0) v[i] = *(const f32x4*)(c.W + (size_t)(c.k0 + r + 16 * i) * c.Nsrc + sc); }
}
__device__ void convert_weights(const KP& p, int l, int t_lo, int t_hi, int w, int nw, unsigned char* smem) {
    float* tile = (float*)smem;
    const int tid = otid();
    int t = t_lo + w;
    if (t >= t_hi) return;
    ConvTile c = conv_decode(p, l, t);
    f32x4 v[4]; conv_load(c, tid, v);
    for (;;) {
        const int tn = t + nw; const bool more = tn < t_hi;
        ConvTile cn = c; f32x4 vn[4];
        if (more) { cn = conv_decode(p, l, tn); conv_load(cn, tid, vn); }
        {
            const int r = tid >> 5, c4 = (tid & 31) * 4;
#pragma unroll
            for (int i = 0; i < 4; ++i) { float* q = tile + (r + 16 * i) * 129 + c4; q[0] = v[i][0]; q[1] = v[i][1]; q[2] = v[i][2]; q[3] = v[i][3]; }
        }
        __syncthreads();
        {
            const int n = tid >> 2, ks = (tid & 3) * 16;
            float f[16];
#pragma unroll
            for (int j = 0; j < 16; ++j) f[j] = tile[(ks + j) * 129 + n];
            u32x4 w0, w1;
            w0.x = pk2(f[0], f[1]); w0.y = pk2(f[2], f[3]); w0.z = pk2(f[4], f[5]); w0.w = pk2(f[6], f[7]);
            w1.x = pk2(f[8], f[9]); w1.y = pk2(f[10], f[11]); w1.z = pk2(f[12], f[13]); w1.w = pk2(f[14], f[15]);
            bf16_t* q = c.dst + (size_t)(c.n0 + n) * c.Kd + c.k0 + ks;
            *(u32x4*)q = w0; *(u32x4*)(q + 8) = w1;
        }
        __syncthreads();
        if (!more) break;
        t = tn; c = cn;
#pragma unroll
        for (int i = 0; i < 4; ++i) v[i] = vn[i];
    }
}

__device__ void phase_init(const KP& p, unsigned char* smem) {
    const int tid = otid(), bid = obid(), nb = ogdim();
    float* sil = (float*)smem;
    float* red = sil + 5 * 2048;
    for (int i = tid; i < 5 * 2048; i += 512) { const int r = i >> 11, k = i & 2047; const float v = r < 4 ? p.in[I_C][r * 2048 + k] : p.in[I_CCTX][k]; sil[i] = silu_f(v); }
    __syncthreads();
    float* mod = (float*)(p.ws + WS_MOD);
    for (int chunk = bid; chunk < 256; chunk += nb) {
        const int l = chunk >> 7, n0 = (chunk & 127) * 96;
        const float* W = p.in[I_ADAW] + (size_t)l * D * NMOD;
        const int kp = tid >> 5, cc = tid & 31;
        float acc[3][5];
#pragma unroll
        for (int j = 0; j < 3; ++j)
#pragma unroll
            for (int r = 0; r < 5; ++r) acc[j][r] = 0.f;
#pragma unroll 8
        for (int k = kp; k < D; k += 16) {
            const float* wr = W + (size_t)k * NMOD + n0 + cc;
            const float w0 = wr[0], w1 = wr[32], w2 = wr[64];
#pragma unroll
            for (int r = 0; r < 5; ++r) { const float s = sil[r * 2048 + k]; acc[0][r] += s * w0; acc[1][r] += s * w1; acc[2][r] += s * w2; }
        }
#pragma unroll
        for (int j = 0; j < 3; ++j)
#pragma unroll
            for (int r = 0; r < 5; ++r) red[(kp * 96 + j * 32 + cc) * 5 + r] = acc[j][r];
        __syncthreads();
        if (tid < 480) {
            const int col = tid / 5, r = tid % 5; float s = 0.f;
#pragma unroll
            for (int k2 = 0; k2 < 16; ++k2) s += red[(k2 * 96 + col) * 5 + r];
            mod[(size_t)(l * 5 + r) * NMOD + n0 + col] = s + p.in[I_ADAB][l * NMOD + n0 + col];
        }
        __syncthreads();
    }
    convert_weights(p, 0, 0, CT_IN, bid, nb, smem);
}

DI void ln_stats(const f32x4 (&v)[8], int lane, float& mean, float& rstd) {
    float s = 0.f;
#pragma unroll
    for (int i = 0; i < 8; ++i) s += (v[i][0] + v[i][1]) + (v[i][2] + v[i][3]);
    s = wave_sum(s, lane); mean = s * (1.f / D);
    float q = 0.f;
#pragma unroll
    for (int i = 0; i < 8; ++i) { const f32x4 dd = v[i] - mean; q += (dd[0] * dd[0] + dd[1] * dd[1]) + (dd[2] * dd[2] + dd[3] * dd[3]); }
    q = wave_sum(q, lane); rstd = rsqrtf(q * (1.f / D) + EPS);
}
template <bool FIRST, bool MOD, bool FROM_INPUT>
DI void row_load(const KP& p, int row, int lane, const float* ycf, int nsplit, f32x4 (&v)[8], f32x4 (&y)[8]) {
    const float* xi = FROM_INPUT ? xin_ptr(p, row) : xrow_ptr(p, row);
#pragma unroll
    for (int i = 0; i < 8; ++i) v[i] = ((const f32x4*)xi)[i * 64 + lane];
    if (FIRST) {
        if (ycf != nullptr && row >= TL) {
            const float* yr = ycf + (size_t)(row - TL) * D;
#pragma unroll
            for (int i = 0; i < 8; ++i) y[i] = ((const f32x4*)yr)[i * 64 + lane];
            for (int sp = 1; sp < nsplit; ++sp) {
                yr += (size_t)TC * D;
#pragma unroll
                for (int i = 0; i < 8; ++i) y[i] += ((const f32x4*)yr)[i * 64 + lane];
            }
        } else {
            const bf16_t* yr = (const bf16_t*)(p.ws + WS_YS) + (size_t)row * D;
#pragma unroll
            for (int i = 0; i < 8; ++i) { const u32x2 t = ((const u32x2*)yr)[i * 64 + lane];
                y[i][0] = __uint_as_float(t[0] << 16); y[i][1] = __uint_as_float(t[0] & 0xffff0000u); y[i][2] = __uint_as_float(t[1] << 16); y[i][3] = __uint_as_float(t[1] & 0xffff0000u); }
        }
    }
}
template <bool FIRST, bool MOD>
DI void row_compute(const KP& p, int row, int lane, f32x4 (&v)[8], const f32x4 (&y)[8], const float* pg, const float* pb, const float* modl, int shoff, int scoff) {
    float mean, rstd;
    if (FIRST) {
        float* xr = xrow_ptr(p, row);
#pragma unroll
        for (int i = 0; i < 8; ++i) v[i] = ALPHA * v[i] + y[i];
        ln_stats(v, lane, mean, rstd);
#pragma unroll
        for (int i = 0; i < 8; ++i) {
            const f32x4 g = ((const f32x4*)pg)[i * 64 + lane], b = ((const f32x4*)pb)[i * 64 + lane];
            v[i] = (v[i] - mean) * rstd * g + b;
            ((f32x4*)xr)[i * 64 + lane] = v[i];
        }
    }
    if (MOD) {
        ln_stats(v, lane, mean, rstd);
        const float* mb = modl + (size_t)modidx(row) * NMOD;
        bf16_t* H = (bf16_t*)(p.ws + WS_H);
#pragma unroll
        for (int i = 0; i < 8; ++i) {
            const f32x4 sh = ((const f32x4*)(mb + shoff))[i * 64 + lane], sc = ((const f32x4*)(mb + scoff))[i * 64 + lane];
            const f32x4 o = (v[i] - mean) * rstd * (1.f + sc) + sh;
            u32x2 w; w[0] = pg8::cvt_pk_bf16(o[0], o[1]); w[1] = pg8::cvt_pk_bf16(o[2], o[3]);
            ((u32x2*)(H + (size_t)row * D))[i * 64 + lane] = w;
        }
    }
}
template <bool FIRST, bool MOD, bool FROM_INPUT = false>
__device__ void phase_row(const KP& p, int Mrows, const float* pg, const float* pb, const float* modl  , int shoff, int scoff, const float* ycf = nullptr, int nsplit = 0) {
    const int tid = otid(); const int lane = tid & 63, wid = tid >> 6;
    const int stride = ogdim() * 8;
    for (int row = obid() * 8 + wid; row < Mrows; row += 2 * stride) {
        const int row1 = row + stride; const bool has1 = row1 < Mrows;
        f32x4 v0[8], v1[8], y0[8], y1[8];
        row_load<FIRST, MOD, FROM_INPUT>(p, row, lane, ycf, nsplit, v0, y0);
        if (has1) row_load<FIRST, MOD, FROM_INPUT>(p, row1, lane, ycf, nsplit, v1, y1);
        row_compute<FIRST, MOD>(p, row, lane, v0, y0, pg, pb, modl, shoff, scoff);
        if (has1) row_compute<FIRST, MOD>(p, row1, lane, v1, y1, pg, pb, modl, shoff, scoff);
    }
}

struct EpiAll {
    static constexpr bool PERM = true, AFTER_DRAIN = false;
    int kind; bf16_t* O; float* G; const float* gmod;
    DI void operator()(const f32x4 (&acc)[2][2][4][2], const pg8::Unit& u, int wr, int wc, int fr, int fq) const {
        const int row0 = u.pm * 256 + wr * 64 + fr;
        if (kind == 0) {
            if (u.pn < 28) {
                const int col0 = u.pn * 256 + wc * 32 + 8 * fq;
#pragma unroll
                for (int ai = 0; ai < 2; ++ai)
#pragma unroll
                    for (int m = 0; m < 4; ++m) {
                        bf16_t* rowp = O + (size_t)(row0 + ai * 128 + m * 16) * NU + col0;
#pragma unroll
                        for (int bj = 0; bj < 2; ++bj) {
                            const f32x4 v0 = acc[ai][bj][m][0], v1 = acc[ai][bj][m][1];
                            u32x4 w; w.x = pg8::cvt_pk_bf16(v0[0], v0[1]); w.y = pg8::cvt_pk_bf16(v0[2], v0[3]); w.z = pg8::cvt_pk_bf16(v1[0], v1[1]); w.w = pg8::cvt_pk_bf16(v1[2], v1[3]);
                            *(u32x4*)(rowp + bj * 128) = w;
                        }
                    }
            } else if (wc < 2) {
                const int col0 = wc * 32 + 8 * fq;
#pragma unroll
                for (int ai = 0; ai < 2; ++ai)
#pragma unroll
                    for (int m = 0; m < 4; ++m) {
                        float* rowp = G + (size_t)(row0 + ai * 128 + m * 16) * 64 + col0;
                        *(f32x4*)rowp = acc[ai][0][m][0]; *(f32x4*)(rowp + 4) = acc[ai][0][m][1];
                    }
            }
        } else if (kind == 1) {
            const int col0 = u.pn * 256 + wc * 32 + 8 * fq;
            const int mi = u.pm < 64 ? (u.pm >> 4) : 4;
            const float* gp = gmod + (size_t)mi * NMOD + col0;
            f32x4 gv[2][2];
#pragma unroll
            for (int bj = 0; bj < 2; ++bj)
#pragma unroll
                for (int n = 0; n < 2; ++n) gv[bj][n] = *(const f32x4*)(gp + bj * 128 + n * 4);
#pragma unroll
            for (int ai = 0; ai < 2; ++ai)
#pragma unroll
                for (int m = 0; m < 4; ++m) {
                    bf16_t* rowp = O + (size_t)(row0 + ai * 128 + m * 16) * D + col0;
#pragma unroll
                    for (int bj = 0; bj < 2; ++bj) {
                        const f32x4 v0 = gv[bj][0] * acc[ai][bj][m][0], v1 = gv[bj][1] * acc[ai][bj][m][1];
                        u32x4 w; w.x = pg8::cvt_pk_bf16(v0[0], v0[1]); w.y = pg8::cvt_pk_bf16(v0[2], v0[3]); w.z = pg8::cvt_pk_bf16(v1[0], v1[1]); w.w = pg8::cvt_pk_bf16(v1[2], v1[3]);
                        *(u32x4*)(rowp + bj * 128) = w;
                    }
                }
        } else if (kind == 3) {
            const int col0 = u.pn * 256 + wc * 32 + 8 * fq;
            const float* gp = gmod + (size_t)4 * NMOD + col0;
            f32x4 gv[2][2];
#pragma unroll
            for (int bj = 0; bj < 2; ++bj)
#pragma unroll
                for (int n = 0; n < 2; ++n) gv[bj][n] = *(const f32x4*)(gp + bj * 128 + n * 4);
            float* Pk = G + (size_t)u.ks * TC * D;
#pragma unroll
            for (int ai = 0; ai < 2; ++ai)
#pragma unroll
                for (int m = 0; m < 4; ++m) {
                    float* rowp = Pk + (size_t)(row0 + ai * 128 + m * 16) * D + col0;
#pragma unroll
                    for (int bj = 0; bj < 2; ++bj)
#pragma unroll
                        for (int n = 0; n < 2; ++n) *(f32x4*)(rowp + bj * 128 + n * 4) = gv[bj][n] * acc[ai][bj][m][n];
                }
        } else {
            const int col0 = u.pn * 128 + wc * 32 + 8 * fq;
#pragma unroll
            for (int ai = 0; ai < 2; ++ai)
#pragma unroll
                for (int m = 0; m < 4; ++m) {
                    bf16_t* rowp = O + (size_t)(row0 + ai * 128 + m * 16) * DFF + col0;
                    f32x4 v0, v1;
#pragma unroll
                    for (int j = 0; j < 4; ++j) { v0[j] = silu_f(acc[ai][0][m][0][j]) * acc[ai][1][m][0][j]; v1[j] = silu_f(acc[ai][0][m][1][j]) * acc[ai][1][m][1][j]; }
                    u32x4 w; w.x = pg8::cvt_pk_bf16(v0[0], v0[1]); w.y = pg8::cvt_pk_bf16(v0[2], v0[3]); w.z = pg8::cvt_pk_bf16(v1[0], v1[1]); w.w = pg8::cvt_pk_bf16(v1[2], v1[3]);
                    *(u32x4*)rowp = w;
                }
        }
    }
};
struct SplitOrder {
    int nsplit, G, c;
    __device__ bool next(int i, pg8::Unit& u) const {
        const int L = i * G + c; if (L >= 32 * nsplit) return false;
        const int tile = L / nsplit; u.ks = L % nsplit; u.pm = tile >> 3; u.pn = tile & 7; return true;
    }
    DI void a_ready(const pg8::Unit&) const {}
    DI void done(const pg8::Unit&) const {}
};
template <class Epi> DI void run_gemm(unsigned char* smem, const bf16_t* A, const bf16_t* Bt, int M, int N, int K, const Epi& E) {
    pg8::Gemm g; g.A = A; g.Bt = Bt; g.M = M; g.N = N; g.K = K; g.ld = K;
    pg8::StaticOrder S; S.init(M, N, ogdim(), obid());
    pg8::gemm_phase<Epi, pg8::StaticOrder, false>((PG8_LAS unsigned char*)smem, g, S, E, nullptr);
}

__device__ void phase_pre(const KP& p, int l, unsigned char* smem) {
    const int tid = otid();
    bf16_t* U = (bf16_t*)(p.ws + WS_U);
    const float* G = (const float*)(p.ws + WS_GATES);
    bf16_t* X = (bf16_t*)(p.ws + WS_XBC);
    float2* GL = (float2*)(p.ws + WS_GL);
    constexpr int NGLA = 2 * (T / 64), NR16 = T / 16;
    for (int it = obid(); it < NGLA + 2 * NR16; it += ogdim()) {
        if (it < NGLA) {
            const int blk = it >> 1, gd = it & 1, r0 = blk * 64;
            const int half = tid >> 8, gch = tid & 255;
            float* as = (float*)smem;
            float* tot = as + 64 * 16;
            __syncthreads();
            if (tid < 256) { const int t = tid >> 2, c4 = (tid & 3) * 4; *(f32x4*)(as + t * 16 + c4) = *(const f32x4*)(G + (size_t)(r0 + t) * 64 + 32 + gd * 16 + c4); }
            float gw[16];
#pragma unroll
            for (int r = 0; r < 16; ++r) gw[r] = p.in[I_GGW][((size_t)(l * 2 + gd) * 16 + r) * 256 + gch];
            const float gb = p.in[I_GGB][(l * 2 + gd) * 256 + gch];
            bf16_t* QG = (bf16_t*)(p.ws + WS_QG) + (size_t)gd * T * 256 + gch;
            bf16_t* KG = (bf16_t*)(p.ws + WS_KG) + (size_t)gd * T * 256 + gch;
            __syncthreads();
            float* las = tot + 256;
            float lsum = 0.f;
#pragma unroll 2
            for (int j = 0; j < 32; ++j) {
                const int sp = half * 32 + j, t = gd ? 63 - sp : sp;
                const float* ar = as + t * 16;
                float x = gb;
#pragma unroll
                for (int r4 = 0; r4 < 4; ++r4) { const f32x4 a4 = *(const f32x4*)(ar + r4 * 4); x += a4[0] * gw[r4 * 4] + a4[1] * gw[r4 * 4 + 1] + a4[2] * gw[r4 * 4 + 2] + a4[3] * gw[r4 * 4 + 3]; }
                const float lv = logsigmoid_f(x) * (1.f / 16.f); las[j * 512 + tid] = lv; lsum += lv;
            }
            if (half == 0) tot[gch] = lsum;
            __syncthreads();
            float bsum = half ? tot[gch] : 0.f;
            if (half) ((float*)(p.ws + WS_EE))[((size_t)gd * (T / 64) + blk) * 256 + gch] = __expf(bsum + lsum);
            for (int tb = 0; tb < 32; tb += 8) {
                unsigned short qv[8], kv[8];
#pragma unroll
                for (int j = 0; j < 8; ++j) { const int sp = half * 32 + tb + j, t = gd ? 63 - sp : sp; qv[j] = U[(size_t)(r0 + t) * NU + U_GQ + gch]; kv[j] = U[(size_t)(r0 + t) * NU + U_GK + gch]; }
#pragma unroll
                for (int j = 0; j < 8; ++j) {
                    const int sp = half * 32 + tb + j, t = gd ? 63 - sp : sp;
                    bsum += las[(tb + j) * 512 + tid];
                    QG[(size_t)(r0 + t) * 256] = f2bf(bf2f(qv[j]) * __expf(bsum) * 0.125f);
                    KG[(size_t)(r0 + t) * 256] = f2bf(bf2f(kv[j]) * __expf(-bsum));
                }
            }
        } else if (it < NGLA + NR16) {
            const int r0 = (it - NGLA) * 16, c0 = 2 * tid;
            int t0, L; if (r0 < TL) { t0 = r0 & (SEQ - 1); L = SEQ; } else { t0 = (r0 - TL) & (CTXL - 1); L = CTXL; }
            const float* cw = p.in[I_SCONVW] + (size_t)l * 3 * 1024; const float* cb = p.in[I_SCONVB] + (size_t)l * 1024;
            const float2 w0 = *(const float2*)(cw + c0), w1 = *(const float2*)(cw + 1024 + c0), w2 = *(const float2*)(cw + 2048 + c0), bb = *(const float2*)(cb + c0);
            const bf16_t* up = U + (size_t)r0 * NU + U_XBC + c0;
            unsigned x[18];
            x[0] = t0 > 0 ? *(const unsigned*)(up - NU) : 0u;
#pragma unroll
            for (int j = 0; j < 16; ++j) x[j + 1] = *(const unsigned*)(up + (size_t)j * NU);
            x[17] = (t0 + 16 < L) ? *(const unsigned*)(up + (size_t)16 * NU) : 0u;
#pragma unroll
            for (int j = 0; j < 16; ++j) {
                const float o0 = bb.x + w0.x * bf2f(x[j] & 0xffff) + w1.x * bf2f(x[j + 1] & 0xffff) + w2.x * bf2f(x[j + 2] & 0xffff);
                const float o1 = bb.y + w0.y * bf2f(x[j] >> 16) + w1.y * bf2f(x[j + 1] >> 16) + w2.y * bf2f(x[j + 2] >> 16);
                *(unsigned*)(X + (size_t)(r0 + j) * 1024 + c0) = pk2(silu_f(o0), silu_f(o1));
            }
        } else {
            const int r0 = (it - NGLA - NR16) * 16;
            {
                const int rsel = tid >> 8, pp = tid & 255, isk = pp >> 7, idx = (2 * pp) & 255, rh = idx >> 6, rhalf = (idx >> 5) & 1, ri = idx & 31;
                const int rcol = (isk ? U_RK : U_RQ) + rh * 128 + rhalf * 64 + ri;
                const float rscale = isk ? 0.08838834764831845f : 1.f;
                const float f0 = __builtin_amdgcn_exp2f(-(float)ri * (13.287712379549449f / 32.f)), f1 = __builtin_amdgcn_exp2f(-(float)(ri + 1) * (13.287712379549449f / 32.f));
                unsigned a[8], b[8];
#pragma unroll
                for (int j = 0; j < 8; ++j) { const bf16_t* q = U + (size_t)(r0 + rsel * 8 + j) * NU + rcol; a[j] = *(const unsigned*)q; b[j] = *(const unsigned*)(q + 32); }
#pragma unroll
                for (int j = 0; j < 8; ++j) {
                    const int row = r0 + rsel * 8 + j;
                    float x1a = bf2f(a[j] & 0xffff), x1b = bf2f(a[j] >> 16), x2a = bf2f(b[j] & 0xffff), x2b = bf2f(b[j] >> 16);
                    if (row < TL) {
                        const int t = row & (SEQ - 1);
                        const float pos = (float)(rhalf ? (t & 63) : (t >> 6));
                        float ra = pos * f0 * 0.15915494309189535f, rb = pos * f1 * 0.15915494309189535f; ra -= floorf(ra); rb -= floorf(rb);
                        const float sa = __builtin_amdgcn_sinf(ra), ca = __builtin_amdgcn_cosf(ra), sb = __builtin_amdgcn_sinf(rb), cbv = __builtin_amdgcn_cosf(rb);
                        const float y1a = x1a * ca - x2a * sa, y2a = x1a * sa + x2a * ca, y1b = x1b * cbv - x2b * sb, y2b = x1b * sb + x2b * cbv;
                        x1a = y1a; x2a = y2a; x1b = y1b; x2b = y2b;
                    }
                    bf16_t* q = U + (size_t)row * NU + rcol;
                    *(unsigned*)q = pk2(x1a * rscale, x1b * rscale); *(unsigned*)(q + 32) = pk2(x2a * rscale, x2b * rscale);
                }
            }
            {
                const int row = r0 + (tid >> 5), ds = tid & 31, d = ds >> 4, slot = ds & 15;
                const float* gr = G + (size_t)row * 64;
                float loga, logw;
                if (slot < 4) {
                    const int h = slot;
                    logw = gr[d * 4 + h] + p.in[I_MIGB][(l * 2 + d) * 4 + h];
                    loga = logsigmoid_f(gr[8 + d * 4 + h] + p.in[I_MFGB][(l * 2 + d) * 4 + h]);
                } else if (slot < 12) {
                    const int h = slot - 4;
                    const float dt = softplus_f(gr[16 + d * 8 + h] + p.in[I_SDTB][(l * 2 + d) * 8 + h]);
                    loga = -dt * __expf(p.in[I_SALOG][(l * 2 + d) * 8 + h]); logw = __logf(dt);
                } else {
                    const int h = slot - 12;
                    loga = -__expf(p.in[I_RDECAY][(l * 2 + d) * 4 + h]); logw = 0.f;
                }
                GL[(size_t)(d * 16 + slot) * T + row] = make_float2(loga, logw);
            }
        }
    }
}

typedef short s16x4 __attribute__((ext_vector_type(4)));
#define LDSP(T_, ptr) ((__attribute__((address_space(3))) T_*)(ptr))
DI bf16x8 tr_frag(const bf16_t* lo_addr, int row_stride  ) {
    const s16x4 lo = __builtin_amdgcn_ds_read_tr16_b64_v4i16(LDSP(s16x4, lo_addr));
    const s16x4 hi = __builtin_amdgcn_ds_read_tr16_b64_v4i16(LDSP(s16x4, lo_addr + 4 * row_stride));
    return __builtin_shufflevector(lo, hi, 0, 1, 2, 3, 4, 5, 6, 7);
}
#define MFMA16(a, b, c) __builtin_amdgcn_mfma_f32_16x16x32_bf16((a), (b), (c), 0, 0, 0)
template <int MIX, bool DEN> struct ScanCfg {
    static constexpr int DK = MIX == 3 ? 64 : 128, NH = MIX == 1 ? 2 : 1, NT = DK / 16, KS2 = DK / 32;
    static constexpr int NVC = DEN ? 144 : 128;
    static constexpr int QST = DK + 8, VST = NVC + 8, PST = 72;
    static constexpr int SZQ = 64 * QST * 2, SZV = 64 * VST * 2, SZVEC = NH * 320 * 4;
    static constexpr int OFF_K = SZQ, OFF_V = 2 * SZQ, OFF_VEC = 2 * SZQ + SZV, BUF = 2 * SZQ + SZV + SZVEC;
    static constexpr int OFF_PW = 2 * BUF, SZP = NH * 64 * PST * 2;
    static_assert(OFF_PW + SZP <= LDS_BYTES, "scan LDS layout");
};
DI int chunk_base(int b, int d, int c) { if (c < 4) return TL + b * CTXL + (d ? 3 - c : c) * 64; const int cc = c - 4; return b * SEQ + (d ? 63 - cc : cc) * 64; }

template <int MIX, bool DEN>
__device__ void scan_item(const KP& p, int b, int d, int grp, unsigned char* smem) {
    using C = ScanCfg<MIX, DEN>;
    constexpr int DK = C::DK, NH = C::NH, NT = C::NT, KS2 = C::KS2, QST = C::QST, VST = C::VST, PST = C::PST;
    constexpr int QPR = DK / 8;
    constexpr int NQP = (64 * QPR) / 512;
    const int tid = otid(), lane = tid & 63, wid = __builtin_amdgcn_readfirstlane(tid >> 6);
    const int l15 = lane & 15, g4 = lane >> 4, tq = l15 >> 2, tp = l15 & 3;
    const bf16_t* U = (const bf16_t*)(p.ws + WS_U); const bf16_t* X = (const bf16_t*)(p.ws + WS_XBC);
    const bf16_t *qsrc, *ksrc, *vsrc; int qld, vld;
    if (MIX == 0) { qsrc = U + U_MQ + grp * 128; ksrc = U + U_MK + grp * 128; vsrc = U + U_MV + grp * 128; qld = NU; vld = NU; }
    if (MIX == 1) { qsrc = X + 768 + (grp >> 1) * 128; ksrc = X + 512 + (grp >> 1) * 128; vsrc = X + grp * 128; qld = 1024; vld = 1024; }
    if (MIX == 2) { qsrc = U + U_RQ + grp * 128; ksrc = U + U_RK + grp * 128; vsrc = U + U_RV + grp * 128; qld = NU; vld = NU; }
    if (MIX == 3) { qsrc = (const bf16_t*)(p.ws + WS_QG) + (size_t)d * T * 256 + grp * 64; ksrc = (const bf16_t*)(p.ws + WS_KG) + (size_t)d * T * 256 + grp * 64; vsrc = U + U_GV + grp * 128; qld = 256; vld = NU; }
    const int slot0 = MIX == 0 ? grp : MIX == 1 ? 4 + 2 * grp : 12 + grp;
    const float2* GL = (const float2*)(p.ws + WS_GL) + (size_t)(d * 16 + slot0 + (wid < NH ? wid : 0)) * T;
    const float* EE = (const float*)(p.ws + WS_EE) + (size_t)d * (T / 64) * 256 + grp * 64;
    bf16_t* YS = (bf16_t*)(p.ws + WS_YS) + (size_t)d * T * D + MIX * 512 + grp * 128;
    float* DENP = (float*)(p.ws + WS_DEN) + (size_t)d * T * 4 + grp;
    constexpr float LOGQS = MIX == 0 ? -2.4260151319598084f : 0.f;

    __syncthreads();
    for (int i = tid; i < C::SZP / 4; i += 512) ((unsigned*)(smem + C::OFF_PW))[i] = 0u;
    if (DEN) {
        for (int i = tid; i < 2 * 64 * 16; i += 512) { const int bf = i >> 10, r = (i >> 4) & 63, cc = i & 15; ((bf16_t*)(smem + bf * C::BUF + C::OFF_V))[r * VST + 128 + cc] = cc == 0 ? (bf16_t)0x3F80 : (bf16_t)0; }
    }
    f32x4 S0[NT];
#pragma unroll
    for (int t = 0; t < NT; ++t) S0[t] = (f32x4){0.f, 0.f, 0.f, 0.f};

    u32x4 rqA[NQP], rkA[NQP], rvA[2], rqB[NQP], rkB[NQP], rvB[2]; float gxA = 0.f, gyA = 0.f, eeA = 0.f, gxB = 0.f, gyB = 0.f, eeB = 0.f;
#define ISSUE_ALL(c_, S_) do { \
        const int base_ = chunk_base(b, d, (c_)); \
_Pragma("unroll") \
        for (int i = 0; i < NQP; ++i) { const int pc = tid + 512 * i, r = pc / QPR, c8 = pc % QPR; const size_t row = (size_t)(base_ + (d ? 63 - r : r)); \
            rq##S_[i] = *(const u32x4*)(qsrc + row * qld + c8 * 8); rk##S_[i] = *(const u32x4*)(ksrc + row * qld + c8 * 8); } \
_Pragma("unroll") \
        for (int i = 0; i < 2; ++i) { const int pc = tid + 512 * i, r = pc >> 4, c8 = pc & 15; const size_t row = (size_t)(base_ + (d ? 63 - r : r)); \
            rv##S_[i] = *(const u32x4*)(vsrc + row * vld + c8 * 8); } \
        if (MIX != 3) { if (wid < NH) { const float2 g_ = GL[base_ + (d ? 63 - lane : lane)]; gx##S_ = g_.x; gy##S_ = g_.y; } } \
        else if (wid == 0) ee##S_ = EE[(size_t)(base_ >> 6) * 256 + lane]; \
    } while (0)
#define STAGE_ALL(bufi, S_) do { \
        unsigned char* B_ = smem + (bufi) * C::BUF; \
_Pragma("unroll") \
        for (int i = 0; i < NQP; ++i) { const int pc = tid + 512 * i, r = pc / QPR, c8 = pc % QPR; \
            *(u32x4*)((bf16_t*)B_ + r * QST + c8 * 8) = rq##S_[i]; *(u32x4*)((bf16_t*)(B_ + C::OFF_K) + r * QST + c8 * 8) = rk##S_[i]; } \
_Pragma("unroll") \
        for (int i = 0; i < 2; ++i) { const int pc = tid + 512 * i, r = pc >> 4, c8 = pc & 15; *(u32x4*)((bf16_t*)(B_ + C::OFF_V) + r * VST + c8 * 8) = rv##S_[i]; } \
        float* vec_ = (float*)(B_ + C::OFF_VEC); \
        if (MIX != 3) { \
            if (wid < NH) { \
                float bc = gx##S_; \
                bc += __uint_as_float(__builtin_amdgcn_update_dpp(0, __float_as_uint(bc), 0x111, 0xf, 0xf, false)); \
                bc += __uint_as_float(__builtin_amdgcn_update_dpp(0, __float_as_uint(bc), 0x112, 0xf, 0xf, false)); \
                bc += __uint_as_float(__builtin_amdgcn_update_dpp(0, __float_as_uint(bc), 0x114, 0xf, 0xf, false)); \
                bc += __uint_as_float(__builtin_amdgcn_update_dpp(0, __float_as_uint(bc), 0x118, 0xf, 0xf, false)); \
                bc += __uint_as_float(__builtin_amdgcn_update_dpp(0, __float_as_uint(bc), 0x142, 0xa, 0xf, false)); \
                bc += __uint_as_float(__builtin_amdgcn_update_dpp(0, __float_as_uint(bc), 0x143, 0xc, 0xf, false)); \
                const float bend = __uint_as_float(__builtin_amdgcn_readlane(__float_as_uint(bc), 63)); \
                const float rt = bc + LOGQS, ct = gy##S_ - bc; \
                float* v = vec_ + wid * 320; \
                v[lane] = rt; v[64 + lane] = ct; v[128 + lane] = __expf(rt); v[192 + lane] = __expf(bend + ct); v[256 + lane] = __expf(bend); \
            } \
        } else if (wid == 0) vec_[256 + lane] = ee##S_; \
    } while (0)

    ISSUE_ALL(0, A);
    STAGE_ALL(0, A);
    ISSUE_ALL(1, B);
    __syncthreads();

    for (int c2 = 0; c2 < (CTXL + SEQ) / 64; c2 += 2) {
#pragma unroll
    for (int par = 0; par < 2; ++par) {
        const int c = c2 + par;
        const int cur = par;
        const int base = chunk_base(b, d, c);
        unsigned char* B = smem + cur * C::BUF;
        const bf16_t* Qs = (const bf16_t*)B; const bf16_t* Ks = (const bf16_t*)(B + C::OFF_K); const bf16_t* Vs = (const bf16_t*)(B + C::OFF_V);
        const float* vec = (const float*)(B + C::OFF_VEC);
        bf16_t* Pw = (bf16_t*)(smem + C::OFF_PW);
        bf16_t* ysb = YS + (size_t)base * D;
        if (c + 2 < (CTXL + SEQ) / 64) { if (par == 0) ISSUE_ALL(c + 2, A); else ISSUE_ALL(c + 2, B); }
#pragma unroll
        for (int rep = 0; rep < 2; ++rep) {
            const int tl = rep == 0 ? wid : wid + 2;
            if (rep == 1 && wid < 6) break;
            const int it = tl >= 6 ? 3 : tl >= 3 ? 2 : tl >= 1 ? 1 : 0, jt = tl - ((it * (it + 1)) >> 1);
            f32x4 acc = (f32x4){0.f, 0.f, 0.f, 0.f};
            bf16x8 pa[KS2], pb[KS2];
#pragma unroll
            for (int ks = 0; ks < KS2; ++ks) {
                pa[ks] = *LDSP(const bf16x8, Ks + (jt * 16 + l15) * QST + ks * 32 + g4 * 8);
                pb[ks] = *LDSP(const bf16x8, Qs + (it * 16 + l15) * QST + ks * 32 + g4 * 8);
            }
            __builtin_amdgcn_sched_barrier(0);
#pragma unroll
            for (int ks = 0; ks < KS2; ++ks) acc = MFMA16(pa[ks], pb[ks], acc);
            const int i = it * 16 + l15, j0 = jt * 16 + g4 * 4;
#pragma unroll
            for (int h = 0; h < NH; ++h) {
                float w[4];
                if (MIX != 3) {
                    const float rt = vec[h * 320 + i]; const f32x4 ct = *LDSP(const f32x4, vec + h * 320 + 64 + j0);
#pragma unroll
                    for (int r = 0; r < 4; ++r) w[r] = (j0 + r <= i) ? __expf(rt + ct[r]) : 0.f;
                } else {
#pragma unroll
                    for (int r = 0; r < 4; ++r) w[r] = (j0 + r <= i) ? 1.f : 0.f;
                }
                u32x2 o; o.x = pg8::cvt_pk_bf16(acc[0] * w[0], acc[1] * w[1]); o.y = pg8::cvt_pk_bf16(acc[2] * w[2], acc[3] * w[3]);
                *LDSP(u32x2, Pw + (h * 64 + i) * PST + j0) = o;
            }
        }
        __syncthreads();
#define SB_() __builtin_amdgcn_sched_barrier(0)
#define QFRAG(dst, it_, ks_) do { \
            const s16x4 a0_ = *LDSP(const s16x4, Qs + ((it_) * 16 + l15) * QST + (ks_) * 32 + g4 * 4); \
            const s16x4 a1_ = *LDSP(const s16x4, Qs + ((it_) * 16 + l15) * QST + (ks_) * 32 + 16 + g4 * 4); \
            dst = __builtin_shufflevector(a0_, a1_, 0, 1, 2, 3, 4, 5, 6, 7); } while (0)
#define SPACK(dst, S, ks_) do { u32x4 sb_; sb_.x = pg8::cvt_pk_bf16(S[2 * (ks_)][0], S[2 * (ks_)][1]); sb_.y = pg8::cvt_pk_bf16(S[2 * (ks_)][2], S[2 * (ks_)][3]); \
            sb_.z = pg8::cvt_pk_bf16(S[2 * (ks_) + 1][0], S[2 * (ks_) + 1][1]); sb_.w = pg8::cvt_pk_bf16(S[2 * (ks_) + 1][2], S[2 * (ks_) + 1][3]); dst = __builtin_bit_cast(bf16x8, sb_); } while (0)
#define SLICE(S, sl) do { \
            const int hh = MIX == 1 ? (sl) >> 2 : 0, vc0 = (sl) * 16; \
            const float* vh = vec + hh * 320; \
            f32x4 Y[4]; \
_Pragma("unroll") \
            for (int it = 0; it < 4; ++it) Y[it] = (f32x4){0.f, 0.f, 0.f, 0.f}; \
              \
            { bf16x8 QA[2][4]; \
_Pragma("unroll") \
              for (int ks = 0; ks < 2; ++ks) \
_Pragma("unroll") \
                for (int it = 0; it < 4; ++it) QFRAG(QA[ks][it], it, ks); \
              SB_(); \
_Pragma("unroll") \
              for (int ks = 0; ks < 2; ++ks) { bf16x8 sbf; SPACK(sbf, S, ks); \
_Pragma("unroll") \
                for (int it = 0; it < 4; ++it) Y[it] = MFMA16(sbf, QA[ks][it], Y[it]); } } \
            SB_(); \
            if (KS2 == 4) { bf16x8 QB[2][4]; \
_Pragma("unroll") \
              for (int ks = 0; ks < 2; ++ks) \
_Pragma("unroll") \
                for (int it = 0; it < 4; ++it) QFRAG(QB[ks][it], it, ks + 2); \
              SB_(); \
_Pragma("unroll") \
              for (int ks = 0; ks < 2; ++ks) { bf16x8 sbf; SPACK(sbf, S, ks + 2); \
_Pragma("unroll") \
                for (int it = 0; it < 4; ++it) Y[it] = MFMA16(sbf, QB[ks][it], Y[it]); } } \
            SB_(); \
              \
            bf16x8 Vf[2], PA[6]; \
_Pragma("unroll") \
            for (int ks = 0; ks < 2; ++ks) Vf[ks] = tr_frag(Vs + (ks * 32 + g4 * 8 + tq) * VST + vc0 + 4 * tp, VST); \
            PA[0] = *LDSP(const bf16x8, Pw + (hh * 64 + 0 * 16 + l15) * PST + 0 * 32 + g4 * 8); \
            PA[1] = *LDSP(const bf16x8, Pw + (hh * 64 + 1 * 16 + l15) * PST + 0 * 32 + g4 * 8); \
            PA[2] = *LDSP(const bf16x8, Pw + (hh * 64 + 2 * 16 + l15) * PST + 0 * 32 + g4 * 8); \
            PA[3] = *LDSP(const bf16x8, Pw + (hh * 64 + 2 * 16 + l15) * PST + 1 * 32 + g4 * 8); \
            PA[4] = *LDSP(const bf16x8, Pw + (hh * 64 + 3 * 16 + l15) * PST + 0 * 32 + g4 * 8); \
            PA[5] = *LDSP(const bf16x8, Pw + (hh * 64 + 3 * 16 + l15) * PST + 1 * 32 + g4 * 8); \
            if (MIX != 3) { \
_Pragma("unroll") \
                for (int it = 0; it < 4; ++it) Y[it] = Y[it] * vh[128 + it * 16 + l15]; \
            } \
            SB_(); \
            Y[0] = MFMA16(Vf[0], PA[0], Y[0]); Y[1] = MFMA16(Vf[0], PA[1], Y[1]); Y[2] = MFMA16(Vf[0], PA[2], Y[2]); Y[3] = MFMA16(Vf[0], PA[4], Y[3]); \
            Y[2] = MFMA16(Vf[1], PA[3], Y[2]); Y[3] = MFMA16(Vf[1], PA[5], Y[3]); \
            SB_(); \
              \
_Pragma("unroll") \
            for (int it = 0; it < 4; ++it) { \
                const int i = it * 16 + l15; const int ro = (d ? 63 - i : i); \
                const f32x4 y = Y[it]; \
                if (DEN) { if (g4 == 0) DENP[((size_t)base + ro) * 4] = y[0]; } \
                else { u32x2 o; o.x = pg8::cvt_pk_bf16(y[0], y[1]); o.y = pg8::cvt_pk_bf16(y[2], y[3]); *(u32x2*)(ysb + ro * D + vc0 + g4 * 4) = o; } \
            } \
            SB_(); \
            bf16x8 Vw[2]; float dec = 1.f; \
            if (MIX != 3) { \
                dec = vh[256]; \
_Pragma("unroll") \
                for (int ks = 0; ks < 2; ++ks) { \
                    const f32x4 w0 = *LDSP(const f32x4, vh + 192 + ks * 32 + g4 * 8), w1 = *LDSP(const f32x4, vh + 192 + ks * 32 + g4 * 8 + 4); \
                    u32x4 o; \
                    o.x = pg8::cvt_pk_bf16(bf2f((unsigned short)Vf[ks][0]) * w0[0], bf2f((unsigned short)Vf[ks][1]) * w0[1]); \
                    o.y = pg8::cvt_pk_bf16(bf2f((unsigned short)Vf[ks][2]) * w0[2], bf2f((unsigned short)Vf[ks][3]) * w0[3]); \
                    o.z = pg8::cvt_pk_bf16(bf2f((unsigned short)Vf[ks][4]) * w1[0], bf2f((unsigned short)Vf[ks][5]) * w1[1]); \
                    o.w = pg8::cvt_pk_bf16(bf2f((unsigned short)Vf[ks][6]) * w1[2], bf2f((unsigned short)Vf[ks][7]) * w1[3]); \
                    Vw[ks] = __builtin_bit_cast(bf16x8, o); \
                } \
            } else { Vw[0] = Vf[0]; Vw[1] = Vf[1]; } \
              \
_Pragma("unroll") \
            for (int th = 0; th < NT / 4; ++th) { \
                bf16x8 KA[4][2]; \
_Pragma("unroll") \
                for (int t = 0; t < 4; ++t) \
_Pragma("unroll") \
                    for (int ks = 0; ks < 2; ++ks) KA[t][ks] = tr_frag(Ks + (ks * 32 + g4 * 8 + tq) * QST + (th * 4 + t) * 16 + 4 * tp, QST); \
                SB_(); \
_Pragma("unroll") \
                for (int t = 0; t < 4; ++t) { \
                    f32x4 acc = S[th * 4 + t] * dec; \
                    acc = MFMA16(KA[t][0], Vw[0], acc); acc = MFMA16(KA[t][1], Vw[1], acc); \
                    if (MIX == 3) { const f32x4 e4 = *LDSP(const f32x4, vec + 256 + (th * 4 + t) * 16 + g4 * 4); acc = acc * e4; } \
                    S[th * 4 + t] = acc; \
                } \
                SB_(); \
            } \
    } while (0)
        if (!DEN) SLICE(S0, wid);
        else if (wid == 0) SLICE(S0, 8);
        if (c + 1 < (CTXL + SEQ) / 64) { if (par == 0) STAGE_ALL(1, B); else STAGE_ALL(0, A); }
        __syncthreads();
    }
    }
}
__device__ void phase_scan(const KP& p, int l, unsigned char* smem) {
    if (ogdim() > 160 && obid() >= 160) {
        const int w = obid() - 160, nw = ogdim() - 160;
        convert_weights(p, l, CT_IN, CT_IN + CT_OUT + CT_UP + CT_DN, w, nw, smem);
        if (l == 0) convert_weights(p, 1, 0, CT_IN, w, nw, smem);
        return;
    }
    for (int item = obid(); item < 160; item += ogdim()) {
        if (item >= 128) { const int idx = item - 128; scan_item<0, true>(p, idx >> 3, (idx >> 2) & 1, idx & 3, smem); continue; }
        const int grp = item & 3, mix = (item >> 2) & 3, d = (item >> 4) & 1, b = item >> 5;
        if (mix == 0) scan_item<0, false>(p, b, d, grp, smem);
        else if (mix == 1) scan_item<1, false>(p, b, d, grp, smem);
        else if (mix == 2) scan_item<2, false>(p, b, d, grp, smem);
        else scan_item<3, false>(p, b, d, grp, smem);
    }
    if (ogdim() <= 160) {
        convert_weights(p, l, CT_IN, CT_IN + CT_OUT + CT_UP + CT_DN, obid(), ogdim(), smem);
        if (l == 0) convert_weights(p, 1, 0, CT_IN, obid(), ogdim(), smem);
    }
}

struct CombRaw { bf16x8 a[4], b[4], g[4], xs[4]; float s0, s1; };
DI void comb_load(const KP& p, int row, int lane, int mixer, int ec0, int gcol, CombRaw& r) {
    const bf16_t* U = (const bf16_t*)(p.ws + WS_U); const bf16_t* X = (const bf16_t*)(p.ws + WS_XBC);
    const bf16_t* YS = (const bf16_t*)(p.ws + WS_YS); const float* DEN = (const float*)(p.ws + WS_DEN);
    const bf16_t* y0p = YS + (size_t)row * D + mixer * 512 + ec0; const bf16_t* y1p = y0p + (size_t)T * D;
    r.s0 = 1.f; r.s1 = 1.f;
    if (mixer == 0) { const int h = (lane & 15) >> 2; r.s0 = DEN[(size_t)row * 4 + h]; r.s1 = DEN[((size_t)T + row) * 4 + h]; }
#pragma unroll
    for (int i = 0; i < 4; ++i) { r.a[i] = *(const bf16x8*)(y0p + i * 8); r.b[i] = *(const bf16x8*)(y1p + i * 8); r.g[i] = *(const bf16x8*)(U + (size_t)row * NU + gcol + i * 8); }
    if (mixer == 1) {
#pragma unroll
        for (int i = 0; i < 4; ++i) r.xs[i] = *(const bf16x8*)(X + (size_t)row * 1024 + ec0 + i * 8);
    }
}
DI void comb_compute(const KP& p, int row, int lane, int mixer, int ec0, const float* gain, float sd, const CombRaw& r) {
    bf16_t* H = (bf16_t*)(p.ws + WS_H);
    float y[32], gt[32];
    float s0 = 1.f, s1 = 1.f;
    if (mixer == 0) { s0 = 1.f / fmaxf(fabsf(r.s0), 1.f); s1 = 1.f / fmaxf(fabsf(r.s1), 1.f); }
#pragma unroll
    for (int i = 0; i < 4; ++i) {
#pragma unroll
        for (int j = 0; j < 8; ++j) {
            y[i * 8 + j] = bf2f((unsigned short)r.a[i][j]) * s0 + bf2f((unsigned short)r.b[i][j]) * s1;
            const float gv = bf2f((unsigned short)r.g[i][j]);
            gt[i * 8 + j] = mixer == 0 ? sigmoid_f(gv) : silu_f(gv);
        }
    }
    if (mixer == 1) {
#pragma unroll
        for (int i = 0; i < 4; ++i) {
#pragma unroll
            for (int j = 0; j < 8; ++j) { y[i * 8 + j] = (y[i * 8 + j] + sd * bf2f((unsigned short)r.xs[i][j])) * gt[i * 8 + j]; gt[i * 8 + j] = 1.f; }
        }
    }
    float s = 0.f;
#pragma unroll
    for (int j = 0; j < 32; ++j) s += y[j];
    s += shx(s, 1, lane); s += shx(s, 2, lane);
    const float mean = (mixer == 0 || mixer == 2) ? s * (1.f / 128.f) : 0.f;
    float q = 0.f;
#pragma unroll
    for (int j = 0; j < 32; ++j) { y[j] -= mean; q += y[j] * y[j]; }
    q += shx(q, 1, lane); q += shx(q, 2, lane);
    float q16 = q; q16 += shx(q16, 4, lane); q16 += shx(q16, 8, lane);
    const float rstd = rsqrtf((mixer == 1 ? q16 * (1.f / 512.f) : q * (1.f / 128.f)) + EPS);
    bf16_t* op = H + (size_t)row * D + mixer * 512 + ec0;
#pragma unroll
    for (int i = 0; i < 4; ++i) {
        const f32x4 g0 = *(const f32x4*)(gain + i * 8), g1 = *(const f32x4*)(gain + i * 8 + 4);
        u32x4 w;
        w.x = pg8::cvt_pk_bf16(y[i * 8 + 0] * rstd * g0[0] * gt[i * 8 + 0], y[i * 8 + 1] * rstd * g0[1] * gt[i * 8 + 1]);
        w.y = pg8::cvt_pk_bf16(y[i * 8 + 2] * rstd * g0[2] * gt[i * 8 + 2], y[i * 8 + 3] * rstd * g0[3] * gt[i * 8 + 3]);
        w.z = pg8::cvt_pk_bf16(y[i * 8 + 4] * rstd * g1[0] * gt[i * 8 + 4], y[i * 8 + 5] * rstd * g1[1] * gt[i * 8 + 5]);
        w.w = pg8::cvt_pk_bf16(y[i * 8 + 6] * rstd * g1[2] * gt[i * 8 + 6], y[i * 8 + 7] * rstd * g1[3] * gt[i * 8 + 7]);
        *(u32x4*)(op + i * 8) = w;
    }
}
__device__ void phase_comb(const KP& p, int l, int Mrows) {
    const int tid = otid(); const int lane = tid & 63, wid = tid >> 6;
    const int mixer = lane >> 4, ec0 = (lane & 15) * 32;
    const int gcol = (mixer == 0 ? U_MO : mixer == 1 ? U_SZ : mixer == 2 ? U_RG : U_GG) + ec0;
    const float* gain = (mixer == 0 ? p.in[I_MNORM] : mixer == 1 ? p.in[I_SNORM] : mixer == 2 ? p.in[I_RNORM] : p.in[I_GNORM]) + l * 512 + ec0;
    const float sd = p.in[I_SD][l * 8 + (ec0 >> 6)];
    const int stride = ogdim() * 8;
    for (int row = obid() * 8 + wid; row < Mrows; row += 2 * stride) {
        const int row1 = row + stride; const bool has1 = row1 < Mrows;
        CombRaw r0, r1;
        comb_load(p, row, lane, mixer, ec0, gcol, r0);
        if (has1) comb_load(p, row1, lane, mixer, ec0, gcol, r1);
        comb_compute(p, row, lane, mixer, ec0, gain, sd, r0);
        if (has1) comb_compute(p, row1, lane, mixer, ec0, gain, sd, r1);
    }
}

__device__ void run_phase(const KP& p, int ph, unsigned char* smem) {
    const float* mod = (const float*)(p.ws + WS_MOD);
    if (ph == 0) { phase_init(p, smem); return; }
    if (ph == 1) { phase_row<false, true, true>(p, T, nullptr, nullptr, mod, 0, 2048); return; }
    const int l = (ph - 2) / 9, k = (ph - 2) % 9;
    const bool last = l == 1;
    const int Mrows = last ? TL : T;
    const float* modl = mod + (size_t)l * 5 * NMOD;
    bf16_t* H = (bf16_t*)(p.ws + WS_H); bf16_t* U = (bf16_t*)(p.ws + WS_U);
    if (k == 0 || k == 4 || k == 6 || k == 7) {
        EpiAll E; E.kind = k == 0 ? 0 : (k == 6 ? 2 : 1); E.O = E.kind == 1 ? (bf16_t*)(p.ws + WS_YS) : U; E.G = (float*)(p.ws + WS_GATES); E.gmod = modl + (k == 4 ? 4096 : 10240);
        const bf16_t* A = k == 7 ? U : H;
        const bf16_t* Bt = (const bf16_t*)(p.ws + (k == 0 ? WS_WIN : k == 4 ? WS_WOUT : k == 6 ? WS_WUP : WS_WDN));
        const int N = k == 0 ? NINP : (k == 6 ? NUP : D), K = k == 7 ? DFF : D;
        const bool split = !last && (k == 4 || k == 7);
        const int M = (k == 0 || k == 6) ? (k == 0 ? T : Mrows) : TL;
        run_gemm(smem, A, Bt, M, N, K, E);
        if (split) {
            const int nsplit = k == 4 ? 8 : 4;
            EpiAll E2 = E; E2.kind = 3; E2.G = (float*)(p.ws + WS_YS + (size_t)T * D * 2);
            pg8::Gemm g; g.A = A + (size_t)TL * K; g.Bt = Bt; g.M = TC; g.N = D; g.K = K / nsplit; g.ld = K;
            SplitOrder S; S.nsplit = nsplit; S.G = ogdim(); S.c = obid();
            pg8::gemm_phase<EpiAll, SplitOrder, false>((PG8_LAS unsigned char*)smem, g, S, E2, nullptr);
        }
        return;
    }
    switch (k) {
    case 1: phase_pre(p, l, smem); break;
    case 2: phase_scan(p, l, smem); break;
    case 3: phase_comb(p, l, Mrows); break;
    case 5:
        if (l == 0) phase_row<true, true, true>(p, Mrows, p.in[I_POSTG] + (size_t)(l * 2 + 0) * D, p.in[I_POSTB] + (size_t)(l * 2 + 0) * D, modl, 6144, 8192, (const float*)(p.ws + WS_YS + (size_t)T * D * 2), 8);
        else phase_row<true, true, false>(p, Mrows, p.in[I_POSTG] + (size_t)(l * 2 + 0) * D, p.in[I_POSTB] + (size_t)(l * 2 + 0) * D, modl, 6144, 8192);
        break;
    case 8:
        if (!last) { phase_row<true, true>(p, T, p.in[I_POSTG] + (size_t)(l * 2 + 1) * D, p.in[I_POSTB] + (size_t)(l * 2 + 1) * D, modl + 5 * NMOD, 0, 2048, (const float*)(p.ws + WS_YS + (size_t)T * D * 2), 4); }
        else phase_row<true, false>(p, TL, p.in[I_POSTG] + (size_t)(l * 2 + 1) * D, p.in[I_POSTB] + (size_t)(l * 2 + 1) * D, modl, 0, 0);
        break;
    }
}

DI void grid_barrier(unsigned* bar, unsigned target) {
    asm volatile("s_waitcnt vmcnt(0) lgkmcnt(0)" ::: "memory");
    __syncthreads();
    if (threadIdx.x == 0) {
        __builtin_amdgcn_fence(__ATOMIC_RELEASE, "agent");
        asm volatile("s_waitcnt vmcnt(0)" ::: "memory");
        __hip_atomic_fetch_add(bar, 1u, __ATOMIC_RELAXED, __HIP_MEMORY_SCOPE_AGENT);
        while (__hip_atomic_load(bar, __ATOMIC_RELAXED, __HIP_MEMORY_SCOPE_AGENT) < target) __builtin_amdgcn_s_sleep(1);
        __builtin_amdgcn_fence(__ATOMIC_ACQUIRE, "agent");
        asm volatile("s_waitcnt vmcnt(0)" ::: "memory");
    }
    __syncthreads();
}
#ifndef PROBE_MASK
#define PROBE_MASK 0u
#endif
__global__ void __launch_bounds__(512, 2) mega(KP p) {
    extern __shared__ __attribute__((aligned(16))) unsigned char smem[];
    cg::grid_group grid = cg::this_grid();
    unsigned nbar = 0;
    unsigned long long tacc = 0ull;
    for (int ph = p.ph_lo; ph < p.ph_hi; ++ph) {
        unsigned long long t0 = 0ull;
        if (PROBE_MASK != 0u) t0 = __builtin_amdgcn_s_memrealtime();
        if (ph == 0 && blockIdx.x == 0 && threadIdx.x == 0) __hip_atomic_store((unsigned*)(p.ws + WS_BAR), 0u, __ATOMIC_RELAXED, __HIP_MEMORY_SCOPE_AGENT);
        run_phase(p, ph, smem);
        if (ph + 1 < p.ph_hi) {
            if (ph == 0) grid.sync();
            else { ++nbar; grid_barrier((unsigned*)(p.ws + WS_BAR), nbar * gridDim.x); }
        }
        if (PROBE_MASK != 0u && ((PROBE_MASK >> ph) & 1u)) tacc += __builtin_amdgcn_s_memrealtime() - t0;
    }
    if (PROBE_MASK != 0u && blockIdx.x == 0 && threadIdx.x == 0) {
        const unsigned long long t1 = __builtin_amdgcn_s_memrealtime();
        while (__builtin_amdgcn_s_memrealtime() - t1 < tacc) __builtin_amdgcn_s_sleep(8);
    }
}

#ifndef ONE_LAUNCH
#define ONE_LAUNCH 1
#endif
extern "C" void kernel_launch(void* const* d_in, const int* in_sizes, int n_in, void* d_out, int out_size, void* d_ws, size_t ws_size, hipStream_t stream) {
    static int grid = 0;
    if (grid == 0) {
        if (n_in != 26 || out_size != TL * D || ws_size < WS_END) { fprintf(stderr, "kernel_launch: unexpected shapes (n_in %d out %d ws %zu need %zu)\n", n_in, out_size, ws_size, (size_t)WS_END); grid = -1; return; }
        int dev = 0, cus = 0, per_cu = 0;
        hipGetDevice(&dev); hipDeviceGetAttribute(&cus, hipDeviceAttributeMultiprocessorCount, dev);
        if (hipFuncSetAttribute((const void*)mega, hipFuncAttributeMaxDynamicSharedMemorySize, LDS_BYTES) != hipSuccess) { fprintf(stderr, "kernel_launch: hipFuncSetAttribute failed\n"); grid = -1; return; }
        if (hipOccupancyMaxActiveBlocksPerMultiprocessor(&per_cu, (const void*)mega, 512, LDS_BYTES) != hipSuccess || per_cu < 1) { fprintf(stderr, "kernel_launch: occupancy query gives %d\n", per_cu); per_cu = 1; }
        (void)hipGetLastError();
        grid = cus;
    }
    if (grid < 0) return;
    KP p{};
    for (int i = 0; i < 26; ++i) p.in[i] = (const float*)d_in[i];
    p.out = (float*)d_out; p.ws = (unsigned char*)d_ws;
#if ONE_LAUNCH
    p.ph_lo = 0; p.ph_hi = NPHASE;
    void* args[] = {&p};
    hipError_t e = hipLaunchCooperativeKernel((const void*)mega, dim3(grid), dim3(512), args, LDS_BYTES, stream);
    if (e != hipSuccess) fprintf(stderr, "cooperative launch failed: %s (grid %d)\n", hipGetErrorString(e), grid);
#else
    for (int ph = 0; ph < NPHASE; ++ph) {
        p.ph_lo = ph; p.ph_hi = ph + 1;
        hipLaunchKernelGGL(mega, dim3(grid), dim3(512), LDS_BYTES, stream, p);
    }
#endif
}
```

```cpp
#include <hip/hip_runtime.h>
#include <hip/hip_cooperative_groups.h>
#include <cstdio>
namespace cg = cooperative_groups;
namespace pg8 {
#define PG8_LAS __attribute__((address_space(3)))
typedef unsigned short bf16_t;
typedef short bf16x8 __attribute__((ext_vector_type(8)));
typedef float f32x4 __attribute__((ext_vector_type(4)));
typedef unsigned u32x4 __attribute__((ext_vector_type(4)));
constexpr int BM = 256, BK = 64, HALF = 128, HTB = HALF * BK * 2  , STAGE_BYTES = 8 * HTB, NXCD = 8, WGM = 8;

__host__ __device__ __forceinline__ int lds_byte(int r, int c) { const int st = (r >> 4) * 2 + (c >> 5), rr = r & 15, cc = c & 31, ob = rr * 64 + cc * 2; return st * 1024 + (ob ^ (((ob >> 9) & 1) << 5)); }
__host__ __device__ __forceinline__ void stage_rc(int b, int& R, int& C) { const int st = b / 1024, sb = b % 1024, swz = sb ^ (((sb >> 9) & 1) << 5); R = (st >> 1) * 16 + swz / 64; C = (st & 1) * 32 + (swz % 64) / 2; }
__host__ __device__ __forceinline__ int perm32(int rho) { const int n = rho >> 4, i = rho & 15; return 8 * (i >> 2) + 4 * n + (i & 3); }

struct Unit { int pm, pn, ks; };
struct Gemm { const bf16_t* A; const bf16_t* Bt; int M, N, K, ld; };

struct StaticOrder {
    int nM, nN, nwg, G, c;
    __host__ __device__ void init(int M, int N, int G_, int c_) { nM = M / BM; nN = N / BM; nwg = nM * nN; G = G_; c = c_; }
    __host__ __device__ bool next(int i, Unit& u) const {
        const long L = (long)i * G + c; if (L >= nwg) return false;
        int wgid = (int)L; { const int q = nwg / NXCD, r = nwg % NXCD, xcd = wgid % NXCD, off = wgid / NXCD; wgid = (xcd < r ? xcd * (q + 1) : r * (q + 1) + (xcd - r) * q) + off; }
        const int nig = WGM * nN, gid = wgid / nig, fm = gid * WGM, gsz = (nM - fm) < WGM ? (nM - fm) : WGM;
        u.pm = fm + ((wgid % nig) % gsz); u.pn = (wgid % nig) / gsz; u.ks = 0; return true;
    }
    __device__ __forceinline__ void a_ready(const Unit&) const {}
    __device__ __forceinline__ void done(const Unit&) const {}
};
__device__ __forceinline__ unsigned cvt_pk_bf16(float lo, float hi) { unsigned r; asm volatile("v_cvt_pk_bf16_f32 %0, %1, %2" : "=v"(r) : "v"(lo), "v"(hi)); return r; }
template <class Epi, class Sched, bool STAMP = false>
__device__ __forceinline__ void gemm_phase(PG8_LAS unsigned char* lds, const Gemm g, const Sched& S, const Epi& E, unsigned long long* stamps) {
    int tid_ = threadIdx.x; asm volatile("" : "+v"(tid_)); const int tid = tid_, wid = __builtin_amdgcn_readfirstlane(tid >> 6), lane = tid & 63, wr = wid >> 2, wc = wid & 3, fr = lane & 15, fq = lane >> 4;
    const int K = g.ld, nt = g.K / BK; const size_t sstep = (size_t)g.K * 2;
    int ts_lo = 0, ts_hi = 0, nts = 0; const unsigned long long rt_entry = STAMP ? (unsigned long long)wall_clock64() : 0ull;
#define PG8_STAMP() do { if (STAMP && wid == 0 && nts < 64) { const unsigned long long _c = (unsigned long long)clock64(); \
        ts_lo = (lane == nts) ? (int)(unsigned)_c : ts_lo; ts_hi = (lane == nts) ? (int)(unsigned)(_c >> 32) : ts_hi; ++nts; } } while (0)
    PG8_STAMP();
    unsigned voffA[2], voffB[2];
#pragma unroll
    for (int i = 0; i < 2; ++i) { int R, C; stage_rc(tid * 16 + i * 8192, R, C); const int Rb = Epi::PERM ? ((R & ~31) + perm32(R & 31)) : R;
        voffA[i] = (unsigned)(R * K + C) * 2u; voffB[i] = (unsigned)(Rb * K + C) * 2u; }
    const size_t kstep = (size_t)(BK * 2);
    const size_t hstep = (size_t)HALF * K * 2;
    const size_t tstep = 2 * hstep;
    const unsigned ldsw = (unsigned)wid * 1024u;
    const int aoff = lds_byte(wr * 64 + fr, fq * 8), boff = lds_byte(wc * 32 + fr, fq * 8);
#define PG8_SA(b, h) (((b) * 2 + (h)) * HTB)
#define PG8_SB(b, h) ((4 + (b) * 2 + (h)) * HTB)
#define PG8_STAGE(bufoff, gbase, voff) do { _Pragma("unroll") for (int _i = 0; _i < 2; ++_i) \
        __builtin_amdgcn_global_load_lds((const unsigned*)((const char*)(gbase) + (voff)[_i]), (PG8_LAS unsigned*)(lds + (bufoff) + ldsw + _i * 8192), 16, 0, 0); } while (0)
#define PG8_LDA(dst, b, h) do { _Pragma("unroll") for (int m = 0; m < 4; ++m) _Pragma("unroll") for (int k = 0; k < 2; ++k) dst[m][k] = *(const PG8_LAS bf16x8*)(lds + PG8_SA(b, h) + aoff + m * 2048 + k * 1024); } while (0)
#define PG8_LDB(dst, b, h) do { _Pragma("unroll") for (int n = 0; n < 2; ++n) _Pragma("unroll") for (int k = 0; k < 2; ++k) dst[n][k] = *(const PG8_LAS bf16x8*)(lds + PG8_SB(b, h) + boff + n * 2048 + k * 1024); } while (0)
#define PG8_MMA(ai, bj, At, Bt) do { __builtin_amdgcn_s_setprio(1); _Pragma("unroll") for (int m = 0; m < 4; ++m) _Pragma("unroll") for (int n = 0; n < 2; ++n) _Pragma("unroll") for (int k = 0; k < 2; ++k) \
        acc[ai][bj][m][n] = __builtin_amdgcn_mfma_f32_16x16x32_bf16(Bt[n][k], At[m][k], acc[ai][bj][m][n], 0, 0, 0); __builtin_amdgcn_s_setprio(0); } while (0)
#define PG8_WAIT_V(n) asm volatile("s_waitcnt vmcnt(" #n ")" ::: "memory")
#define PG8_WAIT_L(n) asm volatile("s_waitcnt lgkmcnt(" #n ")" ::: "memory")
#define PG8_BAR __builtin_amdgcn_s_barrier()
#define PG8_SCHED __builtin_amdgcn_sched_barrier(0)
    Unit cur, nxt; int ui = 0;
    if (!S.next(0, cur)) return;
    f32x4 acc[2][2][4][2];
#pragma unroll
    for (int a = 0; a < 2; ++a)
#pragma unroll
        for (int b = 0; b < 2; ++b)
#pragma unroll
            for (int m = 0; m < 4; ++m)
#pragma unroll
                for (int n = 0; n < 2; ++n) acc[a][b][m][n] = (f32x4){0.f, 0.f, 0.f, 0.f};
    bf16x8 At[4][2], B0[2][2], B1[2][2];
    const char* cA = (const char*)g.A + (size_t)cur.pm * tstep + (size_t)cur.ks * sstep; const char* cB = (const char*)g.Bt + (size_t)cur.pn * tstep + (size_t)cur.ks * sstep;
    S.a_ready(cur);
    PG8_STAGE(PG8_SB(0, 0), cB, voffB); PG8_STAGE(PG8_SA(0, 0), cA, voffA); PG8_STAGE(PG8_SB(0, 1), cB + hstep, voffB); PG8_STAGE(PG8_SA(0, 1), cA + hstep, voffA);
    if (wr == 1) PG8_BAR;
    PG8_WAIT_V(4); PG8_BAR;
    PG8_STAGE(PG8_SB(1, 0), cB + kstep, voffB); PG8_STAGE(PG8_SA(1, 0), cA + kstep, voffA); PG8_STAGE(PG8_SB(1, 1), cB + hstep + kstep, voffB);
    PG8_WAIT_V(6); PG8_BAR;
    PG8_STAMP();
    for (;;) {
        const bool has_next = S.next(ui + 1, nxt);
        const char* nA = has_next ? (const char*)g.A + (size_t)nxt.pm * tstep + (size_t)nxt.ks * sstep : cA; const char* nB = has_next ? (const char*)g.Bt + (size_t)nxt.pn * tstep + (size_t)nxt.ks * sstep : cB;
        for (int t = 0; t < nt; t += 2) {
            const bool last = (t == nt - 2);
            const char* a1 = cA + (size_t)(t + 1) * kstep;
            const char* a2 = last ? nA : cA + (size_t)(t + 2) * kstep; const char* b2 = last ? nB : cB + (size_t)(t + 2) * kstep;
            const char* a3 = a2 + kstep; const char* b3 = b2 + kstep;
            if (last && has_next) S.a_ready(nxt);
            PG8_LDB(B0, 0, 0); PG8_SCHED; PG8_LDA(At, 0, 0); PG8_STAGE(PG8_SA(1, 1), a1 + hstep, voffA);
            PG8_WAIT_L(8); PG8_BAR; PG8_WAIT_L(0); PG8_MMA(0, 0, At, B0); PG8_BAR; PG8_SCHED;
            PG8_LDB(B1, 0, 1); PG8_STAGE(PG8_SB(0, 0), b2, voffB);
            PG8_BAR; PG8_WAIT_L(0); PG8_MMA(0, 1, At, B1); PG8_BAR;
            PG8_LDA(At, 0, 1); PG8_STAGE(PG8_SA(0, 0), a2, voffA);
            PG8_BAR; PG8_WAIT_L(0); PG8_MMA(1, 0, At, B0); PG8_BAR; PG8_SCHED;
            PG8_STAGE(PG8_SB(0, 1), b2 + hstep, voffB);
            PG8_WAIT_V(6); PG8_BAR; PG8_MMA(1, 1, At, B1); PG8_BAR;
            PG8_LDB(B0, 1, 0); PG8_SCHED; PG8_LDA(At, 1, 0); PG8_STAGE(PG8_SA(0, 1), a2 + hstep, voffA);
            PG8_WAIT_L(8); PG8_BAR; PG8_WAIT_L(0); PG8_MMA(0, 0, At, B0); PG8_BAR; PG8_SCHED;
            PG8_LDB(B1, 1, 1); PG8_STAGE(PG8_SB(1, 0), b3, voffB);
            PG8_BAR; PG8_WAIT_L(0); PG8_MMA(0, 1, At, B1); PG8_BAR;
            PG8_LDA(At, 1, 1); PG8_STAGE(PG8_SA(1, 0), a3, voffA);
            PG8_BAR; PG8_WAIT_L(0); PG8_MMA(1, 0, At, B0); PG8_BAR; PG8_SCHED;
            PG8_STAGE(PG8_SB(1, 1), b3 + hstep, voffB);
            PG8_WAIT_V(6); PG8_BAR; PG8_MMA(1, 1, At, B1); PG8_BAR;
        }
        PG8_STAMP();
        if constexpr (!Epi::AFTER_DRAIN) { E(acc, cur, wr, wc, fr, fq); S.done(cur); }
        PG8_STAMP();
        if (!has_next) break;
#pragma unroll
        for (int a = 0; a < 2; ++a)
#pragma unroll
            for (int b = 0; b < 2; ++b)
#pragma unroll
                for (int m = 0; m < 4; ++m)
#pragma unroll
                    for (int n = 0; n < 2; ++n) acc[a][b][m][n] = (f32x4){0.f, 0.f, 0.f, 0.f};
        cur = nxt; cA = nA; cB = nB; ++ui;
    }
    PG8_WAIT_V(0);
    if (wr == 0) PG8_BAR;
    PG8_BAR;
    if constexpr (Epi::AFTER_DRAIN) { E.fused(acc, cur, wr, wc, fr, fq, lds, wid, lane); S.done(cur); }
    PG8_STAMP();
    if (STAMP && wid == 0) { stamps[lane] = lane < nts ? (((unsigned long long)(unsigned)ts_hi << 32) | (unsigned)ts_lo) : 0ull;
        if (lane == 62) stamps[62] = rt_entry; if (lane == 63) stamps[63] = (unsigned long long)wall_clock64(); }
#undef PG8_STAMP
#undef PG8_SA
#undef PG8_SB
#undef PG8_STAGE
#undef PG8_LDA
#undef PG8_LDB
#undef PG8_MMA
#undef PG8_WAIT_V
#undef PG8_WAIT_L
#undef PG8_BAR
#undef PG8_SCHED
}
}

using pg8::bf16_t; using pg8::bf16x8; using pg8::f32x4; using pg8::u32x4;
#define DI __device__ __forceinline__
typedef unsigned u32x2 __attribute__((ext_vector_type(2)));
constexpr int D = 2048, NBATCH = 4, SEQ = 4096, CTXL = 256;
constexpr int TL = NBATCH * SEQ, TC = NBATCH * CTXL, T = TL + TC;
constexpr int NIN = 7232, NINP = 7424, NU = 7168, DFF = 5632, NUP = 2 * DFF, NMOD = 12288;
constexpr float EPS = 1e-5f, ALPHA = 1.41421356237309515f;
constexpr int U_MQ = 0, U_MK = 512, U_MV = 1024, U_MO = 1536, U_SZ = 2048, U_XBC = 2560, U_RQ = 3584, U_RK = 4096, U_RV = 4608, U_RG = 5120,
              U_GQ = 5632, U_GK = 5888, U_GV = 6144, U_GG = 6656;
constexpr size_t al256(size_t x) { return (x + 255) & ~(size_t)255; }
constexpr size_t WS_WIN = 0;
constexpr size_t WS_WOUT = WS_WIN + al256((size_t)NINP * D * 2);
constexpr size_t WS_WUP = WS_WOUT + al256((size_t)D * D * 2);
constexpr size_t WS_WDN = WS_WUP + al256((size_t)NUP * D * 2);
constexpr size_t WS_MOD = WS_WDN + al256((size_t)D * DFF * 2);
constexpr size_t WS_XC = WS_MOD + al256((size_t)2 * 5 * NMOD * 4);
constexpr size_t WS_H = WS_XC + al256((size_t)TC * D * 4);
constexpr size_t WS_U = WS_H + al256((size_t)T * D * 2);
constexpr size_t WS_GATES = WS_U + al256((size_t)T * NU * 2);
constexpr size_t WS_XBC = WS_GATES + al256((size_t)T * 64 * 4);
constexpr size_t WS_GL = WS_XBC + al256((size_t)T * 1024 * 2);
constexpr size_t WS_LA = WS_GL + al256((size_t)2 * 16 * T * 8);
constexpr size_t WS_YS = WS_LA + al256((size_t)2 * T * 256 * 4);
constexpr size_t WS_DEN = WS_YS + al256((size_t)2 * T * D * 2);
constexpr size_t WS_QG = WS_DEN + al256((size_t)2 * T * 4 * 4);
constexpr size_t WS_KG = WS_QG + al256((size_t)2 * T * 256 * 2);
constexpr size_t WS_EE = WS_KG + al256((size_t)2 * T * 256 * 2);
constexpr size_t WS_BAR = WS_EE + al256((size_t)2 * (T / 64) * 256 * 4);
constexpr size_t WS_YC = WS_BAR + 256;
constexpr size_t WS_END = WS_YC;
constexpr int LDS_BYTES = 131072;
constexpr int NPHASE = 20;
#ifndef SCAN_MFMA
#define SCAN_MFMA 15
#endif

struct KP { const float* in[26]; float* out; unsigned char* ws; int ph_lo, ph_hi; };
enum { I_X = 0, I_C, I_CTX, I_CCTX, I_ADAW, I_ADAB, I_WIN, I_MIGB, I_MFGB, I_MNORM, I_SCONVW, I_SCONVB, I_SDTB, I_SALOG, I_SD, I_SNORM, I_RDECAY, I_RNORM,
       I_GGW, I_GGB, I_GNORM, I_WOUT, I_POSTG, I_POSTB, I_WUP, I_WDN };

DI int obid() { int b = blockIdx.x; asm volatile("" : "+s"(b)); return b; }
DI int ogdim() { int g = gridDim.x; asm volatile("" : "+s"(g)); return g; }
DI int otid() { int t = threadIdx.x; asm volatile("" : "+v"(t)); return t; }
DI float bf2f(unsigned short h) { return __uint_as_float(((unsigned)h) << 16); }
DI unsigned short f2bf(float f) { return (unsigned short)pg8::cvt_pk_bf16(f, f); }
DI unsigned pk2(float lo, float hi) { return pg8::cvt_pk_bf16(lo, hi); }
DI float silu_f(float x) { return x * __builtin_amdgcn_rcpf(1.f + __expf(-x)); }
DI float sigmoid_f(float x) { return __builtin_amdgcn_rcpf(1.f + __expf(-x)); }
DI float softplus_f(float x) { return fmaxf(x, 0.f) + __logf(1.f + __expf(-fabsf(x))); }
DI float logsigmoid_f(float x) { return fminf(x, 0.f) - __logf(1.f + __expf(-fabsf(x))); }
DI float shx(float v, int m, int lane) { return __uint_as_float(__builtin_amdgcn_ds_bpermute((lane ^ m) << 2, __float_as_uint(v))); }
DI float wave_sum(float v, int lane) {
#pragma unroll
    for (int m = 32; m >= 1; m >>= 1) v += shx(v, m, lane);
    return v;
}
DI float* xrow_ptr(const KP& p, int row) { return row < TL ? p.out + (size_t)row * D : (float*)(p.ws + WS_XC) + (size_t)(row - TL) * D; }
DI const float* xin_ptr(const KP& p, int row) { return row < TL ? p.in[I_X] + (size_t)row * D : p.in[I_CTX] + (size_t)(row - TL) * D; }
DI int modidx(int row) { return row < TL ? (row >> 12) : 4; }
DI int scan_row(int b, int d, int s) { if (s < CTXL) { const int t = d ? CTXL - 1 - s : s; return TL + b * CTXL + t; } int t = s - CTXL; t = d ? SEQ - 1 - t : t; return b * SEQ + t; }

template <int KIND> DI int srccol(int n) {
    if (KIND == 0) {
        if (n < 2048) return n;
        if (n < 3584) return n + 16;
        if (n < 7168) return n + 32;
        if (n < 7184) return 2048 + (n - 7168);
        if (n < 7200) return 3600 + (n - 7184);
        if (n < 7232) return n;
        return -1;
    }
    if (KIND == 2) { const int pn = n >> 8, bj = (n >> 7) & 1, cl = n & 127; return bj * DFF + pn * 128 + cl; }
    return n;
}
constexpr int CT_IN = (NINP / 128) * (D / 64), CT_OUT = (D / 128) * (D / 64), CT_UP = (NUP / 128) * (D / 64), CT_DN = (D / 128) * (DFF / 64);
struct ConvTile { const float* W; bf16_t* dst; int Nsrc, Kd, n0, k0, kind; };
DI ConvTile conv_decode(const KP& p, int l, int t  ) {
    ConvTile c;
    if (t < CT_IN) { c.kind = 0; c.W = p.in[I_WIN] + (size_t)l * D * NIN; c.Nsrc = NIN; c.dst = (bf16_t*)(p.ws + WS_WIN); c.Kd = D; c.n0 = (t / (D / 64)) * 128; c.k0 = (t % (D / 64)) * 64; return c; }
    t -= CT_IN;
    if (t < CT_OUT) { c.kind = 1; c.W = p.in[I_WOUT] + (size_t)l * D * D; c.Nsrc = D; c.dst = (bf16_t*)(p.ws + WS_WOUT); c.Kd = D; c.n0 = (t / (D / 64)) * 128; c.k0 = (t % (D / 64)) * 64; return c; }
    t -= CT_OUT;
    if (t < CT_UP) { c.kind = 2; c.W = p.in[I_WUP] + (size_t)l * D * NUP; c.Nsrc = NUP; c.dst = (bf16_t*)(p.ws + WS_WUP); c.Kd = D; c.n0 = (t / (D / 64)) * 128; c.k0 = (t % (D / 64)) * 64; return c; }
    t -= CT_UP;
    c.kind = 3; c.W = p.in[I_WDN] + (size_t)l * DFF * D; c.Nsrc = D; c.dst = (bf16_t*)(p.ws + WS_WDN); c.Kd = DFF; c.n0 = (t / (DFF / 64)) * 128; c.k0 = (t % (DFF / 64)) * 64; return c;
}
DI int conv_srccol(int kind, int n) { return kind == 0 ? srccol<0>(n) : kind == 2 ? srccol<2>(n) : n; }
DI void conv_load(const ConvTile& c, int tid, f32x4 (&v)[4]) {
    const int r = tid >> 5, c4 = (tid & 31) * 4;
    const int sc = conv_srccol(c.kind, c.n0 + c4);
#pragma unroll
    for (int i = 0; i < 4; ++i) { v[i] = (f32x4){0.f, 0.f, 0.f, 0.f}; if (sc >= 0) v[i] = *(const f32x4*)(c.W + (size_t)(c.k0 + r + 16 * i) * c.Nsrc + sc); }
}
__device__ void convert_weights(const KP& p, int l, int t_lo, int t_hi, int w, int nw, unsigned char* smem) {
    float* tile = (float*)smem;
    const int tid = otid();
    int t = t_lo + w;
    if (t >= t_hi) return;
    ConvTile c = conv_decode(p, l, t);
    f32x4 v[4]; conv_load(c, tid, v);
    for (;;) {
        const int tn = t + nw; const bool more = tn < t_hi;
        ConvTile cn = c; f32x4 vn[4];
        if (more) { cn = conv_decode(p, l, tn); conv_load(cn, tid, vn); }
        {
            const int r = tid >> 5, c4 = (tid & 31) * 4;
#pragma unroll
            for (int i = 0; i < 4; ++i) { float* q = tile + (r + 16 * i) * 129 + c4; q[0] = v[i][0]; q[1] = v[i][1]; q[2] = v[i][2]; q[3] = v[i][3]; }
        }
        __syncthreads();
        {
            const int n = tid >> 2, ks = (tid & 3) * 16;
            float f[16];
#pragma unroll
            for (int j = 0; j < 16; ++j) f[j] = tile[(ks + j) * 129 + n];
            u32x4 w0, w1;
            w0.x = pk2(f[0], f[1]); w0.y = pk2(f[2], f[3]); w0.z = pk2(f[4], f[5]); w0.w = pk2(f[6], f[7]);
            w1.x = pk2(f[8], f[9]); w1.y = pk2(f[10], f[11]); w1.z = pk2(f[12], f[13]); w1.w = pk2(f[14], f[15]);
            bf16_t* q = c.dst + (size_t)(c.n0 + n) * c.Kd + c.k0 + ks;
            *(u32x4*)q = w0; *(u32x4*)(q + 8) = w1;
        }
        __syncthreads();
        if (!more) break;
        t = tn; c = cn;
#pragma unroll
        for (int i = 0; i < 4; ++i) v[i] = vn[i];
    }
}

__device__ void phase_init(const KP& p, unsigned char* smem) {
    const int tid = otid(), bid = obid(), nb = ogdim();
    float* sil = (float*)smem;
    float* red = sil + 5 * 2048;
    for (int i = tid; i < 5 * 2048; i += 512) { const int r = i >> 11, k = i & 2047; const float v = r < 4 ? p.in[I_C][r * 2048 + k] : p.in[I_CCTX][k]; sil[i] = silu_f(v); }
    __syncthreads();
    float* mod = (float*)(p.ws + WS_MOD);
    for (int chunk = bid; chunk < 256; chunk += nb) {
        const int l = chunk >> 7, n0 = (chunk & 127) * 96;
        const float* W = p.in[I_ADAW] + (size_t)l * D * NMOD;
        const int kp = tid >> 5, cc = tid & 31;
        float acc[3][5];
#pragma unroll
        for (int j = 0; j < 3; ++j)
#pragma unroll
            for (int r = 0; r < 5; ++r) acc[j][r] = 0.f;
#pragma unroll 8
        for (int k = kp; k < D; k += 16) {
            const float* wr = W + (size_t)k * NMOD + n0 + cc;
            const float w0 = wr[0], w1 = wr[32], w2 = wr[64];
#pragma unroll
            for (int r = 0; r < 5; ++r) { const float s = sil[r * 2048 + k]; acc[0][r] += s * w0; acc[1][r] += s * w1; acc[2][r] += s * w2; }
        }
#pragma unroll
        for (int j = 0; j < 3; ++j)
#pragma unroll
            for (int r = 0; r < 5; ++r) red[(kp * 96 + j * 32 + cc) * 5 + r] = acc[j][r];
        __syncthreads();
        if (tid < 480) {
            const int col = tid / 5, r = tid % 5; float s = 0.f;
#pragma unroll
            for (int k2 = 0; k2 < 16; ++k2) s += red[(k2 * 96 + col) * 5 + r];
            mod[(size_t)(l * 5 + r) * NMOD + n0 + col] = s + p.in[I_ADAB][l * NMOD + n0 + col];
        }
        __syncthreads();
    }
    convert_weights(p, 0, 0, CT_IN, bid, nb, smem);
}

DI void ln_stats(const f32x4 (&v)[8], int lane, float& mean, float& rstd) {
    float s = 0.f;
#pragma unroll
    for (int i = 0; i < 8; ++i) s += (v[i][0] + v[i][1]) + (v[i][2] + v[i][3]);
    s = wave_sum(s, lane); mean = s * (1.f / D);
    float q = 0.f;
#pragma unroll
    for (int i = 0; i < 8; ++i) { const f32x4 dd = v[i] - mean; q += (dd[0] * dd[0] + dd[1] * dd[1]) + (dd[2] * dd[2] + dd[3] * dd[3]); }
    q = wave_sum(q, lane); rstd = rsqrtf(q * (1.f / D) + EPS);
}
template <bool FIRST, bool MOD, bool FROM_INPUT>
DI void row_load(const KP& p, int row, int lane, const float* ycf, int nsplit, f32x4 (&v)[8], f32x4 (&y)[8]) {
    const float* xi = FROM_INPUT ? xin_ptr(p, row) : xrow_ptr(p, row);
#pragma unroll
    for (int i = 0; i < 8; ++i) v[i] = ((const f32x4*)xi)[i * 64 + lane];
    if (FIRST) {
        if (ycf != nullptr && row >= TL) {
            const float* yr = ycf + (size_t)(row - TL) * D;
#pragma unroll
            for (int i = 0; i < 8; ++i) y[i] = ((const f32x4*)yr)[i * 64 + lane];
            for (int sp = 1; sp < nsplit; ++sp) {
                yr += (size_t)TC * D;
#pragma unroll
                for (int i = 0; i < 8; ++i) y[i] += ((const f32x4*)yr)[i * 64 + lane];
            }
        } else {
            const bf16_t* yr = (const bf16_t*)(p.ws + WS_YS) + (size_t)row * D;
#pragma unroll
            for (int i = 0; i < 8; ++i) { const u32x2 t = ((const u32x2*)yr)[i * 64 + lane];
                y[i][0] = __uint_as_float(t[0] << 16); y[i][1] = __uint_as_float(t[0] & 0xffff0000u); y[i][2] = __uint_as_float(t[1] << 16); y[i][3] = __uint_as_float(t[1] & 0xffff0000u); }
        }
    }
}
template <bool FIRST, bool MOD>
DI void row_compute(const KP& p, int row, int lane, f32x4 (&v)[8], const f32x4 (&y)[8], const float* pg, const float* pb, const float* modl, int shoff, int scoff) {
    float mean, rstd;
    if (FIRST) {
        float* xr = xrow_ptr(p, row);
#pragma unroll
        for (int i = 0; i < 8; ++i) v[i] = ALPHA * v[i] + y[i];
        ln_stats(v, lane, mean, rstd);
#pragma unroll
        for (int i = 0; i < 8; ++i) {
            const f32x4 g = ((const f32x4*)pg)[i * 64 + lane], b = ((const f32x4*)pb)[i * 64 + lane];
            v[i] = (v[i] - mean) * rstd * g + b;
            ((f32x4*)xr)[i * 64 + lane] = v[i];
        }
    }
    if (MOD) {
        ln_stats(v, lane, mean, rstd);
        const float* mb = modl + (size_t)modidx(row) * NMOD;
        bf16_t* H = (bf16_t*)(p.ws + WS_H);
#pragma unroll
        for (int i = 0; i < 8; ++i) {
            const f32x4 sh = ((const f32x4*)(mb + shoff))[i * 64 + lane], sc = ((const f32x4*)(mb + scoff))[i * 64 + lane];
            const f32x4 o = (v[i] - mean) * rstd * (1.f + sc) + sh;
            u32x2 w; w[0] = pg8::cvt_pk_bf16(o[0], o[1]); w[1] = pg8::cvt_pk_bf16(o[2], o[3]);
            ((u32x2*)(H + (size_t)row * D))[i * 64 + lane] = w;
        }
    }
}
template <bool FIRST, bool MOD, bool FROM_INPUT = false>
__device__ void phase_row(const KP& p, int Mrows, const float* pg, const float* pb, const float* modl  , int shoff, int scoff, const float* ycf = nullptr, int nsplit = 0) {
    const int tid = otid(); const int lane = tid & 63, wid = tid >> 6;
    const int stride = ogdim() * 8;
    if (!FIRST) {
        for (int row = obid() * 8 + wid; row < Mrows; row += 4 * stride) {
            const int r1 = row + stride, r2 = row + 2 * stride, r3 = row + 3 * stride;
            f32x4 v0[8], v1[8], v2[8], v3[8], yd[8];
            row_load<FIRST, MOD, FROM_INPUT>(p, row, lane, ycf, nsplit, v0, yd);
            if (r1 < Mrows) row_load<FIRST, MOD, FROM_INPUT>(p, r1, lane, ycf, nsplit, v1, yd);
            if (r2 < Mrows) row_load<FIRST, MOD, FROM_INPUT>(p, r2, lane, ycf, nsplit, v2, yd);
            if (r3 < Mrows) row_load<FIRST, MOD, FROM_INPUT>(p, r3, lane, ycf, nsplit, v3, yd);
            row_compute<FIRST, MOD>(p, row, lane, v0, yd, pg, pb, modl, shoff, scoff);
            if (r1 < Mrows) row_compute<FIRST, MOD>(p, r1, lane, v1, yd, pg, pb, modl, shoff, scoff);
            if (r2 < Mrows) row_compute<FIRST, MOD>(p, r2, lane, v2, yd, pg, pb, modl, shoff, scoff);
            if (r3 < Mrows) row_compute<FIRST, MOD>(p, r3, lane, v3, yd, pg, pb, modl, shoff, scoff);
        }
        return;
    }
    for (int row = obid() * 8 + wid; row < Mrows; row += 2 * stride) {
        const int row1 = row + stride; const bool has1 = row1 < Mrows;
        f32x4 v0[8], v1[8], y0[8], y1[8];
        row_load<FIRST, MOD, FROM_INPUT>(p, row, lane, ycf, nsplit, v0, y0);
        if (has1) row_load<FIRST, MOD, FROM_INPUT>(p, row1, lane, ycf, nsplit, v1, y1);
        row_compute<FIRST, MOD>(p, row, lane, v0, y0, pg, pb, modl, shoff, scoff);
        if (has1) row_compute<FIRST, MOD>(p, row1, lane, v1, y1, pg, pb, modl, shoff, scoff);
    }
}

struct EpiAll {
    static constexpr bool PERM = true, AFTER_DRAIN = false;
    int kind; bf16_t* O; float* G; const float* gmod;
    DI void operator()(const f32x4 (&acc)[2][2][4][2], const pg8::Unit& u, int wr, int wc, int fr, int fq) const {
        const int row0 = u.pm * 256 + wr * 64 + fr;
        if (kind == 0) {
            if (u.pn < 28) {
                const int col0 = u.pn * 256 + wc * 32 + 8 * fq;
#pragma unroll
                for (int ai = 0; ai < 2; ++ai)
#pragma unroll
                    for (int m = 0; m < 4; ++m) {
                        bf16_t* rowp = O + (size_t)(row0 + ai * 128 + m * 16) * NU + col0;
#pragma unroll
                        for (int bj = 0; bj < 2; ++bj) {
                            const f32x4 v0 = acc[ai][bj][m][0], v1 = acc[ai][bj][m][1];
                            u32x4 w; w.x = pg8::cvt_pk_bf16(v0[0], v0[1]); w.y = pg8::cvt_pk_bf16(v0[2], v0[3]); w.z = pg8::cvt_pk_bf16(v1[0], v1[1]); w.w = pg8::cvt_pk_bf16(v1[2], v1[3]);
                            *(u32x4*)(rowp + bj * 128) = w;
                        }
                    }
            } else if (wc < 2) {
                const int col0 = wc * 32 + 8 * fq;
#pragma unroll
                for (int ai = 0; ai < 2; ++ai)
#pragma unroll
                    for (int m = 0; m < 4; ++m) {
                        float* rowp = G + (size_t)(row0 + ai * 128 + m * 16) * 64 + col0;
                        *(f32x4*)rowp = acc[ai][0][m][0]; *(f32x4*)(rowp + 4) = acc[ai][0][m][1];
                    }
            }
        } else if (kind == 1) {
            const int col0 = u.pn * 256 + wc * 32 + 8 * fq;
            const int mi = u.pm < 64 ? (u.pm >> 4) : 4;
            const float* gp = gmod + (size_t)mi * NMOD + col0;
            f32x4 gv[2][2];
#pragma unroll
            for (int bj = 0; bj < 2; ++bj)
#pragma unroll
                for (int n = 0; n < 2; ++n) gv[bj][n] = *(const f32x4*)(gp + bj * 128 + n * 4);
#pragma unroll
            for (int ai = 0; ai < 2; ++ai)
#pragma unroll
                for (int m = 0; m < 4; ++m) {
                    bf16_t* rowp = O + (size_t)(row0 + ai * 128 + m * 16) * D + col0;
#pragma unroll
                    for (int bj = 0; bj < 2; ++bj) {
                        const f32x4 v0 = gv[bj][0] * acc[ai][bj][m][0], v1 = gv[bj][1] * acc[ai][bj][m][1];
                        u32x4 w; w.x = pg8::cvt_pk_bf16(v0[0], v0[1]); w.y = pg8::cvt_pk_bf16(v0[2], v0[3]); w.z = pg8::cvt_pk_bf16(v1[0], v1[1]); w.w = pg8::cvt_pk_bf16(v1[2], v1[3]);
                        *(u32x4*)(rowp + bj * 128) = w;
                    }
                }
        } else if (kind == 3) {
            const int col0 = u.pn * 256 + wc * 32 + 8 * fq;
            const float* gp = gmod + (size_t)4 * NMOD + col0;
            f32x4 gv[2][2];
#pragma unroll
            for (int bj = 0; bj < 2; ++bj)
#pragma unroll
                for (int n = 0; n < 2; ++n) gv[bj][n] = *(const f32x4*)(gp + bj * 128 + n * 4);
            float* Pk = G + (size_t)u.ks * TC * D;
#pragma unroll
            for (int ai = 0; ai < 2; ++ai)
#pragma unroll
                for (int m = 0; m < 4; ++m) {
                    float* rowp = Pk + (size_t)(row0 + ai * 128 + m * 16) * D + col0;
#pragma unroll
                    for (int bj = 0; bj < 2; ++bj)
#pragma unroll
                        for (int n = 0; n < 2; ++n) *(f32x4*)(rowp + bj * 128 + n * 4) = gv[bj][n] * acc[ai][bj][m][n];
                }
        } else {
            const int col0 = u.pn * 128 + wc * 32 + 8 * fq;
#pragma unroll
            for (int ai = 0; ai < 2; ++ai)
#pragma unroll
                for (int m = 0; m < 4; ++m) {
                    bf16_t* rowp = O + (size_t)(row0 + ai * 128 + m * 16) * DFF + col0;
                    f32x4 v0, v1;
#pragma unroll
                    for (int j = 0; j < 4; ++j) { v0[j] = silu_f(acc[ai][0][m][0][j]) * acc[ai][1][m][0][j]; v1[j] = silu_f(acc[ai][0][m][1][j]) * acc[ai][1][m][1][j]; }
                    u32x4 w; w.x = pg8::cvt_pk_bf16(v0[0], v0[1]); w.y = pg8::cvt_pk_bf16(v0[2], v0[3]); w.z = pg8::cvt_pk_bf16(v1[0], v1[1]); w.w = pg8::cvt_pk_bf16(v1[2], v1[3]);
                    *(u32x4*)rowp = w;
                }
        }
    }
};
struct SplitOrder {
    int nsplit, G, c;
    __device__ bool next(int i, pg8::Unit& u) const {
        const int L = i * G + c; if (L >= 32 * nsplit) return false;
        const int tile = L / nsplit; u.ks = L % nsplit; u.pm = tile >> 3; u.pn = tile & 7; return true;
    }
    DI void a_ready(const pg8::Unit&) const {}
    DI void done(const pg8::Unit&) const {}
};
template <class Epi> DI void run_gemm(unsigned char* smem, const bf16_t* A, const bf16_t* Bt, int M, int N, int K, const Epi& E) {
    pg8::Gemm g; g.A = A; g.Bt = Bt; g.M = M; g.N = N; g.K = K; g.ld = K;
    pg8::StaticOrder S; S.init(M, N, ogdim(), obid());
    pg8::gemm_phase<Epi, pg8::StaticOrder, false>((PG8_LAS unsigned char*)smem, g, S, E, nullptr);
}

__device__ void phase_pre(const KP& p, int l, unsigned char* smem) {
    const int tid = otid();
    bf16_t* U = (bf16_t*)(p.ws + WS_U);
    const float* G = (const float*)(p.ws + WS_GATES);
    bf16_t* X = (bf16_t*)(p.ws + WS_XBC);
    float2* GL = (float2*)(p.ws + WS_GL);
    constexpr int NGLA = 2 * (T / 64), NR16 = T / 16;
    for (int it = obid(); it < NGLA + 2 * NR16; it += ogdim()) {
        if (it < NGLA) {
            const int blk = it >> 1, gd = it & 1, r0 = blk * 64;
            const int half = tid >> 8, gch = tid & 255;
            float* as = (float*)smem;
            float* tot = as + 64 * 16;
            __syncthreads();
            if (tid < 256) { const int t = tid >> 2, c4 = (tid & 3) * 4; *(f32x4*)(as + t * 16 + c4) = *(const f32x4*)(G + (size_t)(r0 + t) * 64 + 32 + gd * 16 + c4); }
            float gw[16];
#pragma unroll
            for (int r = 0; r < 16; ++r) gw[r] = p.in[I_GGW][((size_t)(l * 2 + gd) * 16 + r) * 256 + gch];
            const float gb = p.in[I_GGB][(l * 2 + gd) * 256 + gch];
            bf16_t* QG = (bf16_t*)(p.ws + WS_QG) + (size_t)gd * T * 256 + gch;
            bf16_t* KG = (bf16_t*)(p.ws + WS_KG) + (size_t)gd * T * 256 + gch;
            __syncthreads();
            float* las = tot + 256;
            float lsum = 0.f;
#pragma unroll 2
            for (int j = 0; j < 32; ++j) {
                const int sp = half * 32 + j, t = gd ? 63 - sp : sp;
                const float* ar = as + t * 16;
                float x = gb;
#pragma unroll
                for (int r4 = 0; r4 < 4; ++r4) { const f32x4 a4 = *(const f32x4*)(ar + r4 * 4); x += a4[0] * gw[r4 * 4] + a4[1] * gw[r4 * 4 + 1] + a4[2] * gw[r4 * 4 + 2] + a4[3] * gw[r4 * 4 + 3]; }
                const float lv = logsigmoid_f(x) * (1.f / 16.f); las[j * 512 + tid] = lv; lsum += lv;
            }
            if (half == 0) tot[gch] = lsum;
            __syncthreads();
            float bsum = half ? tot[gch] : 0.f;
            if (half) ((float*)(p.ws + WS_EE))[((size_t)gd * (T / 64) + blk) * 256 + gch] = __expf(bsum + lsum);
            for (int tb = 0; tb < 32; tb += 8) {
                unsigned short qv[8], kv[8];
#pragma unroll
                for (int j = 0; j < 8; ++j) { const int sp = half * 32 + tb + j, t = gd ? 63 - sp : sp; qv[j] = U[(size_t)(r0 + t) * NU + U_GQ + gch]; kv[j] = U[(size_t)(r0 + t) * NU + U_GK + gch]; }
#pragma unroll
                for (int j = 0; j < 8; ++j) {
                    const int sp = half * 32 + tb + j, t = gd ? 63 - sp : sp;
                    bsum += las[(tb + j) * 512 + tid];
                    QG[(size_t)(r0 + t) * 256] = f2bf(bf2f(qv[j]) * __expf(bsum) * 0.125f);
                    KG[(size_t)(r0 + t) * 256] = f2bf(bf2f(kv[j]) * __expf(-bsum));
                }
            }
        } else if (it < NGLA + NR16) {
            const int r0 = (it - NGLA) * 16, c0 = 2 * tid;
            int t0, L; if (r0 < TL) { t0 = r0 & (SEQ - 1); L = SEQ; } else { t0 = (r0 - TL) & (CTXL - 1); L = CTXL; }
            const float* cw = p.in[I_SCONVW] + (size_t)l * 3 * 1024; const float* cb = p.in[I_SCONVB] + (size_t)l * 1024;
            const float2 w0 = *(const float2*)(cw + c0), w1 = *(const float2*)(cw + 1024 + c0), w2 = *(const float2*)(cw + 2048 + c0), bb = *(const float2*)(cb + c0);
            const bf16_t* up = U + (size_t)r0 * NU + U_XBC + c0;
            unsigned x[18];
            x[0] = t0 > 0 ? *(const unsigned*)(up - NU) : 0u;
#pragma unroll
            for (int j = 0; j < 16; ++j) x[j + 1] = *(const unsigned*)(up + (size_t)j * NU);
            x[17] = (t0 + 16 < L) ? *(const unsigned*)(up + (size_t)16 * NU) : 0u;
#pragma unroll
            for (int j = 0; j < 16; ++j) {
                const float o0 = bb.x + w0.x * bf2f(x[j] & 0xffff) + w1.x * bf2f(x[j + 1] & 0xffff) + w2.x * bf2f(x[j + 2] & 0xffff);
                const float o1 = bb.y + w0.y * bf2f(x[j] >> 16) + w1.y * bf2f(x[j + 1] >> 16) + w2.y * bf2f(x[j + 2] >> 16);
                *(unsigned*)(X + (size_t)(r0 + j) * 1024 + c0) = pk2(silu_f(o0), silu_f(o1));
            }
        } else {
            const int r0 = (it - NGLA - NR16) * 16;
            {
                const int rsel = tid >> 8, pp = tid & 255, isk = pp >> 7, idx = (2 * pp) & 255, rh = idx >> 6, rhalf = (idx >> 5) & 1, ri = idx & 31;
                const int rcol = (isk ? U_RK : U_RQ) + rh * 128 + rhalf * 64 + ri;
                const float rscale = isk ? 0.08838834764831845f : 1.f;
                const float f0 = __builtin_amdgcn_exp2f(-(float)ri * (13.287712379549449f / 32.f)), f1 = __builtin_amdgcn_exp2f(-(float)(ri + 1) * (13.287712379549449f / 32.f));
                unsigned a[8], b[8];
#pragma unroll
                for (int j = 0; j < 8; ++j) { const bf16_t* q = U + (size_t)(r0 + rsel * 8 + j) * NU + rcol; a[j] = *(const unsigned*)q; b[j] = *(const unsigned*)(q + 32); }
#pragma unroll
                for (int j = 0; j < 8; ++j) {
                    const int row = r0 + rsel * 8 + j;
                    float x1a = bf2f(a[j] & 0xffff), x1b = bf2f(a[j] >> 16), x2a = bf2f(b[j] & 0xffff), x2b = bf2f(b[j] >> 16);
                    if (row < TL) {
                        const int t = row & (SEQ - 1);
                        const float pos = (float)(rhalf ? (t & 63) : (t >> 6));
                        float ra = pos * f0 * 0.15915494309189535f, rb = pos * f1 * 0.15915494309189535f; ra -= floorf(ra); rb -= floorf(rb);
                        const float sa = __builtin_amdgcn_sinf(ra), ca = __builtin_amdgcn_cosf(ra), sb = __builtin_amdgcn_sinf(rb), cbv = __builtin_amdgcn_cosf(rb);
                        const float y1a = x1a * ca - x2a * sa, y2a = x1a * sa + x2a * ca, y1b = x1b * cbv - x2b * sb, y2b = x1b * sb + x2b * cbv;
                        x1a = y1a; x2a = y2a; x1b = y1b; x2b = y2b;
                    }
                    bf16_t* q = U + (size_t)row * NU + rcol;
                    *(unsigned*)q = pk2(x1a * rscale, x1b * rscale); *(unsigned*)(q + 32) = pk2(x2a * rscale, x2b * rscale);
                }
            }
            {
                const int row = r0 + (tid >> 5), ds = tid & 31, d = ds >> 4, slot = ds & 15;
                const float* gr = G + (size_t)row * 64;
                float loga, logw;
                if (slot < 4) {
                    const int h = slot;
                    logw = gr[d * 4 + h] + p.in[I_MIGB][(l * 2 + d) * 4 + h];
                    loga = logsigmoid_f(gr[8 + d * 4 + h] + p.in[I_MFGB][(l * 2 + d) * 4 + h]);
                } else if (slot < 12) {
                    const int h = slot - 4;
                    const float dt = softplus_f(gr[16 + d * 8 + h] + p.in[I_SDTB][(l * 2 + d) * 8 + h]);
                    loga = -dt * __expf(p.in[I_SALOG][(l * 2 + d) * 8 + h]); logw = __logf(dt);
                } else {
                    const int h = slot - 12;
                    loga = -__expf(p.in[I_RDECAY][(l * 2 + d) * 4 + h]); logw = 0.f;
                }
                GL[(size_t)(d * 16 + slot) * T + row] = make_float2(loga, logw);
            }
        }
    }
}

typedef short s16x4 __attribute__((ext_vector_type(4)));
#define LDSP(T_, ptr) ((__attribute__((address_space(3))) T_*)(ptr))
DI bf16x8 tr_frag(const bf16_t* lo_addr, int row_stride  ) {
    const s16x4 lo = __builtin_amdgcn_ds_read_tr16_b64_v4i16(LDSP(s16x4, lo_addr));
    const s16x4 hi = __builtin_amdgcn_ds_read_tr16_b64_v4i16(LDSP(s16x4, lo_addr + 4 * row_stride));
    return __builtin_shufflevector(lo, hi, 0, 1, 2, 3, 4, 5, 6, 7);
}
#define MFMA16(a, b, c) __builtin_amdgcn_mfma_f32_16x16x32_bf16((a), (b), (c), 0, 0, 0)
template <int MIX, bool DEN> struct ScanCfg {
    static constexpr int DK = MIX == 3 ? 64 : 128, NH = MIX == 1 ? 2 : 1, NT = DK / 16, KS2 = DK / 32;
    static constexpr int NVC = DEN ? 144 : 128;
    static constexpr int QST = DK + 8, VST = NVC + 8, PST = 72;
    static constexpr int SZQ = 64 * QST * 2, SZV = 64 * VST * 2, SZVEC = NH * 320 * 4;
    static constexpr int OFF_K = SZQ, OFF_V = 2 * SZQ, OFF_VEC = 2 * SZQ + SZV, BUF = 2 * SZQ + SZV + SZVEC;
    static constexpr int OFF_PW = 2 * BUF, SZP = NH * 64 * PST * 2;
    static_assert(OFF_PW + SZP <= LDS_BYTES, "scan LDS layout");
};
DI int chunk_base(int b, int d, int c) { if (c < 4) return TL + b * CTXL + (d ? 3 - c : c) * 64; const int cc = c - 4; return b * SEQ + (d ? 63 - cc : cc) * 64; }

template <int MIX, bool DEN>
__device__ void scan_item(const KP& p, int b, int d, int grp, unsigned char* smem) {
    using C = ScanCfg<MIX, DEN>;
    constexpr int DK = C::DK, NH = C::NH, NT = C::NT, KS2 = C::KS2, QST = C::QST, VST = C::VST, PST = C::PST;
    constexpr int QPR = DK / 8;
    constexpr int NQP = (64 * QPR) / 512;
    const int tid = otid(), lane = tid & 63, wid = __builtin_amdgcn_readfirstlane(tid >> 6);
    const int l15 = lane & 15, g4 = lane >> 4, tq = l15 >> 2, tp = l15 & 3;
    const bf16_t* U = (const bf16_t*)(p.ws + WS_U); const bf16_t* X = (const bf16_t*)(p.ws + WS_XBC);
    const bf16_t *qsrc, *ksrc, *vsrc; int qld, vld;
    if (MIX == 0) { qsrc = U + U_MQ + grp * 128; ksrc = U + U_MK + grp * 128; vsrc = U + U_MV + grp * 128; qld = NU; vld = NU; }
    if (MIX == 1) { qsrc = X + 768 + (grp >> 1) * 128; ksrc = X + 512 + (grp >> 1) * 128; vsrc = X + grp * 128; qld = 1024; vld = 1024; }
    if (MIX == 2) { qsrc = U + U_RQ + grp * 128; ksrc = U + U_RK + grp * 128; vsrc = U + U_RV + grp * 128; qld = NU; vld = NU; }
    if (MIX == 3) { qsrc = (const bf16_t*)(p.ws + WS_QG) + (size_t)d * T * 256 + grp * 64; ksrc = (const bf16_t*)(p.ws + WS_KG) + (size_t)d * T * 256 + grp * 64; vsrc = U + U_GV + grp * 128; qld = 256; vld = NU; }
    const int slot0 = MIX == 0 ? grp : MIX == 1 ? 4 + 2 * grp : 12 + grp;
    const float2* GL = (const float2*)(p.ws + WS_GL) + (size_t)(d * 16 + slot0 + (wid < NH ? wid : 0)) * T;
    const float* EE = (const float*)(p.ws + WS_EE) + (size_t)d * (T / 64) * 256 + grp * 64;
    bf16_t* YS = (bf16_t*)(p.ws + WS_YS) + (size_t)d * T * D + MIX * 512 + grp * 128;
    float* DENP = (float*)(p.ws + WS_DEN) + (size_t)d * T * 4 + grp;
    constexpr float LOGQS = MIX == 0 ? -2.4260151319598084f : 0.f;

    __syncthreads();
    for (int i = tid; i < C::SZP / 4; i += 512) ((unsigned*)(smem + C::OFF_PW))[i] = 0u;
    if (DEN) {
        for (int i = tid; i < 2 * 64 * 16; i += 512) { const int bf = i >> 10, r = (i >> 4) & 63, cc = i & 15; ((bf16_t*)(smem + bf * C::BUF + C::OFF_V))[r * VST + 128 + cc] = cc == 0 ? (bf16_t)0x3F80 : (bf16_t)0; }
    }
    f32x4 S0[NT];
#pragma unroll
    for (int t = 0; t < NT; ++t) S0[t] = (f32x4){0.f, 0.f, 0.f, 0.f};

    u32x4 rqA[NQP], rkA[NQP], rvA[2], rqB[NQP], rkB[NQP], rvB[2]; float gxA = 0.f, gyA = 0.f, eeA = 0.f, gxB = 0.f, gyB = 0.f, eeB = 0.f;
#define ISSUE_ALL(c_, S_) do { \
        const int base_ = chunk_base(b, d, (c_)); \
_Pragma("unroll") \
        for (int i = 0; i < NQP; ++i) { const int pc = tid + 512 * i, r = pc / QPR, c8 = pc % QPR; const size_t row = (size_t)(base_ + (d ? 63 - r : r)); \
            rq##S_[i] = *(const u32x4*)(qsrc + row * qld + c8 * 8); rk##S_[i] = *(const u32x4*)(ksrc + row * qld + c8 * 8); } \
_Pragma("unroll") \
        for (int i = 0; i < 2; ++i) { const int pc = tid + 512 * i, r = pc >> 4, c8 = pc & 15; const size_t row = (size_t)(base_ + (d ? 63 - r : r)); \
            rv##S_[i] = *(const u32x4*)(vsrc + row * vld + c8 * 8); } \
        if (MIX != 3) { if (wid < NH) { const float2 g_ = GL[base_ + (d ? 63 - lane : lane)]; gx##S_ = g_.x; gy##S_ = g_.y; } } \
        else if (wid == 0) ee##S_ = EE[(size_t)(base_ >> 6) * 256 + lane]; \
    } while (0)
#define STAGE_ALL(bufi, S_) do { \
        unsigned char* B_ = smem + (bufi) * C::BUF; \
_Pragma("unroll") \
        for (int i = 0; i < NQP; ++i) { const int pc = tid + 512 * i, r = pc / QPR, c8 = pc % QPR; \
            *(u32x4*)((bf16_t*)B_ + r * QST + c8 * 8) = rq##S_[i]; *(u32x4*)((bf16_t*)(B_ + C::OFF_K) + r * QST + c8 * 8) = rk##S_[i]; } \
_Pragma("unroll") \
        for (int i = 0; i < 2; ++i) { const int pc = tid + 512 * i, r = pc >> 4, c8 = pc & 15; *(u32x4*)((bf16_t*)(B_ + C::OFF_V) + r * VST + c8 * 8) = rv##S_[i]; } \
        float* vec_ = (float*)(B_ + C::OFF_VEC); \
        if (MIX != 3) { \
            if (wid < NH) { \
                float bc = gx##S_; \
                bc += __uint_as_float(__builtin_amdgcn_update_dpp(0, __float_as_uint(bc), 0x111, 0xf, 0xf, false)); \
                bc += __uint_as_float(__builtin_amdgcn_update_dpp(0, __float_as_uint(bc), 0x112, 0xf, 0xf, false)); \
                bc += __uint_as_float(__builtin_amdgcn_update_dpp(0, __float_as_uint(bc), 0x114, 0xf, 0xf, false)); \
                bc += __uint_as_float(__builtin_amdgcn_update_dpp(0, __float_as_uint(bc), 0x118, 0xf, 0xf, false)); \
                bc += __uint_as_float(__builtin_amdgcn_update_dpp(0, __float_as_uint(bc), 0x142, 0xa, 0xf, false)); \
                bc += __uint_as_float(__builtin_amdgcn_update_dpp(0, __float_as_uint(bc), 0x143, 0xc, 0xf, false)); \
                const float bend = __uint_as_float(__builtin_amdgcn_readlane(__float_as_uint(bc), 63)); \
                const float rt = bc + LOGQS, ct = gy##S_ - bc; \
                float* v = vec_ + wid * 320; \
                v[lane] = rt; v[64 + lane] = ct; v[128 + lane] = __expf(rt); v[192 + lane] = __expf(bend + ct); v[256 + lane] = __expf(bend); \
            } \
        } else if (wid == 0) vec_[256 + lane] = ee##S_; \
    } while (0)

    ISSUE_ALL(0, A);
    STAGE_ALL(0, A);
    ISSUE_ALL(1, B);
    __syncthreads();

    for (int c2 = 0; c2 < (CTXL + SEQ) / 64; c2 += 2) {
#pragma unroll
    for (int par = 0; par < 2; ++par) {
        const int c = c2 + par;
        const int cur = par;
        const int base = chunk_base(b, d, c);
        unsigned char* B = smem + cur * C::BUF;
        const bf16_t* Qs = (const bf16_t*)B; const bf16_t* Ks = (const bf16_t*)(B + C::OFF_K); const bf16_t* Vs = (const bf16_t*)(B + C::OFF_V);
        const float* vec = (const float*)(B + C::OFF_VEC);
        bf16_t* Pw = (bf16_t*)(smem + C::OFF_PW);
        bf16_t* ysb = YS + (size_t)base * D;
        if (c + 2 < (CTXL + SEQ) / 64) { if (par == 0) ISSUE_ALL(c + 2, A); else ISSUE_ALL(c + 2, B); }
#pragma unroll
        for (int rep = 0; rep < 2; ++rep) {
            const int tl = rep == 0 ? wid : wid + 2;
            if (rep == 1 && wid < 6) break;
            const int it = tl >= 6 ? 3 : tl >= 3 ? 2 : tl >= 1 ? 1 : 0, jt = tl - ((it * (it + 1)) >> 1);
            f32x4 acc = (f32x4){0.f, 0.f, 0.f, 0.f};
            bf16x8 pa[KS2], pb[KS2];
#pragma unroll
            for (int ks = 0; ks < KS2; ++ks) {
                pa[ks] = *LDSP(const bf16x8, Ks + (jt * 16 + l15) * QST + ks * 32 + g4 * 8);
                pb[ks] = *LDSP(const bf16x8, Qs + (it * 16 + l15) * QST + ks * 32 + g4 * 8);
            }
            __builtin_amdgcn_sched_barrier(0);
#pragma unroll
            for (int ks = 0; ks < KS2; ++ks) acc = MFMA16(pa[ks], pb[ks], acc);
            const int i = it * 16 + l15, j0 = jt * 16 + g4 * 4;
#pragma unroll
            for (int h = 0; h < NH; ++h) {
                float w[4];
                if (MIX != 3) {
                    const float rt = vec[h * 320 + i]; const f32x4 ct = *LDSP(const f32x4, vec + h * 320 + 64 + j0);
#pragma unroll
                    for (int r = 0; r < 4; ++r) w[r] = (j0 + r <= i) ? __expf(rt + ct[r]) : 0.f;
                } else {
#pragma unroll
                    for (int r = 0; r < 4; ++r) w[r] = (j0 + r <= i) ? 1.f : 0.f;
                }
                u32x2 o; o.x = pg8::cvt_pk_bf16(acc[0] * w[0], acc[1] * w[1]); o.y = pg8::cvt_pk_bf16(acc[2] * w[2], acc[3] * w[3]);
                *LDSP(u32x2, Pw + (h * 64 + i) * PST + j0) = o;
            }
        }
        __syncthreads();
#define SB_() __builtin_amdgcn_sched_barrier(0)
#define QFRAG(dst, it_, ks_) do { \
            const s16x4 a0_ = *LDSP(const s16x4, Qs + ((it_) * 16 + l15) * QST + (ks_) * 32 + g4 * 4); \
            const s16x4 a1_ = *LDSP(const s16x4, Qs + ((it_) * 16 + l15) * QST + (ks_) * 32 + 16 + g4 * 4); \
            dst = __builtin_shufflevector(a0_, a1_, 0, 1, 2, 3, 4, 5, 6, 7); } while (0)
#define SPACK(dst, S, ks_) do { u32x4 sb_; sb_.x = pg8::cvt_pk_bf16(S[2 * (ks_)][0], S[2 * (ks_)][1]); sb_.y = pg8::cvt_pk_bf16(S[2 * (ks_)][2], S[2 * (ks_)][3]); \
            sb_.z = pg8::cvt_pk_bf16(S[2 * (ks_) + 1][0], S[2 * (ks_) + 1][1]); sb_.w = pg8::cvt_pk_bf16(S[2 * (ks_) + 1][2], S[2 * (ks_) + 1][3]); dst = __builtin_bit_cast(bf16x8, sb_); } while (0)
#define SLICE(S, sl) do { \
            const int hh = MIX == 1 ? (sl) >> 2 : 0, vc0 = (sl) * 16; \
            const float* vh = vec + hh * 320; \
            f32x4 Y[4]; \
_Pragma("unroll") \
            for (int it = 0; it < 4; ++it) Y[it] = (f32x4){0.f, 0.f, 0.f, 0.f}; \
              \
            { bf16x8 QA[2][4]; \
_Pragma("unroll") \
              for (int ks = 0; ks < 2; ++ks) \
_Pragma("unroll") \
                for (int it = 0; it < 4; ++it) QFRAG(QA[ks][it], it, ks); \
              SB_(); \
_Pragma("unroll") \
              for (int ks = 0; ks < 2; ++ks) { bf16x8 sbf; SPACK(sbf, S, ks); \
_Pragma("unroll") \
                for (int it = 0; it < 4; ++it) Y[it] = MFMA16(sbf, QA[ks][it], Y[it]); } } \
            SB_(); \
            if (KS2 == 4) { bf16x8 QB[2][4]; \
_Pragma("unroll") \
              for (int ks = 0; ks < 2; ++ks) \
_Pragma("unroll") \
                for (int it = 0; it < 4; ++it) QFRAG(QB[ks][it], it, ks + 2); \
              SB_(); \
_Pragma("unroll") \
              for (int ks = 0; ks < 2; ++ks) { bf16x8 sbf; SPACK(sbf, S, ks + 2); \
_Pragma("unroll") \
                for (int it = 0; it < 4; ++it) Y[it] = MFMA16(sbf, QB[ks][it], Y[it]); } } \
            SB_(); \
              \
            bf16x8 Vf[2], PA[6]; \
_Pragma("unroll") \
            for (int ks = 0; ks < 2; ++ks) Vf[ks] = tr_frag(Vs + (ks * 32 + g4 * 8 + tq) * VST + vc0 + 4 * tp, VST); \
            PA[0] = *LDSP(const bf16x8, Pw + (hh * 64 + 0 * 16 + l15) * PST + 0 * 32 + g4 * 8); \
            PA[1] = *LDSP(const bf16x8, Pw + (hh * 64 + 1 * 16 + l15) * PST + 0 * 32 + g4 * 8); \
            PA[2] = *LDSP(const bf16x8, Pw + (hh * 64 + 2 * 16 + l15) * PST + 0 * 32 + g4 * 8); \
            PA[3] = *LDSP(const bf16x8, Pw + (hh * 64 + 2 * 16 + l15) * PST + 1 * 32 + g4 * 8); \
            PA[4] = *LDSP(const bf16x8, Pw + (hh * 64 + 3 * 16 + l15) * PST + 0 * 32 + g4 * 8); \
            PA[5] = *LDSP(const bf16x8, Pw + (hh * 64 + 3 * 16 + l15) * PST + 1 * 32 + g4 * 8); \
            if (MIX != 3) { \
_Pragma("unroll") \
                for (int it = 0; it < 4; ++it) Y[it] = Y[it] * vh[128 + it * 16 + l15]; \
            } \
            SB_(); \
            Y[0] = MFMA16(Vf[0], PA[0], Y[0]); Y[1] = MFMA16(Vf[0], PA[1], Y[1]); Y[2] = MFMA16(Vf[0], PA[2], Y[2]); Y[3] = MFMA16(Vf[0], PA[4], Y[3]); \
            Y[2] = MFMA16(Vf[1], PA[3], Y[2]); Y[3] = MFMA16(Vf[1], PA[5], Y[3]); \
            SB_(); \
              \
_Pragma("unroll") \
            for (int it = 0; it < 4; ++it) { \
                const int i = it * 16 + l15; const int ro = (d ? 63 - i : i); \
                const f32x4 y = Y[it]; \
                if (DEN) { if (g4 == 0) DENP[((size_t)base + ro) * 4] = y[0]; } \
                else { u32x2 o; o.x = pg8::cvt_pk_bf16(y[0], y[1]); o.y = pg8::cvt_pk_bf16(y[2], y[3]); *(u32x2*)(ysb + ro * D + vc0 + g4 * 4) = o; } \
            } \
            SB_(); \
            bf16x8 Vw[2]; float dec = 1.f; \
            if (MIX != 3) { \
                dec = vh[256]; \
_Pragma("unroll") \
                for (int ks = 0; ks < 2; ++ks) { \
                    const f32x4 w0 = *LDSP(const f32x4, vh + 192 + ks * 32 + g4 * 8), w1 = *LDSP(const f32x4, vh + 192 + ks * 32 + g4 * 8 + 4); \
                    u32x4 o; \
                    o.x = pg8::cvt_pk_bf16(bf2f((unsigned short)Vf[ks][0]) * w0[0], bf2f((unsigned short)Vf[ks][1]) * w0[1]); \
                    o.y = pg8::cvt_pk_bf16(bf2f((unsigned short)Vf[ks][2]) * w0[2], bf2f((unsigned short)Vf[ks][3]) * w0[3]); \
                    o.z = pg8::cvt_pk_bf16(bf2f((unsigned short)Vf[ks][4]) * w1[0], bf2f((unsigned short)Vf[ks][5]) * w1[1]); \
                    o.w = pg8::cvt_pk_bf16(bf2f((unsigned short)Vf[ks][6]) * w1[2], bf2f((unsigned short)Vf[ks][7]) * w1[3]); \
                    Vw[ks] = __builtin_bit_cast(bf16x8, o); \
                } \
            } else { Vw[0] = Vf[0]; Vw[1] = Vf[1]; } \
              \
_Pragma("unroll") \
            for (int th = 0; th < NT / 4; ++th) { \
                bf16x8 KA[4][2]; \
_Pragma("unroll") \
                for (int t = 0; t < 4; ++t) \
_Pragma("unroll") \
                    for (int ks = 0; ks < 2; ++ks) KA[t][ks] = tr_frag(Ks + (ks * 32 + g4 * 8 + tq) * QST + (th * 4 + t) * 16 + 4 * tp, QST); \
                SB_(); \
_Pragma("unroll") \
                for (int t = 0; t < 4; ++t) { \
                    f32x4 acc = S[th * 4 + t] * dec; \
                    acc = MFMA16(KA[t][0], Vw[0], acc); acc = MFMA16(KA[t][1], Vw[1], acc); \
                    if (MIX == 3) { const f32x4 e4 = *LDSP(const f32x4, vec + 256 + (th * 4 + t) * 16 + g4 * 4); acc = acc * e4; } \
                    S[th * 4 + t] = acc; \
                } \
                SB_(); \
            } \
    } while (0)
        if (!DEN) SLICE(S0, wid);
        else if (wid == 0) SLICE(S0, 8);
        if (c + 1 < (CTXL + SEQ) / 64) { if (par == 0) STAGE_ALL(1, B); else STAGE_ALL(0, A); }
        __syncthreads();
    }
    }
}
__device__ void phase_scan(const KP& p, int l, unsigned char* smem) {
    if (ogdim() > 160 && obid() >= 160) {
        const int w = obid() - 160, nw = ogdim() - 160;
        convert_weights(p, l, CT_IN, CT_IN + CT_OUT + CT_UP + CT_DN, w, nw, smem);
        if (l == 0) convert_weights(p, 1, 0, CT_IN, w, nw, smem);
        return;
    }
    for (int item = obid(); item < 160; item += ogdim()) {
        if (item >= 128) { const int idx = item - 128; scan_item<0, true>(p, idx >> 3, (idx >> 2) & 1, idx & 3, smem); continue; }
        const int grp = item & 3, mix = (item >> 2) & 3, d = (item >> 4) & 1, b = item >> 5;
        if (mix == 0) scan_item<0, false>(p, b, d, grp, smem);
        else if (mix == 1) scan_item<1, false>(p, b, d, grp, smem);
        else if (mix == 2) scan_item<2, false>(p, b, d, grp, smem);
        else scan_item<3, false>(p, b, d, grp, smem);
    }
    if (ogdim() <= 160) {
        convert_weights(p, l, CT_IN, CT_IN + CT_OUT + CT_UP + CT_DN, obid(), ogdim(), smem);
        if (l == 0) convert_weights(p, 1, 0, CT_IN, obid(), ogdim(), smem);
    }
}

struct CombRaw { bf16x8 a[4], b[4], g[4], xs[4]; float s0, s1; };
DI void comb_load(const KP& p, int row, int lane, int mixer, int ec0, int gcol, CombRaw& r) {
    const bf16_t* U = (const bf16_t*)(p.ws + WS_U); const bf16_t* X = (const bf16_t*)(p.ws + WS_XBC);
    const bf16_t* YS = (const bf16_t*)(p.ws + WS_YS); const float* DEN = (const float*)(p.ws + WS_DEN);
    const bf16_t* y0p = YS + (size_t)row * D + mixer * 512 + ec0; const bf16_t* y1p = y0p + (size_t)T * D;
    r.s0 = 1.f; r.s1 = 1.f;
    if (mixer == 0) { const int h = (lane & 15) >> 2; r.s0 = DEN[(size_t)row * 4 + h]; r.s1 = DEN[((size_t)T + row) * 4 + h]; }
#pragma unroll
    for (int i = 0; i < 4; ++i) { r.a[i] = *(const bf16x8*)(y0p + i * 8); r.b[i] = *(const bf16x8*)(y1p + i * 8); r.g[i] = *(const bf16x8*)(U + (size_t)row * NU + gcol + i * 8); }
    if (mixer == 1) {
#pragma unroll
        for (int i = 0; i < 4; ++i) r.xs[i] = *(const bf16x8*)(X + (size_t)row * 1024 + ec0 + i * 8);
    }
}
DI void comb_compute(const KP& p, int row, int lane, int mixer, int ec0, const float* gain, float sd, const CombRaw& r) {
    bf16_t* H = (bf16_t*)(p.ws + WS_H);
    float y[32], gt[32];
    float s0 = 1.f, s1 = 1.f;
    if (mixer == 0) { s0 = 1.f / fmaxf(fabsf(r.s0), 1.f); s1 = 1.f / fmaxf(fabsf(r.s1), 1.f); }
#pragma unroll
    for (int i = 0; i < 4; ++i) {
#pragma unroll
        for (int j = 0; j < 8; ++j) {
            y[i * 8 + j] = bf2f((unsigned short)r.a[i][j]) * s0 + bf2f((unsigned short)r.b[i][j]) * s1;
            const float gv = bf2f((unsigned short)r.g[i][j]);
            gt[i * 8 + j] = mixer == 0 ? sigmoid_f(gv) : silu_f(gv);
        }
    }
    if (mixer == 1) {
#pragma unroll
        for (int i = 0; i < 4; ++i) {
#pragma unroll
            for (int j = 0; j < 8; ++j) { y[i * 8 + j] = (y[i * 8 + j] + sd * bf2f((unsigned short)r.xs[i][j])) * gt[i * 8 + j]; gt[i * 8 + j] = 1.f; }
        }
    }
    float s = 0.f;
#pragma unroll
    for (int j = 0; j < 32; ++j) s += y[j];
    s += shx(s, 1, lane); s += shx(s, 2, lane);
    const float mean = (mixer == 0 || mixer == 2) ? s * (1.f / 128.f) : 0.f;
    float q = 0.f;
#pragma unroll
    for (int j = 0; j < 32; ++j) { y[j] -= mean; q += y[j] * y[j]; }
    q += shx(q, 1, lane); q += shx(q, 2, lane);
    float q16 = q; q16 += shx(q16, 4, lane); q16 += shx(q16, 8, lane);
    const float rstd = rsqrtf((mixer == 1 ? q16 * (1.f / 512.f) : q * (1.f / 128.f)) + EPS);
    bf16_t* op = H + (size_t)row * D + mixer * 512 + ec0;
#pragma unroll
    for (int i = 0; i < 4; ++i) {
        const f32x4 g0 = *(const f32x4*)(gain + i * 8), g1 = *(const f32x4*)(gain + i * 8 + 4);
        u32x4 w;
        w.x = pg8::cvt_pk_bf16(y[i * 8 + 0] * rstd * g0[0] * gt[i * 8 + 0], y[i * 8 + 1] * rstd * g0[1] * gt[i * 8 + 1]);
        w.y = pg8::cvt_pk_bf16(y[i * 8 + 2] * rstd * g0[2] * gt[i * 8 + 2], y[i * 8 + 3] * rstd * g0[3] * gt[i * 8 + 3]);
        w.z = pg8::cvt_pk_bf16(y[i * 8 + 4] * rstd * g1[0] * gt[i * 8 + 4], y[i * 8 + 5] * rstd * g1[1] * gt[i * 8 + 5]);
        w.w = pg8::cvt_pk_bf16(y[i * 8 + 6] * rstd * g1[2] * gt[i * 8 + 6], y[i * 8 + 7] * rstd * g1[3] * gt[i * 8 + 7]);
        *(u32x4*)(op + i * 8) = w;
    }
}
__device__ void phase_comb(const KP& p, int l, int Mrows) {
    const int tid = otid(); const int lane = tid & 63, wid = tid >> 6;
    const int mixer = lane >> 4, ec0 = (lane & 15) * 32;
    const int gcol = (mixer == 0 ? U_MO : mixer == 1 ? U_SZ : mixer == 2 ? U_RG : U_GG) + ec0;
    const float* gain = (mixer == 0 ? p.in[I_MNORM] : mixer == 1 ? p.in[I_SNORM] : mixer == 2 ? p.in[I_RNORM] : p.in[I_GNORM]) + l * 512 + ec0;
    const float sd = p.in[I_SD][l * 8 + (ec0 >> 6)];
    const int stride = ogdim() * 8;
    for (int row = obid() * 8 + wid; row < Mrows; row += 2 * stride) {
        const int row1 = row + stride; const bool has1 = row1 < Mrows;
        CombRaw r0, r1;
        comb_load(p, row, lane, mixer, ec0, gcol, r0);
        if (has1) comb_load(p, row1, lane, mixer, ec0, gcol, r1);
        comb_compute(p, row, lane, mixer, ec0, gain, sd, r0);
        if (has1) comb_compute(p, row1, lane, mixer, ec0, gain, sd, r1);
    }
}

__device__ void run_phase(const KP& p, int ph, unsigned char* smem) {
    const float* mod = (const float*)(p.ws + WS_MOD);
    if (ph == 0) { phase_init(p, smem); return; }
    if (ph == 1) { phase_row<false, true, true>(p, T, nullptr, nullptr, mod, 0, 2048); return; }
    const int l = (ph - 2) / 9, k = (ph - 2) % 9;
    const bool last = l == 1;
    const int Mrows = last ? TL : T;
    const float* modl = mod + (size_t)l * 5 * NMOD;
    bf16_t* H = (bf16_t*)(p.ws + WS_H); bf16_t* U = (bf16_t*)(p.ws + WS_U);
    if (k == 0 || k == 4 || k == 6 || k == 7) {
        EpiAll E; E.kind = k == 0 ? 0 : (k == 6 ? 2 : 1); E.O = E.kind == 1 ? (bf16_t*)(p.ws + WS_YS) : U; E.G = (float*)(p.ws + WS_GATES); E.gmod = modl + (k == 4 ? 4096 : 10240);
        const bf16_t* A = k == 7 ? U : H;
        const bf16_t* Bt = (const bf16_t*)(p.ws + (k == 0 ? WS_WIN : k == 4 ? WS_WOUT : k == 6 ? WS_WUP : WS_WDN));
        const int N = k == 0 ? NINP : (k == 6 ? NUP : D), K = k == 7 ? DFF : D;
        const bool split = !last && (k == 4 || k == 7);
        const int M = (k == 0 || k == 6) ? (k == 0 ? T : Mrows) : TL;
        run_gemm(smem, A, Bt, M, N, K, E);
        if (split) {
            const int nsplit = k == 4 ? 8 : 4;
            EpiAll E2 = E; E2.kind = 3; E2.G = (float*)(p.ws + WS_YS + (size_t)T * D * 2);
            pg8::Gemm g; g.A = A + (size_t)TL * K; g.Bt = Bt; g.M = TC; g.N = D; g.K = K / nsplit; g.ld = K;
            SplitOrder S; S.nsplit = nsplit; S.G = ogdim(); S.c = obid();
            pg8::gemm_phase<EpiAll, SplitOrder, false>((PG8_LAS unsigned char*)smem, g, S, E2, nullptr);
        }
        return;
    }
    switch (k) {
    case 1: phase_pre(p, l, smem); break;
    case 2: phase_scan(p, l, smem); break;
    case 3: phase_comb(p, l, Mrows); break;
    case 5:
        if (l == 0) phase_row<true, true, true>(p, Mrows, p.in[I_POSTG] + (size_t)(l * 2 + 0) * D, p.in[I_POSTB] + (size_t)(l * 2 + 0) * D, modl, 6144, 8192, (const float*)(p.ws + WS_YS + (size_t)T * D * 2), 8);
        else phase_row<true, true, false>(p, Mrows, p.in[I_POSTG] + (size_t)(l * 2 + 0) * D, p.in[I_POSTB] + (size_t)(l * 2 + 0) * D, modl, 6144, 8192);
        break;
    case 8:
        if (!last) { phase_row<true, true>(p, T, p.in[I_POSTG] + (size_t)(l * 2 + 1) * D, p.in[I_POSTB] + (size_t)(l * 2 + 1) * D, modl + 5 * NMOD, 0, 2048, (const float*)(p.ws + WS_YS + (size_t)T * D * 2), 4); }
        else phase_row<true, false>(p, TL, p.in[I_POSTG] + (size_t)(l * 2 + 1) * D, p.in[I_POSTB] + (size_t)(l * 2 + 1) * D, modl, 0, 0);
        break;
    }
}

DI void grid_barrier(unsigned* bar, unsigned target) {
    asm volatile("s_waitcnt vmcnt(0) lgkmcnt(0)" ::: "memory");
    __syncthreads();
    if (threadIdx.x == 0) {
        __builtin_amdgcn_fence(__ATOMIC_RELEASE, "agent");
        asm volatile("s_waitcnt vmcnt(0)" ::: "memory");
        __hip_atomic_fetch_add(bar, 1u, __ATOMIC_RELAXED, __HIP_MEMORY_SCOPE_AGENT);
        while (__hip_atomic_load(bar, __ATOMIC_RELAXED, __HIP_MEMORY_SCOPE_AGENT) < target) __builtin_amdgcn_s_sleep(1);
        __builtin_amdgcn_fence(__ATOMIC_ACQUIRE, "agent");
        asm volatile("s_waitcnt vmcnt(0)" ::: "memory");
    }
    __syncthreads();
}
#ifndef PROBE_MASK
#define PROBE_MASK 0u
#endif
__global__ void __launch_bounds__(512, 2) mega(KP p) {
    extern __shared__ __attribute__((aligned(16))) unsigned char smem[];
    cg::grid_group grid = cg::this_grid();
    unsigned nbar = 0;
    unsigned long long tacc = 0ull;
    for (int ph = p.ph_lo; ph < p.ph_hi; ++ph) {
        unsigned long long t0 = 0ull;
        if (PROBE_MASK != 0u) t0 = __builtin_amdgcn_s_memrealtime();
        if (ph == 0 && blockIdx.x == 0 && threadIdx.x == 0) __hip_atomic_store((unsigned*)(p.ws + WS_BAR), 0u, __ATOMIC_RELAXED, __HIP_MEMORY_SCOPE_AGENT);
        run_phase(p, ph, smem);
        if (ph + 1 < p.ph_hi) {
            if (ph == 0) grid.sync();
            else { ++nbar; grid_barrier((unsigned*)(p.ws + WS_BAR), nbar * gridDim.x); }
        }
        if (PROBE_MASK != 0u && ((PROBE_MASK >> ph) & 1u)) tacc += __builtin_amdgcn_s_memrealtime() - t0;
    }
    if (PROBE_MASK != 0u && blockIdx.x == 0 && threadIdx.x == 0) {
        const unsigned long long t1 = __builtin_amdgcn_s_memrealtime();
        while (__builtin_amdgcn_s_memrealtime() - t1 < tacc) __builtin_amdgcn_s_sleep(8);
    }
}

#ifndef ONE_LAUNCH
#define ONE_LAUNCH 1
#endif
extern "C" void kernel_launch(void* const* d_in, const int* in_sizes, int n_in, void* d_out, int out_size, void* d_ws, size_t ws_size, hipStream_t stream) {
    static int grid = 0;
    if (grid == 0) {
        if (n_in != 26 || out_size != TL * D || ws_size < WS_END) { fprintf(stderr, "kernel_launch: unexpected shapes (n_in %d out %d ws %zu need %zu)\n", n_in, out_size, ws_size, (size_t)WS_END); grid = -1; return; }
        int dev = 0, cus = 0, per_cu = 0;
        hipGetDevice(&dev); hipDeviceGetAttribute(&cus, hipDeviceAttributeMultiprocessorCount, dev);
        if (hipFuncSetAttribute((const void*)mega, hipFuncAttributeMaxDynamicSharedMemorySize, LDS_BYTES) != hipSuccess) { fprintf(stderr, "kernel_launch: hipFuncSetAttribute failed\n"); grid = -1; return; }
        if (hipOccupancyMaxActiveBlocksPerMultiprocessor(&per_cu, (const void*)mega, 512, LDS_BYTES) != hipSuccess || per_cu < 1) { fprintf(stderr, "kernel_launch: occupancy query gives %d\n", per_cu); per_cu = 1; }
        (void)hipGetLastError();
        grid = cus;
    }
    if (grid < 0) return;
    KP p{};
    for (int i = 0; i < 26; ++i) p.in[i] = (const float*)d_in[i];
    p.out = (float*)d_out; p.ws = (unsigned char*)d_ws;
#if ONE_LAUNCH
    p.ph_lo = 0; p.ph_hi = NPHASE;
    void* args[] = {&p};
    hipError_t e = hipLaunchCooperativeKernel((const void*)mega, dim3(grid), dim3(512), args, LDS_BYTES, stream);
    if (e != hipSuccess) fprintf(stderr, "cooperative launch failed: %s (grid %d)\n", hipGetErrorString(e), grid);
#else
    for (int ph = 0; ph < NPHASE; ++ph) {
        p.ph_lo = ph; p.ph_hi = ph + 1;
        hipLaunchKernelGGL(mega, dim3(grid), dim3(512), LDS_BYTES, stream, p);
    }
#endif
}
```
